# Optimizing an MI355X kernel written in HIP

```python
import jax, jax.numpy as jnp
from jax import lax
import numpy as np

D_MODEL = 4096
BATCH = 4
SEQ = 4096
DEPTH = 1

GRID_W = 64
CTX_LEN = 256
NA_HEADS = 16
HEAD_DIM = 128
D_NA = NA_HEADS * HEAD_DIM
NA_KH_MAX = 8
NA_KW = 16
D_SGU = D_MODEL - D_NA
SGU_GROUPS = 4
SGU_GROUP_DIM = D_SGU // SGU_GROUPS
SGU_CHUNK = 128
D_IN = 3 * D_NA + 2 * D_SGU
D_FF = 4 * D_MODEL
N_MOD = 6
NORM_EPS = 1e-6

kernel_name = "hybrid_na_sgu_dit_layer"


def rmsnorm(x, w):
    xf = x.astype(jnp.float32)
    y = xf * lax.rsqrt(jnp.mean(xf * xf, axis=-1, keepdims=True) + NORM_EPS)
    return (y * w.astype(jnp.float32)).astype(x.dtype)


def adaln(cvec, w_ada, b_ada):
    m = (jax.nn.silu(cvec) @ w_ada + b_ada)[..., None, :]
    return jnp.split(m, N_MOD, axis=-1)


def modulate(h, shift, scale):
    return h * (1 + scale) + shift


def split_proj(proj):
    return jnp.split(proj, [D_NA, 2 * D_NA, 3 * D_NA, 3 * D_NA + D_SGU], axis=-1)


def to_heads(t):
    b, l, _ = t.shape
    return t.reshape(b, l, NA_HEADS, HEAD_DIM)


def neighbourhood_attention(q, k, v, k_ctx, v_ctx, rpb):
    b, s, h, dh = q.shape
    rows = s // GRID_W
    kh = min(NA_KH_MAX, rows)
    scale = dh ** -0.5
    qg = (q * scale).reshape(b, rows, GRID_W, h, dh)
    kg = k.reshape(b, rows, GRID_W, h, dh)
    vg = v.reshape(b, rows, GRID_W, h, dh)
    cols = jnp.arange(GRID_W)
    col_start = jnp.clip(cols - NA_KW // 2, 0, GRID_W - NA_KW)
    key_cols = col_start[:, None] + jnp.arange(NA_KW)[None, :]
    col_off = key_cols - cols[:, None] + (NA_KW - 1)
    n_win = kh * NA_KW

    def row_block(r):
        r0 = jnp.clip(r - kh // 2, 0, rows - kh)
        q_r = lax.dynamic_index_in_dim(qg, r, axis=1, keepdims=False)
        k_rows = lax.dynamic_slice_in_dim(kg, r0, kh, axis=1)
        v_rows = lax.dynamic_slice_in_dim(vg, r0, kh, axis=1)
        k_win = k_rows[:, :, key_cols]
        v_win = v_rows[:, :, key_cols]
        s_win = jnp.einsum('bqhd,biqjhd->bhqij', q_r, k_win)
        row_off = r0 + jnp.arange(kh) - r + (NA_KH_MAX - 1)
        bias = rpb[:, row_off][:, :, col_off]
        s_win = s_win + jnp.transpose(bias, (0, 2, 1, 3))[None]
        s_ctx = jnp.einsum('bqhd,bchd->bhqc', q_r, k_ctx)
        scores = jnp.concatenate([s_win.reshape(b, h, GRID_W, n_win), s_ctx], axis=-1)
        p = jax.nn.softmax(scores.astype(jnp.float32), axis=-1).astype(v.dtype)
        p_win = p[..., :n_win].reshape(b, h, GRID_W, kh, NA_KW)
        p_ctx = p[..., n_win:]
        return (jnp.einsum('bhqij,biqjhd->bqhd', p_win, v_win)
                + jnp.einsum('bhqc,bchd->bqhd', p_ctx, v_ctx))

    out = lax.map(row_block, jnp.arange(rows))
    return jnp.transpose(out, (1, 0, 2, 3, 4)).reshape(b, s, h * dh)


def context_attention(q, k, v):
    b, l, h, dh = q.shape
    s = jnp.einsum('bqhd,bkhd->bhqk', q * dh ** -0.5, k)
    p = jax.nn.softmax(s.astype(jnp.float32), axis=-1).astype(v.dtype)
    return jnp.einsum('bhqk,bkhd->bqhd', p, v).reshape(b, l, h * dh)


def spatial_gating(u, g, w_s, b_s, norm_w):
    b, l, _ = u.shape
    gn = rmsnorm(g, norm_w).reshape(b, l // SGU_CHUNK, SGU_CHUNK, SGU_GROUPS, SGU_GROUP_DIM)
    mixed = jnp.einsum('gpq,bnqgc->bnpgc', w_s, gn) + jnp.transpose(b_s)[None, None, :, :, None]
    return u * mixed.reshape(b, l, D_SGU)


def merge_groups(o_na, o_sgu, gn_na, gn_sgu, w_out):
    return jnp.concatenate([rmsnorm(o_na, gn_na), rmsnorm(o_sgu, gn_sgu)], axis=-1) @ w_out


def squared_relu_mlp(h, w1, w2):
    return jnp.square(jax.nn.relu(h @ w1)) @ w2


def setup_inputs(seed: int = 0) -> dict:
    key = jax.random.key(seed)
    ks = jax.random.split(key, 20)
    f32 = jnp.float32
    nrm = lambda k, shape, s: jax.random.normal(k, shape, f32) * s
    gain = lambda k, shape: 1.0 + 0.01 * jax.random.normal(k, shape, f32)
    return {
        "x": nrm(ks[0], (BATCH, SEQ, D_MODEL), 1.0),
        "c": nrm(ks[1], (BATCH, D_MODEL), 1.0),
        "ctx": nrm(ks[2], (BATCH, CTX_LEN, D_MODEL), 1.0),
        "c_ctx": nrm(ks[3], (D_MODEL,), 1.0),
        "w_ada": nrm(ks[4], (DEPTH, D_MODEL, N_MOD * D_MODEL), D_MODEL ** -0.5),
        "b_ada": nrm(ks[5], (DEPTH, N_MOD * D_MODEL), 0.01),
        "norm1_w": gain(ks[6], (DEPTH, D_MODEL)),
        "w_in": nrm(ks[7], (DEPTH, D_MODEL, D_IN), D_MODEL ** -0.5),
        "rpb": nrm(ks[8], (DEPTH, NA_HEADS, 2 * NA_KH_MAX - 1, 2 * NA_KW - 1), 0.1),
        "sgu_norm_w": gain(ks[9], (DEPTH, D_SGU)),
        "sgu_w": nrm(ks[10], (DEPTH, SGU_GROUPS, SGU_CHUNK, SGU_CHUNK), SGU_CHUNK ** -0.5),
        "sgu_b": gain(ks[11], (DEPTH, SGU_GROUPS, SGU_CHUNK)),
        "grp_norm_na": gain(ks[12], (DEPTH, D_NA)),
        "grp_norm_sgu": gain(ks[13], (DEPTH, D_SGU)),
        "w_out": nrm(ks[14], (DEPTH, D_MODEL, D_MODEL), D_MODEL ** -0.5),
        "norm2_w": gain(ks[15], (DEPTH, D_MODEL)),
        "w_ff1": nrm(ks[16], (DEPTH, D_MODEL, D_FF), D_MODEL ** -0.5),
        "w_ff2": nrm(ks[17], (DEPTH, D_FF, D_MODEL), D_FF ** -0.5),
        "final_norm_w": gain(ks[18], (D_MODEL,)),
    }


def reference(x, c, ctx, c_ctx, w_ada, b_ada, norm1_w, w_in, rpb, sgu_norm_w, sgu_w, sgu_b,
              grp_norm_na, grp_norm_sgu, w_out, norm2_w, w_ff1, w_ff2, final_norm_w):
    for l in range(DEPTH):
        last = l == DEPTH - 1
        sh1, sc1, g1, sh2, sc2, g2 = adaln(c, w_ada[l], b_ada[l])
        csh1, csc1, cg1, csh2, csc2, cg2 = adaln(c_ctx, w_ada[l], b_ada[l])

        h = modulate(rmsnorm(x, norm1_w[l]), sh1, sc1)
        hc = modulate(rmsnorm(ctx, norm1_w[l]), csh1, csc1)
        q, k, v, u, gt = split_proj(h @ w_in[l])
        if last:
            kc, vc = jnp.split(hc @ w_in[l][:, D_NA:3 * D_NA], 2, axis=-1)
        else:
            qc, kc, vc, uc, gc = split_proj(hc @ w_in[l])
        kc_h, vc_h = to_heads(kc), to_heads(vc)
        o_na = neighbourhood_attention(to_heads(q), to_heads(k), to_heads(v), kc_h, vc_h, rpb[l])
        o_sgu = spatial_gating(jax.nn.gelu(u), jax.nn.gelu(gt), sgu_w[l], sgu_b[l], sgu_norm_w[l])
        x = x + g1 * merge_groups(o_na, o_sgu, grp_norm_na[l], grp_norm_sgu[l], w_out[l])

        h2 = modulate(rmsnorm(x, norm2_w[l]), sh2, sc2)
        x = x + g2 * squared_relu_mlp(h2, w_ff1[l], w_ff2[l])

        if not last:
            oc_na = context_attention(to_heads(qc), kc_h, vc_h)
            oc_sgu = spatial_gating(jax.nn.gelu(uc), jax.nn.gelu(gc), sgu_w[l], sgu_b[l], sgu_norm_w[l])
            ctx = ctx + cg1 * merge_groups(oc_na, oc_sgu, grp_norm_na[l], grp_norm_sgu[l], w_out[l])
            hc2 = modulate(rmsnorm(ctx, norm2_w[l]), csh2, csc2)
            ctx = ctx + cg2 * squared_relu_mlp(hc2, w_ff1[l], w_ff2[l])

    return rmsnorm(x, final_norm_w)
```

```cpp
#include <hip/hip_runtime.h>
#include <stdint.h>

constexpr int D = 4096, BATCH = 4, SEQ = 4096, GW = 64, CTX = 256;
constexpr int NH = 16, HD = 128, DNA = 2048, KH = 8, KW = 16;
constexpr int DSGU = 2048, SG = 4, SGD = 512, SCH = 128;
constexpr int DIN = 10240, DFF = 16384, NMOD = 6;
constexpr int M = BATCH * SEQ;
constexpr int MC = BATCH * CTX;
constexpr float EPS = 1e-6f;
constexpr size_t MiB = 1u << 20;

constexpr size_t WS_MOD = 0;
constexpr size_t WS_RG = 1 * MiB;
constexpr size_t WS_H = 16 * MiB;
constexpr size_t WS_PROJ = 288 * MiB;
constexpr size_t WS_KVC = 928 * MiB;
constexpr size_t WS_H2 = 944 * MiB;
constexpr size_t WS_END = 1200 * MiB;

__device__ __forceinline__ float gelu_tanh(float x) {
    const float u = 0.7978845608028654f * (x + 0.044715f * x * x * x);
    return 0.5f * x * (1.0f + tanhf(u));
}
__device__ __forceinline__ float block_sum(float v, float* red) {
    for (int o = 32; o >= 1; o >>= 1) v += __shfl_xor(v, o);
    const int w = threadIdx.x >> 6;
    __syncthreads();
    if ((threadIdx.x & 63) == 0) red[w] = v;
    __syncthreads();
    float s = 0.f;
    for (int i = 0; i < (int)(blockDim.x >> 6); ++i) s += red[i];
    return s;
}

__global__ void k_adaln(const float* c, const float* cctx, const float* w, const float* b, float* mod) {
    const int j = blockIdx.x * blockDim.x + threadIdx.x;
    __shared__ float s[5][256];
    float acc[5] = {0.f, 0.f, 0.f, 0.f, 0.f};
    for (int k0 = 0; k0 < D; k0 += 256) {
        __syncthreads();
        for (int r = 0; r < 5; ++r) { const float v = (r < 4) ? c[r * D + k0 + threadIdx.x] : cctx[k0 + threadIdx.x]; s[r][threadIdx.x] = v / (1.0f + expf(-v)); }
        __syncthreads();
        for (int kk = 0; kk < 256; ++kk) { const float wv = w[(size_t)(k0 + kk) * (NMOD * D) + j];
            for (int r = 0; r < 5; ++r) acc[r] += s[r][kk] * wv; }
    }
    for (int r = 0; r < 5; ++r) mod[r * (NMOD * D) + j] = acc[r] + b[j];
}

__global__ void k_rmsnorm_mod(const float* x, const float* w, const float* mod, int rows_per_batch, int mod_row_fixed, int shift_off, int scale_off, float* out, int ncols) {
    __shared__ float red[8];
    const int row = blockIdx.x; const float* xr = x + (size_t)row * ncols; float* o = out + (size_t)row * ncols;
    float ss = 0.f;
    for (int i = threadIdx.x; i < ncols; i += blockDim.x) { const float v = xr[i]; ss += v * v; }
    ss = block_sum(ss, red);
    const float rstd = rsqrtf(ss / (float)ncols + EPS);
    const int mr = mod_row_fixed >= 0 ? mod_row_fixed : row / rows_per_batch;
    for (int i = threadIdx.x; i < ncols; i += blockDim.x) {
        float v = xr[i] * rstd * w[i];
        if (mod) v = v * (1.0f + mod[mr * (NMOD * D) + scale_off + i]) + mod[mr * (NMOD * D) + shift_off + i];
        o[i] = v;
    }
}

template <int ACT>
__global__ void __launch_bounds__(256) k_sgemm(const float* __restrict__ A, int lda, const float* __restrict__ B, int ldb, float* __restrict__ C, int ldc, int K) {
    __shared__ float As[16][128 + 4];
    __shared__ float Bs[16][128 + 4];
    const int tid = threadIdx.x, tx = tid & 15, ty = tid >> 4;
    const int m0 = blockIdx.y * 128, n0 = blockIdx.x * 128;
    float acc[8][8];
#pragma unroll
    for (int i = 0; i < 8; ++i)
#pragma unroll
        for (int j = 0; j < 8; ++j) acc[i][j] = 0.f;
    const int ar = tid >> 1, ac = (tid & 1) * 8;
    const int br = tid >> 4, bc = (tid & 15) * 8;
    for (int k0 = 0; k0 < K; k0 += 16) {
        const float4 a0 = *(const float4*)(A + (size_t)(m0 + ar) * lda + k0 + ac), a1 = *(const float4*)(A + (size_t)(m0 + ar) * lda + k0 + ac + 4);
        const float4 b0 = *(const float4*)(B + (size_t)(k0 + br) * ldb + n0 + bc), b1 = *(const float4*)(B + (size_t)(k0 + br) * ldb + n0 + bc + 4);
        __syncthreads();
        As[ac + 0][ar] = a0.x; As[ac + 1][ar] = a0.y; As[ac + 2][ar] = a0.z; As[ac + 3][ar] = a0.w;
        As[ac + 4][ar] = a1.x; As[ac + 5][ar] = a1.y; As[ac + 6][ar] = a1.z; As[ac + 7][ar] = a1.w;
        *(float4*)&Bs[br][bc] = b0; *(float4*)&Bs[br][bc + 4] = b1;
        __syncthreads();
#pragma unroll
        for (int k = 0; k < 16; ++k) {
            float a[8], b[8];
            *(float4*)&a[0] = *(const float4*)&As[k][ty * 8]; *(float4*)&a[4] = *(const float4*)&As[k][ty * 8 + 4];
            *(float4*)&b[0] = *(const float4*)&Bs[k][tx * 8]; *(float4*)&b[4] = *(const float4*)&Bs[k][tx * 8 + 4];
#pragma unroll
            for (int i = 0; i < 8; ++i)
#pragma unroll
                for (int j = 0; j < 8; ++j) acc[i][j] += a[i] * b[j];
        }
    }
#pragma unroll
    for (int i = 0; i < 8; ++i) {
        float* cp = C + (size_t)(m0 + ty * 8 + i) * ldc + n0 + tx * 8;
        float o[8];
#pragma unroll
        for (int j = 0; j < 8; ++j) { float v = acc[i][j]; if (ACT == 2) { v = v > 0.f ? v : 0.f; v = v * v; } o[j] = v; }
        *(float4*)cp = *(float4*)&o[0]; *(float4*)(cp + 4) = *(float4*)&o[4];
    }
}

__global__ void __launch_bounds__(128) k_attn(const float* proj, const float* kvc, const float* rpb, float* merged) {
    const int h = blockIdx.x & 15, t = (blockIdx.x >> 4) & (SEQ - 1), b = blockIdx.x >> 16;
    const int r = t / GW, col = t % GW;
    int r0 = r - KH / 2; r0 = r0 < 0 ? 0 : (r0 > GW - KH ? GW - KH : r0);
    int cs = col - KW / 2; cs = cs < 0 ? 0 : (cs > GW - KW ? GW - KW : cs);
    __shared__ float qs[HD]; __shared__ float sc[128 + CTX]; __shared__ float red[8];
    const int tid = threadIdx.x;
    const float scale = 0.08838834764831845f;
    qs[tid] = proj[((size_t)b * SEQ + t) * DIN + h * HD + tid] * scale;
    __syncthreads();
    {
        const int i = tid >> 4, j = tid & 15; const int kt = (r0 + i) * GW + cs + j;
        const float* kp = proj + ((size_t)b * SEQ + kt) * DIN + DNA + h * HD;
        float s = 0.f; for (int d = 0; d < HD; ++d) s += qs[d] * kp[d];
        s += rpb[(h * (2 * KH - 1) + (r0 + i - r + KH - 1)) * (2 * KW - 1) + (cs + j - col + KW - 1)];
        sc[tid] = s;
    }
    for (int cc = tid; cc < CTX; cc += 128) {
        const float* kp = kvc + ((size_t)b * CTX + cc) * 4096 + h * HD;
        float s = 0.f; for (int d = 0; d < HD; ++d) s += qs[d] * kp[d];
        sc[128 + cc] = s;
    }
    __syncthreads();
    float mx = -1e30f; for (int i = tid; i < 128 + CTX; i += 128) mx = fmaxf(mx, sc[i]);
    for (int o = 32; o >= 1; o >>= 1) mx = fmaxf(mx, __shfl_xor(mx, o));
    if ((tid & 63) == 0) red[tid >> 6] = mx;
    __syncthreads();
    mx = fmaxf(red[0], red[1]);
    float sum = 0.f; for (int i = tid; i < 128 + CTX; i += 128) { const float e = expf(sc[i] - mx); sc[i] = e; sum += e; }
    for (int o = 32; o >= 1; o >>= 1) sum += __shfl_xor(sum, o);
    __syncthreads();
    if ((tid & 63) == 0) red[2 + (tid >> 6)] = sum;
    __syncthreads();
    const float inv = 1.0f / (red[2] + red[3]);
    float acc = 0.f;
    for (int i = 0; i < 128; ++i) { const int kt = (r0 + (i >> 4)) * GW + cs + (i & 15); acc += sc[i] * proj[((size_t)b * SEQ + kt) * DIN + 2 * DNA + h * HD + tid]; }
    for (int cc = 0; cc < CTX; ++cc) acc += sc[128 + cc] * kvc[((size_t)b * CTX + cc) * 4096 + DNA + h * HD + tid];
    merged[((size_t)b * SEQ + t) * D + h * HD + tid] = acc * inv;
}

__global__ void k_g_rstd(const float* proj, float* rg) {
    __shared__ float red[8];
    const float* g = proj + (size_t)blockIdx.x * DIN + 3 * DNA + DSGU;
    float ss = 0.f; for (int i = threadIdx.x; i < DSGU; i += blockDim.x) { const float v = gelu_tanh(g[i]); ss += v * v; }
    ss = block_sum(ss, red);
    if (threadIdx.x == 0) rg[blockIdx.x] = rsqrtf(ss / (float)DSGU + EPS);
}
__global__ void k_sgu(const float* proj, const float* rg, const float* sgu_norm_w, const float* sgu_w, const float* sgu_b, float* merged) {
    const int ch = blockIdx.x * blockDim.x + threadIdx.x;
    const int tok = blockIdx.y;
    const int g = ch / SGD, p = tok % SCH, tok0 = tok - p;
    const float nw = sgu_norm_w[ch];
    float acc = 0.f;
    for (int q = 0; q < SCH; ++q) {
        const float gv = gelu_tanh(proj[(size_t)(tok0 + q) * DIN + 3 * DNA + DSGU + ch]) * rg[tok0 + q] * nw;
        acc += sgu_w[(g * SCH + p) * SCH + q] * gv;
    }
    acc += sgu_b[g * SCH + p];
    merged[(size_t)tok * D + DNA + ch] = gelu_tanh(proj[(size_t)tok * DIN + 3 * DNA + ch]) * acc;
}
__global__ void k_grpnorm(float* merged, const float* gna, const float* gsgu) {
    __shared__ float red[8];
    float* row = merged + (size_t)blockIdx.x * D;
    for (int half = 0; half < 2; ++half) {
        float* p = row + half * 2048; const float* w = half ? gsgu : gna;
        float ss = 0.f; for (int i = threadIdx.x; i < 2048; i += blockDim.x) { const float v = p[i]; ss += v * v; }
        ss = block_sum(ss, red);
        const float rstd = rsqrtf(ss / 2048.0f + EPS);
        for (int i = threadIdx.x; i < 2048; i += blockDim.x) p[i] = p[i] * rstd * w[i];
    }
}
__global__ void k_gated_res(const float* base, const float* y, const float* mod, int gate_off, float* out) {
    const size_t idx = (size_t)blockIdx.x * blockDim.x + threadIdx.x;
    const size_t e = idx * 4; const int row = (int)(e / D), i = (int)(e % D), b = row / SEQ;
    const float4 bv = *(const float4*)(base + e), yv = *(const float4*)(y + e), gv = *(const float4*)(mod + b * (NMOD * D) + gate_off + i);
    float4 o; o.x = bv.x + gv.x * yv.x; o.y = bv.y + gv.y * yv.y; o.z = bv.z + gv.z * yv.z; o.w = bv.w + gv.w * yv.w;
    *(float4*)(out + e) = o;
}

extern "C" void kernel_launch(void* const* d_in, const int* in_sizes, int n_in, void* d_out, int out_size, void* d_ws, size_t ws_size, hipStream_t stream) {
    if (n_in != 19 || ws_size < WS_END || out_size != M * D) return;
    const float* x = (const float*)d_in[0]; const float* c = (const float*)d_in[1]; const float* ctx = (const float*)d_in[2]; const float* cctx = (const float*)d_in[3];
    const float* w_ada = (const float*)d_in[4]; const float* b_ada = (const float*)d_in[5]; const float* norm1_w = (const float*)d_in[6]; const float* w_in = (const float*)d_in[7];
    const float* rpb = (const float*)d_in[8]; const float* sgu_norm_w = (const float*)d_in[9]; const float* sgu_w = (const float*)d_in[10]; const float* sgu_b = (const float*)d_in[11];
    const float* gna = (const float*)d_in[12]; const float* gsgu = (const float*)d_in[13]; const float* w_out = (const float*)d_in[14]; const float* norm2_w = (const float*)d_in[15];
    const float* w_ff1 = (const float*)d_in[16]; const float* w_ff2 = (const float*)d_in[17]; const float* fnw = (const float*)d_in[18];
    char* ws = (char*)d_ws; float* out = (float*)d_out;
    float* mod = (float*)(ws + WS_MOD); float* rg = (float*)(ws + WS_RG); float* H = (float*)(ws + WS_H); float* PROJ = (float*)(ws + WS_PROJ);
    float* KVC = (float*)(ws + WS_KVC); float* H2 = (float*)(ws + WS_H2); float* MERGED = H; float* HID = PROJ; float* Y2 = (float*)(ws + WS_PROJ + 256 * MiB);

    k_adaln<<<NMOD * D / 256, 256, 0, stream>>>(c, cctx, w_ada, b_ada, mod);
    k_rmsnorm_mod<<<M, 256, 0, stream>>>(x, norm1_w, mod, SEQ, -1, 0, D, H, D);
    k_rmsnorm_mod<<<MC, 256, 0, stream>>>(ctx, norm1_w, mod, CTX, 4, 0, D, H + (size_t)M * D, D);
    k_sgemm<0><<<dim3(DIN / 128, M / 128), 256, 0, stream>>>(H, D, w_in, DIN, PROJ, DIN, D);
    k_sgemm<0><<<dim3(4096 / 128, MC / 128), 256, 0, stream>>>(H + (size_t)M * D, D, w_in + DNA, DIN, KVC, 4096, D);
    k_attn<<<BATCH * SEQ * NH, 128, 0, stream>>>(PROJ, KVC, rpb, MERGED);
    k_g_rstd<<<M, 256, 0, stream>>>(PROJ, rg);
    k_sgu<<<dim3(DSGU / 256, M), 256, 0, stream>>>(PROJ, rg, sgu_norm_w, sgu_w, sgu_b, MERGED);
    k_grpnorm<<<M, 256, 0, stream>>>(MERGED, gna, gsgu);
    k_sgemm<0><<<dim3(D / 128, M / 128), 256, 0, stream>>>(MERGED, D, w_out, D, Y2, D, D);
    k_gated_res<<<(size_t)M * D / 4 / 256, 256, 0, stream>>>(x, Y2, mod, 2 * D, out);
    k_rmsnorm_mod<<<M, 256, 0, stream>>>(out, norm2_w, mod, SEQ, -1, 3 * D, 4 * D, H2, D);
    for (int ch = 0; ch < 4; ++ch) {
        k_sgemm<2><<<dim3(DFF / 128, 4096 / 128), 256, 0, stream>>>(H2 + (size_t)ch * 4096 * D, D, w_ff1, DFF, HID, DFF, D);
        k_sgemm<0><<<dim3(D / 128, 4096 / 128), 256, 0, stream>>>(HID, DFF, w_ff2, D, Y2 + (size_t)ch * 4096 * D, D, DFF);
    }
    k_gated_res<<<(size_t)M * D / 4 / 256, 256, 0, stream>>>(out, Y2, mod, 5 * D, out);
    k_rmsnorm_mod<<<M, 256, 0, stream>>>(out, fnw, nullptr, SEQ, -1, 0, 0, out, D);
}
```

```cpp
#include <hip/hip_runtime.h>
#include <cstdio>
#include <cstdint>
namespace pg8 {
#define PG8_LAS __attribute__((address_space(3)))
typedef unsigned short bf16_t;
typedef short bf16x8 __attribute__((ext_vector_type(8)));
typedef float f32x4 __attribute__((ext_vector_type(4)));
typedef unsigned u32x4 __attribute__((ext_vector_type(4)));
constexpr int BM = 256, BK = 64, HALF = 128, HTB = HALF * BK * 2  , STAGE_BYTES = 8 * HTB, NXCD = 8, WGM = 8;

__host__ __device__ __forceinline__ int lds_byte(int r, int c) { const int st = (r >> 4) * 2 + (c >> 5), rr = r & 15, cc = c & 31, ob = rr * 64 + cc * 2; return st * 1024 + (ob ^ (((ob >> 9) & 1) << 5)); }
__host__ __device__ __forceinline__ void stage_rc(int b, int& R, int& C) { const int st = b / 1024, sb = b % 1024, swz = sb ^ (((sb >> 9) & 1) << 5); R = (st >> 1) * 16 + swz / 64; C = (st & 1) * 32 + (swz % 64) / 2; }
__host__ __device__ __forceinline__ int perm32(int rho) { const int n = rho >> 4, i = rho & 15; return 8 * (i >> 2) + 4 * n + (i & 3); }

struct Unit { int pm, pn; };
struct Gemm { const bf16_t* A; const bf16_t* Bt; int M, N, K; };

__device__ __forceinline__ void std_map(int wgid, int nM, int nN, Unit& u) {
    const int nwg = nM * nN;
    { const int q = nwg / NXCD, r = nwg % NXCD, xcd = wgid % NXCD, off = wgid / NXCD; wgid = (xcd < r ? xcd * (q + 1) : r * (q + 1) + (xcd - r) * q) + off; }
    const int nig = WGM * nN, gid = wgid / nig, fm = gid * WGM, gsz = (nM - fm) < WGM ? (nM - fm) : WGM;
    u.pm = fm + ((wgid % nig) % gsz); u.pn = (wgid % nig) / gsz;
}
struct StdOrder {
    int nM, nN, nwg, G, c;
    __device__ void init(int M, int N, int G_, int c_) { nM = M / BM; nN = N / BM; nwg = nM * nN; G = G_; c = c_; }
    __device__ bool next(int i, Unit& u) const { const long L = (long)i * G + c; if (L >= nwg) return false; std_map((int)L, nM, nN, u); return true; }
    __device__ __forceinline__ void bases(const Unit& u, const Gemm& g, size_t tstep, const char*& a, const char*& b) const { a = (const char*)g.A + (size_t)u.pm * tstep; b = (const char*)g.Bt + (size_t)u.pn * tstep; }
    __device__ __forceinline__ void a_ready(const Unit&) const {}
    __device__ __forceinline__ void done(const Unit&) const {}
};
struct InProjOrder {
    int G, c;
    __device__ bool next(int i, Unit& u) const {
        const long L = (long)i * G + c;
        if (L < 2560) { std_map((int)L, 64, 40, u); return true; }
        if (L < 2624) { const int j = (int)L - 2560; u.pm = 64 + (j >> 4); u.pn = 8 + (j & 15); return true; }
        return false;
    }
    __device__ __forceinline__ void bases(const Unit& u, const Gemm& g, size_t tstep, const char*& a, const char*& b) const {
        const int ty = u.pn >> 3; const bool sw = (ty == 2) || (ty == 4);
        const char* act = (const char*)g.A + (size_t)u.pm * tstep; const char* w = (const char*)g.Bt + (size_t)u.pn * tstep;
        a = sw ? w : act; b = sw ? act : w;
    }
    __device__ __forceinline__ void a_ready(const Unit&) const {}
    __device__ __forceinline__ void done(const Unit&) const {}
};

__device__ __forceinline__ unsigned cvt_pk_bf16(float lo, float hi) { unsigned r; asm volatile("v_cvt_pk_bf16_f32 %0, %1, %2" : "=v"(r) : "v"(lo), "v"(hi)); return r; }
__device__ __forceinline__ float gelu_t(float x) { const float u = x * (0.7978845608f + 0.0356774081f * x * x); const float t = __builtin_amdgcn_exp2f(-2.8853900818f * u); return x * __builtin_amdgcn_rcpf(1.0f + t); }

struct EpiInProj {
    static constexpr bool PERM = true, AFTER_DRAIN = false;
    bf16_t* base0; size_t slot; float qscale;
    __device__ __forceinline__ void operator()(const f32x4 (&acc)[2][2][4][2], const Unit& u, int wr, int wc, int fr, int fq) const {
        const int ty = u.pn >> 3, sub = (u.pn & 7) * BM, tokb = u.pm * BM;
        bf16_t* base = base0 + (size_t)ty * slot; const bool sw = (ty == 2) || (ty == 4);
        const int ldc = (ty == 2) ? 17408 : ((ty == 4) ? 16384 : 2048), rb = sw ? sub : tokb, cb = sw ? tokb : sub;
        const float sc = (ty == 0) ? qscale : 1.f; const bool act = ty >= 3;
        const int row0 = rb + wr * 64 + fr, col0 = cb + wc * 32 + 8 * fq;
#pragma unroll
        for (int ai = 0; ai < 2; ++ai)
#pragma unroll
            for (int m = 0; m < 4; ++m) { bf16_t* rowp = base + (size_t)(row0 + ai * HALF + m * 16) * ldc + col0;
#pragma unroll
                for (int bj = 0; bj < 2; ++bj) { f32x4 v0 = acc[ai][bj][m][0] * sc, v1 = acc[ai][bj][m][1] * sc;
                    if (act) {
#pragma unroll
                        for (int j = 0; j < 4; ++j) { v0[j] = gelu_t(v0[j]); v1[j] = gelu_t(v1[j]); } }
                    u32x4 w; w.x = cvt_pk_bf16(v0[0], v0[1]); w.y = cvt_pk_bf16(v0[2], v0[3]); w.z = cvt_pk_bf16(v1[0], v1[1]); w.w = cvt_pk_bf16(v1[2], v1[3]);
                    *(u32x4*)(rowp + bj * HALF) = w; } }
    }
};
struct EpiRelu2 {
    static constexpr bool PERM = true, AFTER_DRAIN = false;
    bf16_t* O; int ldc;
    __device__ __forceinline__ void operator()(const f32x4 (&acc)[2][2][4][2], const Unit& u, int wr, int wc, int fr, int fq) const {
        const int row0 = u.pm * BM + wr * 64 + fr, col0 = u.pn * BM + wc * 32 + 8 * fq;
#pragma unroll
        for (int ai = 0; ai < 2; ++ai)
#pragma unroll
            for (int m = 0; m < 4; ++m) { bf16_t* rowp = O + (size_t)(row0 + ai * HALF + m * 16) * ldc + col0;
#pragma unroll
                for (int bj = 0; bj < 2; ++bj) { f32x4 v0 = acc[ai][bj][m][0], v1 = acc[ai][bj][m][1];
#pragma unroll
                    for (int j = 0; j < 4; ++j) { const float a = fmaxf(v0[j], 0.f), b = fmaxf(v1[j], 0.f); v0[j] = a * a; v1[j] = b * b; }
                    u32x4 w; w.x = cvt_pk_bf16(v0[0], v0[1]); w.y = cvt_pk_bf16(v0[2], v0[3]); w.z = cvt_pk_bf16(v1[0], v1[1]); w.w = cvt_pk_bf16(v1[2], v1[3]);
                    *(u32x4*)(rowp + bj * HALF) = w; } }
    }
};
struct EpiGatedRes {
    static constexpr bool PERM = false, AFTER_DRAIN = false;
    const float* base; float* out; int ldc; const float* gate; int gate_pitch;
    __device__ __forceinline__ void operator()(const f32x4 (&acc)[2][2][4][2], const Unit& u, int wr, int wc, int fr, int fq) const {
        const int row0 = u.pm * BM + wr * 64 + fr, col0 = u.pn * BM + wc * 32 + 4 * fq;
        const float* gp = gate + (size_t)(u.pm >> 4) * gate_pitch + col0;
        f32x4 gv[2][2];
#pragma unroll
        for (int bj = 0; bj < 2; ++bj)
#pragma unroll
            for (int n = 0; n < 2; ++n) gv[bj][n] = *(const f32x4*)(gp + bj * HALF + n * 16);
#pragma unroll
        for (int ai = 0; ai < 2; ++ai)
#pragma unroll
            for (int m = 0; m < 4; ++m) { const size_t off = (size_t)(row0 + ai * HALF + m * 16) * ldc + col0;
#pragma unroll
                for (int bj = 0; bj < 2; ++bj)
#pragma unroll
                    for (int n = 0; n < 2; ++n) { const f32x4 bs = *(const f32x4*)(base + off + bj * HALF + n * 16); *(f32x4*)(out + off + bj * HALF + n * 16) = bs + gv[bj][n] * acc[ai][bj][m][n]; }
                asm volatile("" ::: "memory"); }
    }
};

template <class Epi, class Sched, bool ALIGN_EPI = false, bool SP2 = false>
__device__ __forceinline__ void gemm_phase(PG8_LAS unsigned char* lds, const Gemm g, const Sched& S, const Epi& E) {
    const int tid = threadIdx.x, wid = __builtin_amdgcn_readfirstlane(tid >> 6), lane = tid & 63, wr = wid >> 2, wc = wid & 3, fr = lane & 15, fq = lane >> 4;
    const int K = g.K, nt = K / BK;
    unsigned voffA[2], voffB[2];
#pragma unroll
    for (int i = 0; i < 2; ++i) { int R, C; stage_rc(tid * 16 + i * 8192, R, C); const int Rb = Epi::PERM ? ((R & ~31) + perm32(R & 31)) : R;
        voffA[i] = (unsigned)(R * K + C) * 2u; voffB[i] = (unsigned)(Rb * K + C) * 2u; }
    const size_t kstep = (size_t)(BK * 2);
    const size_t hstep = (size_t)HALF * K * 2;
    const size_t tstep = 2 * hstep;
    const unsigned ldsw = (unsigned)wid * 1024u;
    const int aoff = lds_byte(wr * 64 + fr, fq * 8), boff = lds_byte(wc * 32 + fr, fq * 8);
#define PG8_SA(b, h) (((b) * 2 + (h)) * HTB)
#define PG8_SB(b, h) ((4 + (b) * 2 + (h)) * HTB)
#define PG8_STAGE(bufoff, gbase, voff) do { _Pragma("unroll") for (int _i = 0; _i < 2; ++_i) \
        __builtin_amdgcn_global_load_lds((const unsigned*)((const char*)(gbase) + (voff)[_i]), (PG8_LAS unsigned*)(lds + (bufoff) + ldsw + _i * 8192), 16, 0, 0); } while (0)
#define PG8_LDA(dst, b, h) do { _Pragma("unroll") for (int m = 0; m < 4; ++m) _Pragma("unroll") for (int k = 0; k < 2; ++k) dst[m][k] = *(const PG8_LAS bf16x8*)(lds + PG8_SA(b, h) + aoff + m * 2048 + k * 1024); } while (0)
#define PG8_LDB(dst, b, h) do { _Pragma("unroll") for (int n = 0; n < 2; ++n) _Pragma("unroll") for (int k = 0; k < 2; ++k) dst[n][k] = *(const PG8_LAS bf16x8*)(lds + PG8_SB(b, h) + boff + n * 2048 + k * 1024); } while (0)
#define PG8_MMA(ai, bj, At, Bt) do { __builtin_amdgcn_s_setprio(1); _Pragma("unroll") for (int m = 0; m < 4; ++m) _Pragma("unroll") for (int n = 0; n < 2; ++n) _Pragma("unroll") for (int k = 0; k < 2; ++k) \
        acc[ai][bj][m][n] = __builtin_amdgcn_mfma_f32_16x16x32_bf16(Bt[n][k], At[m][k], acc[ai][bj][m][n], 0, 0, 0); __builtin_amdgcn_s_setprio(0); } while (0)
#define PG8_WAIT_V(n) asm volatile("s_waitcnt vmcnt(" #n ")" ::: "memory")
#define PG8_WAIT_L(n) asm volatile("s_waitcnt lgkmcnt(" #n ")" ::: "memory")
#define PG8_BAR __builtin_amdgcn_s_barrier()
#define PG8_SCHED __builtin_amdgcn_sched_barrier(0)
    Unit cur, nxt; int ui = 0;
    if (!S.next(0, cur)) return;
    f32x4 acc[2][2][4][2];
#pragma unroll
    for (int a = 0; a < 2; ++a)
#pragma unroll
        for (int b = 0; b < 2; ++b)
#pragma unroll
            for (int m = 0; m < 4; ++m)
#pragma unroll
                for (int n = 0; n < 2; ++n) acc[a][b][m][n] = (f32x4){0.f, 0.f, 0.f, 0.f};
    bf16x8 At[4][2], B0[2][2], B1[2][2];
    const char* cA; const char* cB; S.bases(cur, g, tstep, cA, cB);
    S.a_ready(cur);
    if constexpr (SP2) {
        PG8_STAGE(PG8_SB(0, 0), cB, voffB); PG8_STAGE(PG8_SB(0, 1), cB + hstep, voffB); PG8_STAGE(PG8_SA(0, 0), cA, voffA); PG8_STAGE(PG8_SA(0, 1), cA + hstep, voffA);
        if (wr == 1) PG8_BAR;
        PG8_WAIT_V(2); PG8_BAR;
        PG8_STAGE(PG8_SB(1, 0), cB + kstep, voffB); PG8_STAGE(PG8_SA(1, 0), cA + kstep, voffA); PG8_STAGE(PG8_SB(1, 1), cB + hstep + kstep, voffB);
        PG8_WAIT_V(6); PG8_BAR;
    } else {
        PG8_STAGE(PG8_SB(0, 0), cB, voffB); PG8_STAGE(PG8_SA(0, 0), cA, voffA); PG8_STAGE(PG8_SB(0, 1), cB + hstep, voffB); PG8_STAGE(PG8_SA(0, 1), cA + hstep, voffA);
        if (wr == 1) PG8_BAR;
        PG8_WAIT_V(4); PG8_BAR;
        PG8_STAGE(PG8_SB(1, 0), cB + kstep, voffB); PG8_STAGE(PG8_SA(1, 0), cA + kstep, voffA); PG8_STAGE(PG8_SB(1, 1), cB + hstep + kstep, voffB);
        PG8_WAIT_V(6); PG8_BAR;
    }
    for (;;) {
        const bool has_next = S.next(ui + 1, nxt);
        const char* nA = cA; const char* nB = cB; if (has_next) S.bases(nxt, g, tstep, nA, nB);
        for (int t = 0; t < nt; t += 2) {
            const bool last = (t == nt - 2);
            const char* a1 = cA + (size_t)(t + 1) * kstep;
            const char* a2 = last ? nA : cA + (size_t)(t + 2) * kstep; const char* b2 = last ? nB : cB + (size_t)(t + 2) * kstep;
            const char* a3 = a2 + kstep; const char* b3 = b2 + kstep;
            if (last && has_next) S.a_ready(nxt);
            if constexpr (SP2) {
            PG8_LDB(B0, 0, 0); PG8_LDB(B1, 0, 1); PG8_SCHED; PG8_LDA(At, 0, 0); PG8_STAGE(PG8_SA(1, 1), a1 + hstep, voffA);
            PG8_WAIT_V(8); PG8_WAIT_L(0); PG8_BAR; PG8_MMA(0, 0, At, B0); PG8_MMA(0, 1, At, B1); PG8_BAR; PG8_SCHED;
            PG8_LDA(At, 0, 1); PG8_STAGE(PG8_SB(0, 0), b2, voffB); PG8_STAGE(PG8_SB(0, 1), b2 + hstep, voffB); PG8_STAGE(PG8_SA(0, 0), a2, voffA);
            PG8_WAIT_V(8); PG8_WAIT_L(0); PG8_BAR; PG8_MMA(1, 0, At, B0); PG8_MMA(1, 1, At, B1); PG8_BAR; PG8_SCHED;
            PG8_LDB(B0, 1, 0); PG8_LDB(B1, 1, 1); PG8_SCHED; PG8_LDA(At, 1, 0); PG8_STAGE(PG8_SA(0, 1), a2 + hstep, voffA);
            PG8_WAIT_V(8); PG8_WAIT_L(0); PG8_BAR; PG8_MMA(0, 0, At, B0); PG8_MMA(0, 1, At, B1); PG8_BAR; PG8_SCHED;
            PG8_LDA(At, 1, 1); PG8_STAGE(PG8_SB(1, 0), b3, voffB); PG8_STAGE(PG8_SB(1, 1), b3 + hstep, voffB); PG8_STAGE(PG8_SA(1, 0), a3, voffA);
            PG8_WAIT_V(8); PG8_WAIT_L(0); PG8_BAR; PG8_MMA(1, 0, At, B0); PG8_MMA(1, 1, At, B1); PG8_BAR; PG8_SCHED;
            } else {
            PG8_LDB(B0, 0, 0); PG8_SCHED; PG8_LDA(At, 0, 0); PG8_STAGE(PG8_SA(1, 1), a1 + hstep, voffA);
            PG8_WAIT_L(8); PG8_BAR; PG8_WAIT_L(0); PG8_MMA(0, 0, At, B0); PG8_BAR; PG8_SCHED;
            PG8_LDB(B1, 0, 1); PG8_STAGE(PG8_SB(0, 0), b2, voffB);
            PG8_BAR; PG8_WAIT_L(0); PG8_MMA(0, 1, At, B1); PG8_BAR;
            PG8_LDA(At, 0, 1); PG8_STAGE(PG8_SA(0, 0), a2, voffA);
            PG8_BAR; PG8_WAIT_L(0); PG8_MMA(1, 0, At, B0); PG8_BAR; PG8_SCHED;
            PG8_STAGE(PG8_SB(0, 1), b2 + hstep, voffB);
            PG8_WAIT_V(6); PG8_BAR; PG8_MMA(1, 1, At, B1); PG8_BAR;
            PG8_LDB(B0, 1, 0); PG8_SCHED; PG8_LDA(At, 1, 0); PG8_STAGE(PG8_SA(0, 1), a2 + hstep, voffA);
            PG8_WAIT_L(8); PG8_BAR; PG8_WAIT_L(0); PG8_MMA(0, 0, At, B0); PG8_BAR; PG8_SCHED;
            PG8_LDB(B1, 1, 1); PG8_STAGE(PG8_SB(1, 0), b3, voffB);
            PG8_BAR; PG8_WAIT_L(0); PG8_MMA(0, 1, At, B1); PG8_BAR;
            PG8_LDA(At, 1, 1); PG8_STAGE(PG8_SA(1, 0), a3, voffA);
            PG8_BAR; PG8_WAIT_L(0); PG8_MMA(1, 0, At, B0); PG8_BAR; PG8_SCHED;
            PG8_STAGE(PG8_SB(1, 1), b3 + hstep, voffB);
            PG8_WAIT_V(6); PG8_BAR; PG8_MMA(1, 1, At, B1); PG8_BAR;
            }
        }
        if constexpr (ALIGN_EPI) { if (wr == 0) PG8_BAR; }
        if constexpr (!Epi::AFTER_DRAIN) { E(acc, cur, wr, wc, fr, fq); S.done(cur); }
        if (!has_next) break;
#pragma unroll
        for (int a = 0; a < 2; ++a)
#pragma unroll
            for (int b = 0; b < 2; ++b)
#pragma unroll
                for (int m = 0; m < 4; ++m)
#pragma unroll
                    for (int n = 0; n < 2; ++n) acc[a][b][m][n] = (f32x4){0.f, 0.f, 0.f, 0.f};
        cur = nxt; cA = nA; cB = nB; ++ui;
        if constexpr (ALIGN_EPI) { if (wr == 1) PG8_BAR; }
    }
    PG8_WAIT_V(0);
    if constexpr (!ALIGN_EPI) { if (wr == 0) PG8_BAR; }
    PG8_BAR;
    if constexpr (Epi::AFTER_DRAIN) { E.fused(acc, cur, wr, wc, fr, fq, lds, wid, lane); S.done(cur); }
#undef PG8_SA
#undef PG8_SB
#undef PG8_STAGE
#undef PG8_LDA
#undef PG8_LDB
#undef PG8_MMA
#undef PG8_WAIT_V
#undef PG8_WAIT_L
#undef PG8_BAR
#undef PG8_SCHED
}
}

constexpr int NWAVES = 8;
#ifndef MK_N_LAUNCHES
#define MK_N_LAUNCHES 1
#endif
constexpr int N_PHASES = 10;
constexpr int D = 4096, BATCH = 4, SEQ = 4096, GW = 64, CTX = 256;
constexpr int NH = 16, HD = 128, DNA = 2048, DSGU = 2048, DIN = 10240, DFF = 16384, NMODC = 6 * D;
constexpr int M = BATCH * SEQ, MC = BATCH * CTX, MA = M + MC;
constexpr float EPS = 1e-6f;
constexpr float LOG2E = 1.4426950408889634f;
constexpr int ADA_KS = 16, ADA_STRIPS = NMODC / 256;

constexpr size_t MiB = 1u << 20;
constexpr size_t WS_CTL = 0, CTL_ZERO_BYTES = 1 * MiB;
constexpr size_t WS_MODF = 1 * MiB;
constexpr size_t WS_PART = 2 * MiB;
constexpr size_t WS_SSNA = 10 * MiB;
constexpr size_t WS_SSSG = 11 * MiB;
constexpr size_t WS_WIN = 16 * MiB;
constexpr size_t WS_WOUT = 96 * MiB;
constexpr size_t WS_WFF1 = 128 * MiB;
constexpr size_t WS_WFF2 = 256 * MiB;
constexpr size_t WS_A1 = 384 * MiB;
constexpr size_t WS_SLOT = 68 * MiB;
constexpr size_t WS_Q = 520 * MiB;
constexpr size_t WS_K = WS_Q + 1 * WS_SLOT;
constexpr size_t WS_VT = WS_Q + 2 * WS_SLOT;
constexpr size_t WS_U = WS_Q + 3 * WS_SLOT;
constexpr size_t WS_GT = WS_Q + 4 * WS_SLOT;
constexpr size_t WS_A2 = WS_Q + 5 * WS_SLOT;
constexpr size_t WS_H = 520 * MiB;
constexpr size_t WS_END = 1032 * MiB;
static_assert(WS_A1 + (size_t)MA * D * 2 <= WS_Q && WS_K + (size_t)MA * DNA * 2 <= WS_VT && WS_VT + (size_t)DNA * MA * 2 <= WS_U && WS_GT + (size_t)DSGU * M * 2 <= WS_A2 && WS_A2 + (size_t)M * D * 2 <= WS_END && WS_H + (size_t)M * DFF * 2 <= WS_END, "d_ws map");
constexpr int CW_BAR = 4096;

constexpr int RING_OFF = 0, RING_BYTES = 131072;
constexpr int LDSCTL_OFF = RING_BYTES, MISC_OFF = LDSCTL_OFF + 320;
constexpr int LDS_BYTES = 147456;

#define GAS __attribute__((address_space(1)))
#define LAS __attribute__((address_space(3)))
typedef unsigned short bf16;
typedef unsigned v4u __attribute__((ext_vector_type(4)));
typedef unsigned v2u __attribute__((ext_vector_type(2)));
typedef float f32x4 __attribute__((ext_vector_type(4)));
typedef short bf16x8 __attribute__((ext_vector_type(8)));
typedef GAS unsigned gu32;
#define RLX_AGENT __ATOMIC_RELAXED, __HIP_MEMORY_SCOPE_AGENT
#define LDS_WAIT() asm volatile("s_waitcnt lgkmcnt(0)" ::: "memory")
#define VM_WAIT() asm volatile("s_waitcnt vmcnt(0)" ::: "memory")
__device__ __forceinline__ unsigned pk2(float lo, float hi) { return pg8::cvt_pk_bf16(lo, hi); }
__device__ __forceinline__ float bf_lo(unsigned w) { return __builtin_bit_cast(float, w << 16); }
__device__ __forceinline__ float bf_hi(unsigned w) { return __builtin_bit_cast(float, w & 0xffff0000u); }

#define XB_TMO      128
#define XB_XCNT(j)  (256  + 64 * (j))
#define XB_XSUB(j)  (1280 + 64 * (j))
#define XB_XGEN(j)  (2304 + 64 * (j))
#define XB_TOP      3328
#define XB_TOPGEN   3392
#define XCD_BAR_WORDS 3456
#define XB_SPIN_CAP (1u << 18)

__device__ __forceinline__ unsigned xb_ld(unsigned* p)              { return __hip_atomic_load(p, __ATOMIC_RELAXED, __HIP_MEMORY_SCOPE_AGENT); }
__device__ __forceinline__ unsigned xb_add(unsigned* p, unsigned v) { return __hip_atomic_fetch_add(p, v, __ATOMIC_RELAXED, __HIP_MEMORY_SCOPE_AGENT); }
__device__ __forceinline__ unsigned xb_xcc_id() { return (unsigned)__builtin_amdgcn_s_getreg((3 << 11) | 20) & 0xFu; }
#define XB_SPIN(cond, bar) do { unsigned _sp = 0; while (cond) { __builtin_amdgcn_s_sleep(1); \
    if ((++_sp & 255u) == 0u) { if (xb_ld(&(bar)[XB_TMO])) break; if (_sp > XB_SPIN_CAP) { atomicAdd(&(bar)[XB_TMO], 1u); break; } } } } while (0)

struct XcdBarrier {
    unsigned* bar; unsigned x;
    volatile LAS unsigned* st;
};

__device__ __forceinline__ XcdBarrier xcd_barrier_post(unsigned* bar, volatile LAS unsigned* st) {
    XcdBarrier b; b.bar = bar; b.x = xb_xcc_id(); b.st = st;
    if (threadIdx.x == 0) (void)xb_add(&bar[XB_XCNT(b.x)], 1u);
    return b;
}
__device__ __forceinline__ void xcd_barrier_complete(unsigned* bar, unsigned x, unsigned& nloc, unsigned& nx) {
    const unsigned G = gridDim.x * gridDim.y * gridDim.z;
    unsigned sum, cnt, mine, sp = 0u;
    for (;;) {
        sum = 0u; cnt = 0u; mine = 0u;
#pragma unroll
        for (unsigned j = 0; j < 16; ++j) { const unsigned c = xb_ld(&bar[XB_XCNT(j)]); sum += c; cnt += (c > 0u) ? 1u : 0u; mine = (j == x) ? c : mine; }
        if (sum == G) break;
        __builtin_amdgcn_s_sleep(1);
        if ((++sp & 255u) == 0u) { if (xb_ld(&bar[XB_TMO])) break; if (sp > XB_SPIN_CAP) { atomicAdd(&bar[XB_TMO], 1u); break; } }
    }
    nloc = mine > 0u ? mine : 1u; nx = cnt > 0u ? cnt : 1u;
}

__device__ __forceinline__ void xcd_barrier(const XcdBarrier& b) {
    asm volatile("s_waitcnt vmcnt(0)" ::: "memory");
    __syncthreads();
    if (threadIdx.x == 0) {
        unsigned* bar = b.bar;
        __builtin_amdgcn_s_waitcnt(0);
        unsigned nloc = b.st[0], nx = b.st[1];
        if (nloc == 0u) { xcd_barrier_complete(bar, b.x, nloc, nx); b.st[0] = nloc; b.st[1] = nx; }
        const unsigned old = xb_add(&bar[XB_XSUB(b.x)], 1u);
        const unsigned gen = old / nloc;
        if (old + 1u == (gen + 1u) * nloc) {
            __builtin_amdgcn_fence(__ATOMIC_RELEASE, "agent");
            asm volatile("s_waitcnt vmcnt(0)" ::: "memory");
            const unsigned og = xb_add(&bar[XB_TOP], 1u);
            const unsigned tg = og / nx;
            if (og + 1u == (tg + 1u) * nx) xb_add(&bar[XB_TOPGEN], 1u);
            else XB_SPIN(xb_ld(&bar[XB_TOPGEN]) == tg, bar);
            __builtin_amdgcn_fence(__ATOMIC_ACQUIRE, "agent");
            xb_add(&bar[XB_XGEN(b.x)], 1u);
            asm volatile("s_waitcnt vmcnt(0)" ::: "memory");
        } else {
            XB_SPIN(xb_ld(&bar[XB_XGEN(b.x)]) == gen, bar);
            __builtin_amdgcn_fence(__ATOMIC_ACQUIRE, "agent");
            asm volatile("s_waitcnt vmcnt(0)" ::: "memory");
        }
    }
    __syncthreads();
}

struct Frame {
    LAS unsigned char* lds;
    volatile LAS unsigned* MISC;
    gu32* ctl;
    int tid, lane, wave, G;
    const float *x, *c, *ctx, *cctx, *w_ada, *b_ada, *norm1_w, *w_in, *rpb, *sgu_norm_w, *sgu_w, *sgu_b, *gna, *gsgu, *w_out, *norm2_w, *w_ff1, *w_ff2, *fnw;
    float* out;
    float *modf, *part, *ssna, *sssg;
    bf16 *Wt_in, *Wt_out, *Wt_ff1, *Wt_ff2, *A1, *QB, *KB, *VT, *UB, *GT, *A2, *HB;
};
__device__ __forceinline__ float wave_sum(float v) {
#pragma unroll
    for (int o = 1; o < 64; o <<= 1) v += __shfl_xor(v, o);
    return v;
}
__device__ __forceinline__ void p0_transpose_item(const float* W, int K, int N, bf16* WT, const float* gA, const float* gB, LAS float* scr, int item, int lane) {
    const int nblk = N / 32, kb = item / nblk, nb = item % nblk, k0 = 64 * kb, n0 = 32 * nb;
    const float* kg = gA ? (k0 < 2048 ? gA + k0 : gB + (k0 - 2048)) : nullptr;
#pragma unroll 8
    for (int i = 0; i < 32; ++i) { const int kk = 2 * i + (lane >> 5); float v = W[(size_t)(k0 + kk) * N + n0 + (lane & 31)]; if (kg) v *= kg[kk]; scr[kk * 33 + (lane & 31)] = v; }
    LDS_WAIT(); asm volatile("" ::: "memory");
    const int c = lane & 7;
#pragma unroll
    for (int j = 0; j < 4; ++j) { const int n = (lane >> 3) + 8 * j; const LAS float* s = scr + (8 * c) * 33 + n;
        v4u o; o.x = pk2(s[0 * 33], s[1 * 33]); o.y = pk2(s[2 * 33], s[3 * 33]); o.z = pk2(s[4 * 33], s[5 * 33]); o.w = pk2(s[6 * 33], s[7 * 33]);
        *(GAS v4u*)(WT + (size_t)(n0 + n) * K + k0 + 8 * c) = o; }
    LDS_WAIT(); asm volatile("" ::: "memory");
}
__device__ __forceinline__ float silu_f(float v) { return v / (1.0f + __expf(-v)); }
__device__ __forceinline__ void p0_ada_item(Frame& F, int item, LAS float* sil) {
    const int s = item % ADA_STRIPS, ks = item / ADA_STRIPS, k0 = ks * 256, lane = F.lane;
#pragma unroll
    for (int r = 0; r < 5; ++r) { const float* src = (r < 4) ? F.c + r * D : F.cctx; const f32x4 v = *(const f32x4*)(src + k0 + 4 * lane);
        f32x4 o; o.x = silu_f(v.x); o.y = silu_f(v.y); o.z = silu_f(v.z); o.w = silu_f(v.w); *(LAS f32x4*)(sil + r * 256 + 4 * lane) = o; }
    LDS_WAIT(); asm volatile("" ::: "memory");
    f32x4 acc[5];
#pragma unroll
    for (int r = 0; r < 5; ++r) acc[r] = (f32x4){0.f, 0.f, 0.f, 0.f};
    const float* wp = F.w_ada + (size_t)k0 * NMODC + 256 * s + 4 * lane;
#pragma unroll 8
    for (int kk = 0; kk < 256; ++kk) { const f32x4 w = *(const f32x4*)(wp + (size_t)kk * NMODC);
#pragma unroll
        for (int r = 0; r < 5; ++r) acc[r] += w * sil[r * 256 + kk]; }
#pragma unroll
    for (int r = 0; r < 5; ++r) *(f32x4*)(F.part + (size_t)(ks * 5 + r) * NMODC + 256 * s + 4 * lane) = acc[r];
    LDS_WAIT(); asm volatile("" ::: "memory");
}
__device__ __forceinline__ void p0_prologue(Frame& F) {
    LAS float* scr = (LAS float*)(F.lds + RING_OFF + F.wave * 16384);
    LAS float* sil = (LAS float*)(F.lds + RING_OFF + F.wave * 16384 + 8704);
    const int gw = (int)blockIdx.x * NWAVES + F.wave, NGW = F.G * NWAVES;
    constexpr int I_ADA = ADA_KS * ADA_STRIPS;
    constexpr int I_IN = (D / 64) * (DIN / 32), I_OUT = (D / 64) * (D / 32), I_F1 = (D / 64) * (DFF / 32), I_F2 = (DFF / 64) * (D / 32);
    constexpr int NITEMS = I_ADA + I_IN + I_OUT + I_F1 + I_F2;
    for (int it = gw; it < NITEMS; it += NGW) {
        int r = it;
        if (r < I_ADA) { p0_ada_item(F, r, sil); continue; } r -= I_ADA;
        if (r < I_IN) { p0_transpose_item(F.w_in, D, DIN, F.Wt_in, nullptr, nullptr, scr, r, F.lane); continue; } r -= I_IN;
        if (r < I_OUT) { p0_transpose_item(F.w_out, D, D, F.Wt_out, F.gna, F.gsgu, scr, r, F.lane); continue; } r -= I_OUT;
        if (r < I_F1) { p0_transpose_item(F.w_ff1, D, DFF, F.Wt_ff1, nullptr, nullptr, scr, r, F.lane); continue; } r -= I_F1;
        p0_transpose_item(F.w_ff2, DFF, D, F.Wt_ff2, nullptr, nullptr, scr, r, F.lane);
    }
}
__device__ __forceinline__ f32x4 ld4(const float* p) { return *(const f32x4*)p; }
__device__ __forceinline__ f32x4 ld4(const LAS float* p) { return *(const LAS f32x4*)p; }
template <class SP> __device__ __forceinline__ void row_norm_mod(const float* xrow, const float* nw, SP sh, SP sc, bf16* orow, int lane) {
    const f32x4* xr = (const f32x4*)xrow + lane;
    f32x4 v[16]; float ss = 0.f;
#pragma unroll
    for (int j = 0; j < 16; ++j) { v[j] = xr[64 * j]; ss += (v[j].x * v[j].x + v[j].y * v[j].y) + (v[j].z * v[j].z + v[j].w * v[j].w); }
    const float rstd = rsqrtf(wave_sum(ss) * (1.0f / D) + EPS);
#pragma unroll
    for (int j = 0; j < 16; ++j) { const int col = 4 * lane + 256 * j;
        const f32x4 w4 = ld4(nw + col), s4 = ld4(sc + col), h4 = ld4(sh + col);
        const f32x4 o = v[j] * rstd * w4 * (s4 + 1.0f) + h4;
        v2u pk; pk.x = pk2(o.x, o.y); pk.y = pk2(o.z, o.w);
        *(v2u*)(orow + col) = pk; }
}
__device__ __forceinline__ void p1_rows(Frame& F) {
    LAS float* modL = (LAS float*)(F.lds + RING_OFF);
    const int bx = (int)blockIdx.x, b = bx >> 6;
    for (int i = F.tid; i < 2 * D; i += NWAVES * 64) { float s0 = F.b_ada[i], s1 = s0;
#pragma unroll 4
        for (int sp = 0; sp < ADA_KS; ++sp) { s0 += F.part[(size_t)(sp * 5 + b) * NMODC + i]; s1 += F.part[(size_t)(sp * 5 + 4) * NMODC + i]; }
        modL[i] = s0; modL[2 * D + i] = s1; }
    if (F.tid < 480) { const int idx = bx * 480 + F.tid, r = idx / NMODC, j = idx % NMODC; float s = F.b_ada[j];
#pragma unroll 4
        for (int sp = 0; sp < ADA_KS; ++sp) s += F.part[(size_t)(sp * 5 + r) * NMODC + j];
        F.modf[idx] = s; }
    __syncthreads();
    for (int rr = F.wave; rr < 64; rr += NWAVES) { const int row = 64 * bx + rr;
        row_norm_mod<const LAS float*>(F.x + (size_t)row * D, F.norm1_w, modL, modL + D, F.A1 + (size_t)row * D, F.lane); }
    if (F.wave < 4) { const int row = 4 * bx + F.wave;
        row_norm_mod<const LAS float*>(F.ctx + (size_t)row * D, F.norm1_w, modL + 2 * D, modL + 3 * D, F.A1 + (size_t)(M + row) * D, F.lane); }
}
__device__ __forceinline__ void p4_grpnorm(Frame& F) {
    const int gw = (int)blockIdx.x * NWAVES + F.wave, NGW = F.G * NWAVES;
    for (int m = gw; m < M; m += NGW) {
        float sa = 0.f, sg = 0.f;
#pragma unroll
        for (int i = 0; i < 4; ++i) { const f32x4 t = *(const f32x4*)(F.ssna + (size_t)m * 16 + 4 * i); sa += (t.x + t.y) + (t.z + t.w); }
        { const f32x4 t = *(const f32x4*)(F.sssg + (size_t)m * 4); sg = (t.x + t.y) + (t.z + t.w); }
        const float rna = rsqrtf(sa * (1.0f / DNA) + EPS), rsg = rsqrtf(sg * (1.0f / DSGU) + EPS);
        v4u* p = (v4u*)(F.A2 + (size_t)m * D) + F.lane;
#pragma unroll
        for (int j = 0; j < 8; ++j) { v4u w = p[64 * j]; const float r = (j < 4) ? rna : rsg;
            w.x = pk2(bf_lo(w.x) * r, bf_hi(w.x) * r); w.y = pk2(bf_lo(w.y) * r, bf_hi(w.y) * r); w.z = pk2(bf_lo(w.z) * r, bf_hi(w.z) * r); w.w = pk2(bf_lo(w.w) * r, bf_hi(w.w) * r);
            p[64 * j] = w; }
    }
}
__device__ __forceinline__ void p6_rows(Frame& F) {
    const int gw = (int)blockIdx.x * NWAVES + F.wave, NGW = F.G * NWAVES;
    for (int m = gw; m < M; m += NGW) { const float* mf = F.modf + (size_t)(m >> 12) * NMODC;
        row_norm_mod<const float*>(F.out + (size_t)m * D, F.norm2_w, mf + 3 * D, mf + 4 * D, F.A1 + (size_t)m * D, F.lane); }
}
__device__ __forceinline__ void p9_final(Frame& F) {
    const int gw = (int)blockIdx.x * NWAVES + F.wave, NGW = F.G * NWAVES;
    for (int m = gw; m < M; m += NGW) {
        f32x4* xr = (f32x4*)(F.out + (size_t)m * D) + F.lane;
        f32x4 v[16]; float ss = 0.f;
#pragma unroll
        for (int j = 0; j < 16; ++j) { v[j] = xr[64 * j]; ss += (v[j].x * v[j].x + v[j].y * v[j].y) + (v[j].z * v[j].z + v[j].w * v[j].w); }
        const float rstd = rsqrtf(wave_sum(ss) * (1.0f / D) + EPS);
#pragma unroll
        for (int j = 0; j < 16; ++j) xr[64 * j] = v[j] * rstd * ld4(F.fnw + 4 * F.lane + 256 * j);
    }
}
__device__ __forceinline__ void sgu_unit(Frame& F, int b, int n, int grp) {
    const int lane = F.lane, w = F.wave, l15 = lane & 15, g = lane >> 4;
    const int tok0 = b * SEQ + n * 128, cbase = grp * 512;
    LAS float* part = (LAS float*)(F.lds + RING_OFF);
    LAS float* rgs = part + 16 * 128;
    {
        const int hp = lane >> 5, t4 = 4 * (lane & 31);
        float a0 = 0.f, a1 = 0.f, a2 = 0.f, a3 = 0.f;
        const bf16* gp = F.GT + (size_t)(256 * w + hp) * M + tok0 + t4;
#pragma unroll 16
        for (int cc = 0; cc < 128; ++cc) { const v2u v = *(const v2u*)(gp + (size_t)(2 * cc) * M);
            const float f0 = bf_lo(v.x), f1 = bf_hi(v.x), f2 = bf_lo(v.y), f3 = bf_hi(v.y); a0 += f0 * f0; a1 += f1 * f1; a2 += f2 * f2; a3 += f3 * f3; }
        *(LAS f32x4*)(part + (w * 2 + hp) * 128 + t4) = (f32x4){a0, a1, a2, a3};
    }
    __syncthreads();
    if (F.tid < 128) { float s = 0.f;
#pragma unroll
        for (int i = 0; i < 16; ++i) s += part[i * 128 + F.tid];
        rgs[F.tid] = rsqrtf(s * (1.0f / DSGU) + EPS); }
    __syncthreads();
    const int p = 16 * w + l15, token = tok0 + p;
    bf16x8 wf[4];
#pragma unroll
    for (int ks = 0; ks < 4; ++ks) { const int q0 = ks * 32 + 8 * g; const float* wp = F.sgu_w + (size_t)(grp * 128 + p) * 128 + q0;
        const f32x4 w0 = *(const f32x4*)wp, w1 = *(const f32x4*)(wp + 4); const f32x4 r0 = *(const LAS f32x4*)(rgs + q0), r1 = *(const LAS f32x4*)(rgs + q0 + 4);
        v4u pk; pk.x = pk2(w0.x * r0.x, w0.y * r0.y); pk.y = pk2(w0.z * r0.z, w0.w * r0.w); pk.z = pk2(w1.x * r1.x, w1.y * r1.y); pk.w = pk2(w1.z * r1.z, w1.w * r1.w);
        wf[ks] = __builtin_bit_cast(bf16x8, pk); }
    const float bias = F.sgu_b[grp * 128 + p];
    float ssq = 0.f;
#pragma unroll 2
    for (int ct = 0; ct < 32; ++ct) {
        f32x4 d = (f32x4){0.f, 0.f, 0.f, 0.f};
        const bf16* gp = F.GT + (size_t)(cbase + 16 * ct + l15) * M + tok0 + 8 * g;
#pragma unroll
        for (int ks = 0; ks < 4; ++ks) { const bf16x8 gf = *(const bf16x8*)(gp + ks * 32); d = __builtin_amdgcn_mfma_f32_16x16x32_bf16(gf, wf[ks], d, 0, 0, 0); }
        const int ch = cbase + 16 * ct + 4 * g;
        const f32x4 nw = *(const f32x4*)(F.sgu_norm_w + ch);
        const v2u uu = *(const v2u*)(F.UB + (size_t)token * DSGU + ch);
        const float o0 = bf_lo(uu.x) * (nw.x * d[0] + bias), o1 = bf_hi(uu.x) * (nw.y * d[1] + bias), o2 = bf_lo(uu.y) * (nw.z * d[2] + bias), o3 = bf_hi(uu.y) * (nw.w * d[3] + bias);
        ssq += (o0 * o0 + o1 * o1) + (o2 * o2 + o3 * o3);
        v2u pk; pk.x = pk2(o0, o1); pk.y = pk2(o2, o3);
        *(v2u*)(F.A2 + (size_t)token * D + DNA + ch) = pk;
    }
    ssq += __shfl_xor(ssq, 16); ssq += __shfl_xor(ssq, 32);
    if (g == 0) F.sssg[(size_t)token * 4 + grp] = ssq;
    __syncthreads();
}
__device__ __forceinline__ void attn_unit(Frame& F, int b, int h, int r, int j) {
    const int lane = F.lane, q = lane & 15, g = lane >> 4;
    const int qcol = 16 * j + q, qtok = b * SEQ + r * GW + qcol;
    int r0 = r - 4; r0 = r0 < 0 ? 0 : (r0 > 56 ? 56 : r0);
    int cs = qcol - 8; cs = cs < 0 ? 0 : (cs > 48 ? 48 : cs);
    const int band0 = (j == 0) ? 0 : (j == 1 ? 8 : (j == 2 ? 24 : 32));
    bf16x8 qf[4];
#pragma unroll
    for (int ds = 0; ds < 4; ++ds) qf[ds] = *(const bf16x8*)(F.QB + (size_t)qtok * DNA + h * HD + ds * 32 + 8 * g);
    f32x4 o[8];
#pragma unroll
    for (int dt = 0; dt < 8; ++dt) o[dt] = (f32x4){0.f, 0.f, 0.f, 0.f};
    float mrun = -1e30f, lrun = 0.f;
    const bf16* kbase = F.KB + (size_t)q * DNA + h * HD + 8 * g;
    const bf16* vbase = F.VT + (size_t)(h * HD + q) * MA + 4 * g;
    for (int step = 0; step < 16; ++step) {
        const bool win = step < 8;
        const int T0 = win ? (b * SEQ + (r0 + step) * GW + band0) : (M + b * CTX + (step - 8) * 32);
        f32x4 s[2];
#pragma unroll
        for (int tt = 0; tt < 2; ++tt) { s[tt] = (f32x4){0.f, 0.f, 0.f, 0.f};
#pragma unroll
            for (int ds = 0; ds < 4; ++ds) { const bf16x8 kf = *(const bf16x8*)(kbase + (size_t)(T0 + 16 * tt) * DNA + ds * 32); s[tt] = __builtin_amdgcn_mfma_f32_16x16x32_bf16(kf, qf[ds], s[tt], 0, 0, 0); } }
        if (win) { const float* bp = F.rpb + (size_t)(h * 15 + (r0 + step - r + 7)) * 31;
#pragma unroll
            for (int tt = 0; tt < 2; ++tt)
#pragma unroll
                for (int rg = 0; rg < 4; ++rg) { const int kc = band0 + 16 * tt + 4 * g + rg; const bool valid = (kc >= cs) && (kc < cs + 16);
                    int co = kc - qcol + 15; co = co < 0 ? 0 : (co > 30 ? 30 : co);
                    const float bias = bp[co] * LOG2E; s[tt][rg] = valid ? s[tt][rg] + bias : -1e30f; } }
        float mx = fmaxf(fmaxf(fmaxf(s[0][0], s[0][1]), fmaxf(s[0][2], s[0][3])), fmaxf(fmaxf(s[1][0], s[1][1]), fmaxf(s[1][2], s[1][3])));
        mx = fmaxf(mx, __shfl_xor(mx, 16)); mx = fmaxf(mx, __shfl_xor(mx, 32));
        const float mn = fmaxf(mrun, mx), alpha = __builtin_amdgcn_exp2f(mrun - mn); mrun = mn;
        float ps = 0.f;
#pragma unroll
        for (int tt = 0; tt < 2; ++tt)
#pragma unroll
            for (int rg = 0; rg < 4; ++rg) { s[tt][rg] = __builtin_amdgcn_exp2f(s[tt][rg] - mn); ps += s[tt][rg]; }
        lrun = lrun * alpha + ps;
#pragma unroll
        for (int dt = 0; dt < 8; ++dt) o[dt] *= alpha;
        v4u pk; pk.x = pk2(s[0][0], s[0][1]); pk.y = pk2(s[0][2], s[0][3]); pk.z = pk2(s[1][0], s[1][1]); pk.w = pk2(s[1][2], s[1][3]);
        const bf16x8 pf = __builtin_bit_cast(bf16x8, pk);
#pragma unroll
        for (int dt = 0; dt < 8; ++dt) { const bf16* vp = vbase + (size_t)(dt * 16) * MA + T0;
            v4u vv; const v2u lo = *(const v2u*)vp, hi = *(const v2u*)(vp + 16); vv.x = lo.x; vv.y = lo.y; vv.z = hi.x; vv.w = hi.y;
            o[dt] = __builtin_amdgcn_mfma_f32_16x16x32_bf16(__builtin_bit_cast(bf16x8, vv), pf, o[dt], 0, 0, 0); }
    }
    lrun += __shfl_xor(lrun, 16); lrun += __shfl_xor(lrun, 32);
    const float inv = 1.0f / lrun; float ssq = 0.f;
    bf16* op = F.A2 + (size_t)qtok * D + h * HD + 4 * g;
#pragma unroll
    for (int dt = 0; dt < 8; ++dt) { const f32x4 v = o[dt] * inv; ssq += (v.x * v.x + v.y * v.y) + (v.z * v.z + v.w * v.w);
        v2u pk; pk.x = pk2(v.x, v.y); pk.y = pk2(v.z, v.w); *(v2u*)(op + dt * 16) = pk; }
    ssq += __shfl_xor(ssq, 16); ssq += __shfl_xor(ssq, 32);
    if (g == 0) F.ssna[(size_t)qtok * 16 + h] = ssq;
}
__device__ __forceinline__ void p3_mixers(Frame& F) {
    for (int uid = (int)blockIdx.x; uid < BATCH * 32 * 4; uid += F.G) sgu_unit(F, uid >> 7, (uid >> 2) & 31, uid & 3);
    const int gw = (int)blockIdx.x * NWAVES + F.wave, NGW = F.G * NWAVES;
    for (int uid = gw; uid < BATCH * NH * GW * 4; uid += NGW) attn_unit(F, uid >> 12, (uid >> 8) & 15, (uid >> 2) & 63, uid & 3);
}

struct Args { const float* in[19]; float* out; unsigned char* ws; int ph_lo, ph_hi; };
__global__ void __launch_bounds__(NWAVES * 64, 2) mk_fwd(Args args) {
    extern __shared__ __attribute__((aligned(16))) unsigned char lds[];
    Frame F;
    F.lds = (LAS unsigned char*)lds;
    F.MISC = (volatile LAS unsigned*)(F.lds + MISC_OFF);
    F.tid = threadIdx.x; F.lane = F.tid & 63; F.wave = __builtin_amdgcn_readfirstlane(F.tid >> 6);
    F.G = gridDim.x;
    unsigned char* ws = args.ws;
    F.ctl = (gu32*)(ws + WS_CTL);
    F.x = args.in[0]; F.c = args.in[1]; F.ctx = args.in[2]; F.cctx = args.in[3]; F.w_ada = args.in[4]; F.b_ada = args.in[5]; F.norm1_w = args.in[6]; F.w_in = args.in[7]; F.rpb = args.in[8];
    F.sgu_norm_w = args.in[9]; F.sgu_w = args.in[10]; F.sgu_b = args.in[11]; F.gna = args.in[12]; F.gsgu = args.in[13]; F.w_out = args.in[14]; F.norm2_w = args.in[15];
    F.w_ff1 = args.in[16]; F.w_ff2 = args.in[17]; F.fnw = args.in[18]; F.out = args.out;
    F.modf = (float*)(ws + WS_MODF); F.part = (float*)(ws + WS_PART); F.ssna = (float*)(ws + WS_SSNA); F.sssg = (float*)(ws + WS_SSSG);
    F.Wt_in = (bf16*)(ws + WS_WIN); F.Wt_out = (bf16*)(ws + WS_WOUT); F.Wt_ff1 = (bf16*)(ws + WS_WFF1); F.Wt_ff2 = (bf16*)(ws + WS_WFF2);
    F.A1 = (bf16*)(ws + WS_A1); F.QB = (bf16*)(ws + WS_Q); F.KB = (bf16*)(ws + WS_K); F.VT = (bf16*)(ws + WS_VT); F.UB = (bf16*)(ws + WS_U); F.GT = (bf16*)(ws + WS_GT);
    F.A2 = (bf16*)(ws + WS_A2); F.HB = (bf16*)(ws + WS_H);
    for (int u = F.tid; u < (LDS_BYTES - LDSCTL_OFF) / 4; u += NWAVES * 64) ((LAS unsigned*)(F.lds + LDSCTL_OFF))[u] = 0u;
    __syncthreads();
    XcdBarrier bar; bar.bar = (unsigned*)(F.ctl + CW_BAR); bar.x = 0; bar.st = nullptr;
    if (MK_N_LAUNCHES == 1) bar = xcd_barrier_post((unsigned*)(F.ctl + CW_BAR), F.MISC + 8);
    const int lo = args.ph_lo, hi = args.ph_hi;
#define IN(k) (lo <= (k) && (k) < hi)
#define SEAM(k) do { if (IN(k) && IN((k) + 1)) xcd_barrier(bar); } while (0)

    if (IN(0)) { p0_prologue(F); } SEAM(0);
    if (IN(1)) { p1_rows(F); } SEAM(1);
    if (IN(2)) {
        pg8::Gemm g{F.A1, F.Wt_in, MA, DIN, D}; pg8::InProjOrder S; S.G = F.G; S.c = (int)blockIdx.x;
        pg8::EpiInProj E{F.QB, WS_SLOT / 2, 0.08838834764831845f * LOG2E};
        pg8::gemm_phase<pg8::EpiInProj, pg8::InProjOrder, true, true>(F.lds + RING_OFF, g, S, E);
    } SEAM(2);
    if (IN(3)) { p3_mixers(F); } SEAM(3);
    if (IN(4)) { p4_grpnorm(F); } SEAM(4);
    if (IN(5)) {
        pg8::Gemm g{F.A2, F.Wt_out, M, D, D}; pg8::StdOrder S; S.init(M, D, F.G, (int)blockIdx.x);
        pg8::EpiGatedRes E{F.x, F.out, D, F.modf + 2 * D, NMODC};
        pg8::gemm_phase<pg8::EpiGatedRes, pg8::StdOrder, true, true>(F.lds + RING_OFF, g, S, E);
    } SEAM(5);
    if (IN(6)) { p6_rows(F); } SEAM(6);
    if (IN(7)) {
        pg8::Gemm g{F.A1, F.Wt_ff1, M, DFF, D}; pg8::StdOrder S; S.init(M, DFF, F.G, (int)blockIdx.x);
        pg8::EpiRelu2 E{F.HB, DFF};
        pg8::gemm_phase<pg8::EpiRelu2, pg8::StdOrder, true, true>(F.lds + RING_OFF, g, S, E);
    } SEAM(7);
    if (IN(8)) {
        pg8::Gemm g{F.HB, F.Wt_ff2, M, D, DFF}; pg8::StdOrder S; S.init(M, D, F.G, (int)blockIdx.x);
        pg8::EpiGatedRes E{F.out, F.out, D, F.modf + 5 * D, NMODC};
        pg8::gemm_phase<pg8::EpiGatedRes, pg8::StdOrder, true, true>(F.lds + RING_OFF, g, S, E);
    } SEAM(8);
    if (IN(9)) { p9_final(F); }
#undef IN
#undef SEAM
}

extern "C" void kernel_launch(void* const* d_in, const int* in_sizes, int n_in, void* d_out, int out_size, void* d_ws, size_t ws_size, hipStream_t stream) {
    static int grid = 0;
    if (grid == 0) {
        if (n_in != 19 || in_sizes[0] != M * D || out_size != M * D || ws_size < WS_END) { fprintf(stderr, "kernel_launch: unexpected shapes / workspace (%zu)\n", ws_size); grid = -1; return; }
        int dev = 0, cus = 0, per_cu = 0;
        if (hipGetDevice(&dev) != hipSuccess || hipDeviceGetAttribute(&cus, hipDeviceAttributeMultiprocessorCount, dev) != hipSuccess) { grid = -1; return; }
        if (hipFuncSetAttribute((const void*)mk_fwd, hipFuncAttributeMaxDynamicSharedMemorySize, LDS_BYTES) != hipSuccess) { grid = -1; return; }
        if (hipOccupancyMaxActiveBlocksPerMultiprocessor(&per_cu, (const void*)mk_fwd, NWAVES * 64, LDS_BYTES) != hipSuccess || per_cu < 1) { fprintf(stderr, "kernel_launch: occupancy query says %d\n", per_cu); }
        (void)hipGetLastError();
        if (cus < 256) { fprintf(stderr, "kernel_launch: needs 256 CUs, device has %d\n", cus); grid = -1; return; }
        grid = 256;
    }
    if (grid < 0) return;
    if (hipMemsetAsync((char*)d_ws + WS_CTL, 0, CTL_ZERO_BYTES, stream) != hipSuccess) return;
    Args a{};
    for (int i = 0; i < 19; ++i) a.in[i] = (const float*)d_in[i];
    a.out = (float*)d_out; a.ws = (unsigned char*)d_ws;
    if (MK_N_LAUNCHES == 1) { a.ph_lo = 0; a.ph_hi = N_PHASES; hipLaunchKernelGGL(mk_fwd, dim3(grid), dim3(NWAVES * 64), LDS_BYTES, stream, a); }
    else for (int p = 0; p < N_PHASES; ++p) { a.ph_lo = p; a.ph_hi = p + 1; hipLaunchKernelGGL(mk_fwd, dim3(grid), dim3(NWAVES * 64), LDS_BYTES, stream, a); }
}
```

```cpp
#include <hip/hip_runtime.h>
#include <cstdio>
#include <cstdint>
namespace pg8 {
#define PG8_LAS __attribute__((address_space(3)))
typedef unsigned short bf16_t;
typedef short bf16x8 __attribute__((ext_vector_type(8)));
typedef float f32x4 __attribute__((ext_vector_type(4)));
typedef unsigned u32x4 __attribute__((ext_vector_type(4)));
constexpr int BM = 256, BK = 64, HALF = 128, HTB = HALF * BK * 2  , STAGE_BYTES = 8 * HTB, NXCD = 8, WGM = 8;

__host__ __device__ __forceinline__ int lds_byte(int r, int c) { const int st = (r >> 4) * 2 + (c >> 5), rr = r & 15, cc = c & 31, ob = rr * 64 + cc * 2; return st * 1024 + (ob ^ (((ob >> 9) & 1) << 5)); }
__host__ __device__ __forceinline__ void stage_rc(int b, int& R, int& C) { const int st = b / 1024, sb = b % 1024, swz = sb ^ (((sb >> 9) & 1) << 5); R = (st >> 1) * 16 + swz / 64; C = (st & 1) * 32 + (swz % 64) / 2; }
__host__ __device__ __forceinline__ int perm32(int rho) { const int n = rho >> 4, i = rho & 15; return 8 * (i >> 2) + 4 * n + (i & 3); }

struct Unit { int pm, pn; };
struct Gemm { const bf16_t* A; const bf16_t* Bt; int M, N, K; };

__device__ __forceinline__ void std_map(int wgid, int nM, int nN, Unit& u) {
    const int nwg = nM * nN;
    { const int q = nwg / NXCD, r = nwg % NXCD, xcd = wgid % NXCD, off = wgid / NXCD; wgid = (xcd < r ? xcd * (q + 1) : r * (q + 1) + (xcd - r) * q) + off; }
    const int nig = WGM * nN, gid = wgid / nig, fm = gid * WGM, gsz = (nM - fm) < WGM ? (nM - fm) : WGM;
    u.pm = fm + ((wgid % nig) % gsz); u.pn = (wgid % nig) / gsz;
}
struct StdOrder {
    int nM, nN, nwg, G, c;
    __device__ void init(int M, int N, int G_, int c_) { nM = M / BM; nN = N / BM; nwg = nM * nN; G = G_; c = c_; }
    __device__ bool next(int i, Unit& u) const { const long L = (long)i * G + c; if (L >= nwg) return false; std_map((int)L, nM, nN, u); return true; }
    __device__ __forceinline__ void bases(const Unit& u, const Gemm& g, size_t tstep, const char*& a, const char*& b) const { a = (const char*)g.A + (size_t)u.pm * tstep; b = (const char*)g.Bt + (size_t)u.pn * tstep; }
    __device__ __forceinline__ void a_ready(const Unit&) const {}
    __device__ __forceinline__ void done(const Unit&) const {}
};
struct InProjOrder {
    int G, c;
    __device__ bool next(int i, Unit& u) const {
        const long L = (long)i * G + c;
        if (L < 2560) { std_map((int)L, 64, 40, u); return true; }
        if (L < 2624) { const int j = (int)L - 2560; u.pm = 64 + (j >> 4); u.pn = 8 + (j & 15); return true; }
        return false;
    }
    __device__ __forceinline__ void bases(const Unit& u, const Gemm& g, size_t tstep, const char*& a, const char*& b) const {
        const int ty = u.pn >> 3; const bool sw = (ty == 2) || (ty == 4);
        const char* act = (const char*)g.A + (size_t)u.pm * tstep; const char* w = (const char*)g.Bt + (size_t)u.pn * tstep;
        a = sw ? w : act; b = sw ? act : w;
    }
    __device__ __forceinline__ void a_ready(const Unit&) const {}
    __device__ __forceinline__ void done(const Unit&) const {}
};

__device__ __forceinline__ unsigned cvt_pk_bf16(float lo, float hi) { unsigned r; asm volatile("v_cvt_pk_bf16_f32 %0, %1, %2" : "=v"(r) : "v"(lo), "v"(hi)); return r; }
__device__ __forceinline__ float gelu_t(float x) { const float u = x * (0.7978845608f + 0.0356774081f * x * x); const float t = __builtin_amdgcn_exp2f(-2.8853900818f * u); return x * __builtin_amdgcn_rcpf(1.0f + t); }

struct EpiInProj {
    static constexpr bool PERM = true, AFTER_DRAIN = false;
    bf16_t* base0; size_t slot; float qscale;
    __device__ __forceinline__ void operator()(const f32x4 (&acc)[2][2][4][2], const Unit& u, int wr, int wc, int fr, int fq) const {
        const int ty = u.pn >> 3, sub = (u.pn & 7) * BM, tokb = u.pm * BM;
        bf16_t* base = base0 + (size_t)ty * slot; const bool sw = (ty == 2) || (ty == 4);
        const int ldc = (ty == 2) ? 17408 : ((ty == 4) ? 16384 : 2048), rb = sw ? sub : tokb, cb = sw ? tokb : sub;
        const float sc = (ty == 0) ? qscale : 1.f; const bool act = ty >= 3;
        const int row0 = rb + wr * 64 + fr, col0 = cb + wc * 32 + 8 * fq;
#pragma unroll
        for (int ai = 0; ai < 2; ++ai)
#pragma unroll
            for (int m = 0; m < 4; ++m) { bf16_t* rowp = base + (size_t)(row0 + ai * HALF + m * 16) * ldc + col0;
#pragma unroll
                for (int bj = 0; bj < 2; ++bj) { f32x4 v0 = acc[ai][bj][m][0] * sc, v1 = acc[ai][bj][m][1] * sc;
                    if (act) {
#pragma unroll
                        for (int j = 0; j < 4; ++j) { v0[j] = gelu_t(v0[j]); v1[j] = gelu_t(v1[j]); } }
                    u32x4 w; w.x = cvt_pk_bf16(v0[0], v0[1]); w.y = cvt_pk_bf16(v0[2], v0[3]); w.z = cvt_pk_bf16(v1[0], v1[1]); w.w = cvt_pk_bf16(v1[2], v1[3]);
                    *(u32x4*)(rowp + bj * HALF) = w; } }
    }
};
struct EpiRelu2 {
    static constexpr bool PERM = true, AFTER_DRAIN = false;
    bf16_t* O; int ldc;
    __device__ __forceinline__ void operator()(const f32x4 (&acc)[2][2][4][2], const Unit& u, int wr, int wc, int fr, int fq) const {
        const int row0 = u.pm * BM + wr * 64 + fr, col0 = u.pn * BM + wc * 32 + 8 * fq;
#pragma unroll
        for (int ai = 0; ai < 2; ++ai)
#pragma unroll
            for (int m = 0; m < 4; ++m) { bf16_t* rowp = O + (size_t)(row0 + ai * HALF + m * 16) * ldc + col0;
#pragma unroll
                for (int bj = 0; bj < 2; ++bj) { f32x4 v0 = acc[ai][bj][m][0], v1 = acc[ai][bj][m][1];
#pragma unroll
                    for (int j = 0; j < 4; ++j) { const float a = fmaxf(v0[j], 0.f), b = fmaxf(v1[j], 0.f); v0[j] = a * a; v1[j] = b * b; }
                    u32x4 w; w.x = cvt_pk_bf16(v0[0], v0[1]); w.y = cvt_pk_bf16(v0[2], v0[3]); w.z = cvt_pk_bf16(v1[0], v1[1]); w.w = cvt_pk_bf16(v1[2], v1[3]);
                    *(u32x4*)(rowp + bj * HALF) = w; } }
    }
};
struct EpiGatedRes {
    static constexpr bool PERM = false, AFTER_DRAIN = false;
    const float* base; float* out; int ldc; const float* gate; int gate_pitch;
    __device__ __forceinline__ void operator()(const f32x4 (&acc)[2][2][4][2], const Unit& u, int wr, int wc, int fr, int fq) const {
        const int row0 = u.pm * BM + wr * 64 + fr, col0 = u.pn * BM + wc * 32 + 4 * fq;
        const float* gp = gate + (size_t)(u.pm >> 4) * gate_pitch + col0;
        f32x4 gv[2][2];
#pragma unroll
        for (int bj = 0; bj < 2; ++bj)
#pragma unroll
            for (int n = 0; n < 2; ++n) gv[bj][n] = *(const f32x4*)(gp + bj * HALF + n * 16);
#pragma unroll
        for (int ai = 0; ai < 2; ++ai)
#pragma unroll
            for (int m = 0; m < 4; ++m) { const size_t off = (size_t)(row0 + ai * HALF + m * 16) * ldc + col0;
#pragma unroll
                for (int bj = 0; bj < 2; ++bj)
#pragma unroll
                    for (int n = 0; n < 2; ++n) { const f32x4 bs = *(const f32x4*)(base + off + bj * HALF + n * 16); *(f32x4*)(out + off + bj * HALF + n * 16) = bs + gv[bj][n] * acc[ai][bj][m][n]; }
                asm volatile("" ::: "memory"); }
    }
};

template <class Epi, class Sched, bool ALIGN_EPI = false, bool SP2 = false>
__device__ __forceinline__ void gemm_phase(PG8_LAS unsigned char* lds, const Gemm g, const Sched& S, const Epi& E) {
    const int tid = threadIdx.x, wid = __builtin_amdgcn_readfirstlane(tid >> 6), lane = tid & 63, wr = wid >> 2, wc = wid & 3, fr = lane & 15, fq = lane >> 4;
    const int K = g.K, nt = K / BK;
    unsigned voffA[2], voffB[2];
#pragma unroll
    for (int i = 0; i < 2; ++i) { int R, C; stage_rc(tid * 16 + i * 8192, R, C); const int Rb = Epi::PERM ? ((R & ~31) + perm32(R & 31)) : R;
        voffA[i] = (unsigned)(R * K + C) * 2u; voffB[i] = (unsigned)(Rb * K + C) * 2u; }
    const size_t kstep = (size_t)(BK * 2);
    const size_t hstep = (size_t)HALF * K * 2;
    const size_t tstep = 2 * hstep;
    const unsigned ldsw = (unsigned)wid * 1024u;
    const int aoff = lds_byte(wr * 64 + fr, fq * 8), boff = lds_byte(wc * 32 + fr, fq * 8);
#define PG8_SA(b, h) (((b) * 2 + (h)) * HTB)
#define PG8_SB(b, h) ((4 + (b) * 2 + (h)) * HTB)
#define PG8_STAGE(bufoff, gbase, voff) do { _Pragma("unroll") for (int _i = 0; _i < 2; ++_i) \
        __builtin_amdgcn_global_load_lds((const unsigned*)((const char*)(gbase) + (voff)[_i]), (PG8_LAS unsigned*)(lds + (bufoff) + ldsw + _i * 8192), 16, 0, 0); } while (0)
#define PG8_LDA(dst, b, h) do { _Pragma("unroll") for (int m = 0; m < 4; ++m) _Pragma("unroll") for (int k = 0; k < 2; ++k) dst[m][k] = *(const PG8_LAS bf16x8*)(lds + PG8_SA(b, h) + aoff + m * 2048 + k * 1024); } while (0)
#define PG8_LDB(dst, b, h) do { _Pragma("unroll") for (int n = 0; n < 2; ++n) _Pragma("unroll") for (int k = 0; k < 2; ++k) dst[n][k] = *(const PG8_LAS bf16x8*)(lds + PG8_SB(b, h) + boff + n * 2048 + k * 1024); } while (0)
#define PG8_MMA(ai, bj, At, Bt) do { __builtin_amdgcn_s_setprio(1); _Pragma("unroll") for (int m = 0; m < 4; ++m) _Pragma("unroll") for (int n = 0; n < 2; ++n) _Pragma("unroll") for (int k = 0; k < 2; ++k) \
        acc[ai][bj][m][n] = __builtin_amdgcn_mfma_f32_16x16x32_bf16(Bt[n][k], At[m][k], acc[ai][bj][m][n], 0, 0, 0); __builtin_amdgcn_s_setprio(0); } while (0)
#define PG8_WAIT_V(n) asm volatile("s_waitcnt vmcnt(" #n ")" ::: "memory")
#define PG8_WAIT_L(n) asm volatile("s_waitcnt lgkmcnt(" #n ")" ::: "memory")
#define PG8_BAR __builtin_amdgcn_s_barrier()
#define PG8_SCHED __builtin_amdgcn_sched_barrier(0)
    Unit cur, nxt; int ui = 0;
    if (!S.next(0, cur)) return;
    f32x4 acc[2][2][4][2];
#pragma unroll
    for (int a = 0; a < 2; ++a)
#pragma unroll
        for (int b = 0; b < 2; ++b)
#pragma unroll
            for (int m = 0; m < 4; ++m)
#pragma unroll
                for (int n = 0; n < 2; ++n) acc[a][b][m][n] = (f32x4){0.f, 0.f, 0.f, 0.f};
    bf16x8 At[4][2], B0[2][2], B1[2][2];
    const char* cA; const char* cB; S.bases(cur, g, tstep, cA, cB);
    S.a_ready(cur);
    if constexpr (SP2) {
        PG8_STAGE(PG8_SB(0, 0), cB, voffB); PG8_STAGE(PG8_SB(0, 1), cB + hstep, voffB); PG8_STAGE(PG8_SA(0, 0), cA, voffA); PG8_STAGE(PG8_SA(0, 1), cA + hstep, voffA);
        if (wr == 1) PG8_BAR;
        PG8_WAIT_V(2); PG8_BAR;
        PG8_STAGE(PG8_SB(1, 0), cB + kstep, voffB); PG8_STAGE(PG8_SA(1, 0), cA + kstep, voffA); PG8_STAGE(PG8_SB(1, 1), cB + hstep + kstep, voffB);
        PG8_WAIT_V(6); PG8_BAR;
    } else {
        PG8_STAGE(PG8_SB(0, 0), cB, voffB); PG8_STAGE(PG8_SA(0, 0), cA, voffA); PG8_STAGE(PG8_SB(0, 1), cB + hstep, voffB); PG8_STAGE(PG8_SA(0, 1), cA + hstep, voffA);
        if (wr == 1) PG8_BAR;
        PG8_WAIT_V(4); PG8_BAR;
        PG8_STAGE(PG8_SB(1, 0), cB + kstep, voffB); PG8_STAGE(PG8_SA(1, 0), cA + kstep, voffA); PG8_STAGE(PG8_SB(1, 1), cB + hstep + kstep, voffB);
        PG8_WAIT_V(6); PG8_BAR;
    }
    for (;;) {
        const bool has_next = S.next(ui + 1, nxt);
        const char* nA = cA; const char* nB = cB; if (has_next) S.bases(nxt, g, tstep, nA, nB);
        for (int t = 0; t < nt; t += 2) {
            const bool last = (t == nt - 2);
            const char* a1 = cA + (size_t)(t + 1) * kstep;
            const char* a2 = last ? nA : cA + (size_t)(t + 2) * kstep; const char* b2 = last ? nB : cB + (size_t)(t + 2) * kstep;
            const char* a3 = a2 + kstep; const char* b3 = b2 + kstep;
            if (last && has_next) S.a_ready(nxt);
            if constexpr (SP2) {
            PG8_LDB(B0, 0, 0); PG8_LDB(B1, 0, 1); PG8_SCHED; PG8_LDA(At, 0, 0); PG8_STAGE(PG8_SA(1, 1), a1 + hstep, voffA);
            PG8_WAIT_V(8); PG8_WAIT_L(0); PG8_BAR; PG8_MMA(0, 0, At, B0); PG8_MMA(0, 1, At, B1); PG8_BAR; PG8_SCHED;
            PG8_LDA(At, 0, 1); PG8_STAGE(PG8_SB(0, 0), b2, voffB); PG8_STAGE(PG8_SB(0, 1), b2 + hstep, voffB); PG8_STAGE(PG8_SA(0, 0), a2, voffA);
            PG8_WAIT_V(8); PG8_WAIT_L(0); PG8_BAR; PG8_MMA(1, 0, At, B0); PG8_MMA(1, 1, At, B1); PG8_BAR; PG8_SCHED;
            PG8_LDB(B0, 1, 0); PG8_LDB(B1, 1, 1); PG8_SCHED; PG8_LDA(At, 1, 0); PG8_STAGE(PG8_SA(0, 1), a2 + hstep, voffA);
            PG8_WAIT_V(8); PG8_WAIT_L(0); PG8_BAR; PG8_MMA(0, 0, At, B0); PG8_MMA(0, 1, At, B1); PG8_BAR; PG8_SCHED;
            PG8_LDA(At, 1, 1); PG8_STAGE(PG8_SB(1, 0), b3, voffB); PG8_STAGE(PG8_SB(1, 1), b3 + hstep, voffB); PG8_STAGE(PG8_SA(1, 0), a3, voffA);
            PG8_WAIT_V(8); PG8_WAIT_L(0); PG8_BAR; PG8_MMA(1, 0, At, B0); PG8_MMA(1, 1, At, B1); PG8_BAR; PG8_SCHED;
            } else {
            PG8_LDB(B0, 0, 0); PG8_SCHED; PG8_LDA(At, 0, 0); PG8_STAGE(PG8_SA(1, 1), a1 + hstep, voffA);
            PG8_WAIT_L(8); PG8_BAR; PG8_WAIT_L(0); PG8_MMA(0, 0, At, B0); PG8_BAR; PG8_SCHED;
            PG8_LDB(B1, 0, 1); PG8_STAGE(PG8_SB(0, 0), b2, voffB);
            PG8_BAR; PG8_WAIT_L(0); PG8_MMA(0, 1, At, B1); PG8_BAR;
            PG8_LDA(At, 0, 1); PG8_STAGE(PG8_SA(0, 0), a2, voffA);
            PG8_BAR; PG8_WAIT_L(0); PG8_MMA(1, 0, At, B0); PG8_BAR; PG8_SCHED;
            PG8_STAGE(PG8_SB(0, 1), b2 + hstep, voffB);
            PG8_WAIT_V(6); PG8_BAR; PG8_MMA(1, 1, At, B1); PG8_BAR;
            PG8_LDB(B0, 1, 0); PG8_SCHED; PG8_LDA(At, 1, 0); PG8_STAGE(PG8_SA(0, 1), a2 + hstep, voffA);
            PG8_WAIT_L(8); PG8_BAR; PG8_WAIT_L(0); PG8_MMA(0, 0, At, B0); PG8_BAR; PG8_SCHED;
            PG8_LDB(B1, 1, 1); PG8_STAGE(PG8_SB(1, 0), b3, voffB);
            PG8_BAR; PG8_WAIT_L(0); PG8_MMA(0, 1, At, B1); PG8_BAR;
            PG8_LDA(At, 1, 1); PG8_STAGE(PG8_SA(1, 0), a3, voffA);
            PG8_BAR; PG8_WAIT_L(0); PG8_MMA(1, 0, At, B0); PG8_BAR; PG8_SCHED;
            PG8_STAGE(PG8_SB(1, 1), b3 + hstep, voffB);
            PG8_WAIT_V(6); PG8_BAR; PG8_MMA(1, 1, At, B1); PG8_BAR;
            }
        }
        if constexpr (ALIGN_EPI) { if (wr == 0) PG8_BAR; }
        if constexpr (!Epi::AFTER_DRAIN) { E(acc, cur, wr, wc, fr, fq); S.done(cur); }
        if (!has_next) break;
#pragma unroll
        for (int a = 0; a < 2; ++a)
#pragma unroll
            for (int b = 0; b < 2; ++b)
#pragma unroll
                for (int m = 0; m < 4; ++m)
#pragma unroll
                    for (int n = 0; n < 2; ++n) acc[a][b][m][n] = (f32x4){0.f, 0.f, 0.f, 0.f};
        cur = nxt; cA = nA; cB = nB; ++ui;
        if constexpr (ALIGN_EPI) { if (wr == 1) PG8_BAR; }
    }
    PG8_WAIT_V(0);
    if constexpr (!ALIGN_EPI) { if (wr == 0) PG8_BAR; }
    PG8_BAR;
    if constexpr (Epi::AFTER_DRAIN) { E.fused(acc, cur, wr, wc, fr, fq, lds, wid, lane); S.done(cur); }
#undef PG8_SA
#undef PG8_SB
#undef PG8_STAGE
#undef PG8_LDA
#undef PG8_LDB
#undef PG8_MMA
#undef PG8_WAIT_V
#undef PG8_WAIT_L
#undef PG8_BAR
#undef PG8_SCHED
}
}

constexpr int NWAVES = 8;
#ifndef MK_N_LAUNCHES
#define MK_N_LAUNCHES 1
#endif
constexpr int N_PHASES = 10;
#ifndef REP_PHASE
#define REP_PHASE -1
#endif
#define REPS(k) (((k) == REP_PHASE) ? 2 : 1)
constexpr int D = 4096, BATCH = 4, SEQ = 4096, GW = 64, CTX = 256;
constexpr int NH = 16, HD = 128, DNA = 2048, DSGU = 2048, DIN = 10240, DFF = 16384, NMODC = 6 * D;
constexpr int M = BATCH * SEQ, MC = BATCH * CTX, MA = M + MC;
constexpr float EPS = 1e-6f;
constexpr float LOG2E = 1.4426950408889634f;
constexpr int ADA_KS = 16, ADA_STRIPS = NMODC / 256;

constexpr size_t MiB = 1u << 20;
constexpr size_t WS_CTL = 0, CTL_ZERO_BYTES = 1 * MiB;
constexpr size_t WS_MODF = 1 * MiB;
constexpr size_t WS_PART = 2 * MiB;
constexpr size_t WS_SSNA = 10 * MiB;
constexpr size_t WS_SSSG = 11 * MiB;
constexpr size_t WS_WIN = 16 * MiB;
constexpr size_t WS_WOUT = 96 * MiB;
constexpr size_t WS_WFF1 = 128 * MiB;
constexpr size_t WS_WFF2 = 256 * MiB;
constexpr size_t WS_A1 = 384 * MiB;
constexpr size_t WS_SLOT = 68 * MiB;
constexpr size_t WS_Q = 520 * MiB;
constexpr size_t WS_K = WS_Q + 1 * WS_SLOT;
constexpr size_t WS_VT = WS_Q + 2 * WS_SLOT;
constexpr size_t WS_U = WS_Q + 3 * WS_SLOT;
constexpr size_t WS_GT = WS_Q + 4 * WS_SLOT;
constexpr size_t WS_A2 = WS_Q + 5 * WS_SLOT;
constexpr size_t WS_H = 520 * MiB;
constexpr size_t WS_END = 1032 * MiB;
static_assert(WS_A1 + (size_t)MA * D * 2 <= WS_Q && WS_K + (size_t)MA * DNA * 2 <= WS_VT && WS_VT + (size_t)DNA * MA * 2 <= WS_U && WS_GT + (size_t)DSGU * M * 2 <= WS_A2 && WS_A2 + (size_t)M * D * 2 <= WS_END && WS_H + (size_t)M * DFF * 2 <= WS_END, "d_ws map");
constexpr int CW_BAR = 4096;

constexpr int RING_OFF = 0, RING_BYTES = 131072;
constexpr int LDSCTL_OFF = 143360, MISC_OFF = LDSCTL_OFF + 320;
constexpr int LDS_BYTES = 147456;

#define GAS __attribute__((address_space(1)))
#define LAS __attribute__((address_space(3)))
typedef unsigned short bf16;
typedef unsigned v4u __attribute__((ext_vector_type(4)));
typedef unsigned v2u __attribute__((ext_vector_type(2)));
typedef float f32x4 __attribute__((ext_vector_type(4)));
typedef short bf16x8 __attribute__((ext_vector_type(8)));
typedef GAS unsigned gu32;
#define RLX_AGENT __ATOMIC_RELAXED, __HIP_MEMORY_SCOPE_AGENT
#define LDS_WAIT() asm volatile("s_waitcnt lgkmcnt(0)" ::: "memory")
#define VM_WAIT() asm volatile("s_waitcnt vmcnt(0)" ::: "memory")
__device__ __forceinline__ unsigned pk2(float lo, float hi) { return pg8::cvt_pk_bf16(lo, hi); }
__device__ __forceinline__ float bf_lo(unsigned w) { return __builtin_bit_cast(float, w << 16); }
__device__ __forceinline__ float bf_hi(unsigned w) { return __builtin_bit_cast(float, w & 0xffff0000u); }

#define XB_TMO      128
#define XB_XCNT(j)  (256  + 64 * (j))
#define XB_XSUB(j)  (1280 + 64 * (j))
#define XB_XGEN(j)  (2304 + 64 * (j))
#define XB_TOP      3328
#define XB_TOPGEN   3392
#define XCD_BAR_WORDS 3456
#define XB_SPIN_CAP (1u << 18)

__device__ __forceinline__ unsigned xb_ld(unsigned* p)              { return __hip_atomic_load(p, __ATOMIC_RELAXED, __HIP_MEMORY_SCOPE_AGENT); }
__device__ __forceinline__ unsigned xb_add(unsigned* p, unsigned v) { return __hip_atomic_fetch_add(p, v, __ATOMIC_RELAXED, __HIP_MEMORY_SCOPE_AGENT); }
__device__ __forceinline__ unsigned xb_xcc_id() { return (unsigned)__builtin_amdgcn_s_getreg((3 << 11) | 20) & 0xFu; }
#define XB_SPIN(cond, bar) do { unsigned _sp = 0; while (cond) { __builtin_amdgcn_s_sleep(1); \
    if ((++_sp & 255u) == 0u) { if (xb_ld(&(bar)[XB_TMO])) break; if (_sp > XB_SPIN_CAP) { atomicAdd(&(bar)[XB_TMO], 1u); break; } } } } while (0)

struct XcdBarrier {
    unsigned* bar; unsigned x;
    volatile LAS unsigned* st;
};

__device__ __forceinline__ XcdBarrier xcd_barrier_post(unsigned* bar, volatile LAS unsigned* st) {
    XcdBarrier b; b.bar = bar; b.x = xb_xcc_id(); b.st = st;
    if (threadIdx.x == 0) (void)xb_add(&bar[XB_XCNT(b.x)], 1u);
    return b;
}
__device__ __forceinline__ void xcd_barrier_complete(unsigned* bar, unsigned x, unsigned& nloc, unsigned& nx) {
    const unsigned G = gridDim.x * gridDim.y * gridDim.z;
    unsigned sum, cnt, mine, sp = 0u;
    for (;;) {
        sum = 0u; cnt = 0u; mine = 0u;
#pragma unroll
        for (unsigned j = 0; j < 16; ++j) { const unsigned c = xb_ld(&bar[XB_XCNT(j)]); sum += c; cnt += (c > 0u) ? 1u : 0u; mine = (j == x) ? c : mine; }
        if (sum == G) break;
        __builtin_amdgcn_s_sleep(1);
        if ((++sp & 255u) == 0u) { if (xb_ld(&bar[XB_TMO])) break; if (sp > XB_SPIN_CAP) { atomicAdd(&bar[XB_TMO], 1u); break; } }
    }
    nloc = mine > 0u ? mine : 1u; nx = cnt > 0u ? cnt : 1u;
}

__device__ __forceinline__ void xcd_barrier(const XcdBarrier& b) {
    asm volatile("s_waitcnt vmcnt(0)" ::: "memory");
    __syncthreads();
    if (threadIdx.x == 0) {
        unsigned* bar = b.bar;
        __builtin_amdgcn_s_waitcnt(0);
        unsigned nloc = b.st[0], nx = b.st[1];
        if (nloc == 0u) { xcd_barrier_complete(bar, b.x, nloc, nx); b.st[0] = nloc; b.st[1] = nx; }
        const unsigned old = xb_add(&bar[XB_XSUB(b.x)], 1u);
        const unsigned gen = old / nloc;
        if (old + 1u == (gen + 1u) * nloc) {
            __builtin_amdgcn_fence(__ATOMIC_RELEASE, "agent");
            asm volatile("s_waitcnt vmcnt(0)" ::: "memory");
            const unsigned og = xb_add(&bar[XB_TOP], 1u);
            const unsigned tg = og / nx;
            if (og + 1u == (tg + 1u) * nx) xb_add(&bar[XB_TOPGEN], 1u);
            else XB_SPIN(xb_ld(&bar[XB_TOPGEN]) == tg, bar);
            __builtin_amdgcn_fence(__ATOMIC_ACQUIRE, "agent");
            xb_add(&bar[XB_XGEN(b.x)], 1u);
            asm volatile("s_waitcnt vmcnt(0)" ::: "memory");
        } else {
            XB_SPIN(xb_ld(&bar[XB_XGEN(b.x)]) == gen, bar);
            __builtin_amdgcn_fence(__ATOMIC_ACQUIRE, "agent");
            asm volatile("s_waitcnt vmcnt(0)" ::: "memory");
        }
    }
    __syncthreads();
}

struct Frame {
    LAS unsigned char* lds;
    volatile LAS unsigned* MISC;
    gu32* ctl;
    int tid, lane, wave, G;
    const float *x, *c, *ctx, *cctx, *w_ada, *b_ada, *norm1_w, *w_in, *rpb, *sgu_norm_w, *sgu_w, *sgu_b, *gna, *gsgu, *w_out, *norm2_w, *w_ff1, *w_ff2, *fnw;
    float* out;
    float *modf, *part, *ssna, *sssg;
    bf16 *Wt_in, *Wt_out, *Wt_ff1, *Wt_ff2, *A1, *QB, *KB, *VT, *UB, *GT, *A2, *HB;
};
__device__ __forceinline__ float wave_sum(float v) {
#pragma unroll
    for (int o = 1; o < 64; o <<= 1) v += __shfl_xor(v, o);
    return v;
}
__device__ __forceinline__ void p0_transpose_item(const float* W, int K, int N, bf16* WT, const float* gA, const float* gB, LAS float* scr, int item, int lane) {
    const int nblk = N / 32, kb = item / nblk, nb = item % nblk, k0 = 64 * kb, n0 = 32 * nb;
    const float* kg = gA ? (k0 < 2048 ? gA + k0 : gB + (k0 - 2048)) : nullptr;
#pragma unroll 8
    for (int i = 0; i < 32; ++i) { const int kk = 2 * i + (lane >> 5); float v = W[(size_t)(k0 + kk) * N + n0 + (lane & 31)]; if (kg) v *= kg[kk]; scr[kk * 33 + (lane & 31)] = v; }
    LDS_WAIT(); asm volatile("" ::: "memory");
    const int c = lane & 7;
#pragma unroll
    for (int j = 0; j < 4; ++j) { const int n = (lane >> 3) + 8 * j; const LAS float* s = scr + (8 * c) * 33 + n;
        v4u o; o.x = pk2(s[0 * 33], s[1 * 33]); o.y = pk2(s[2 * 33], s[3 * 33]); o.z = pk2(s[4 * 33], s[5 * 33]); o.w = pk2(s[6 * 33], s[7 * 33]);
        *(GAS v4u*)(WT + (size_t)(n0 + n) * K + k0 + 8 * c) = o; }
    LDS_WAIT(); asm volatile("" ::: "memory");
}
__device__ __forceinline__ float silu_f(float v) { return v / (1.0f + __expf(-v)); }
__device__ __forceinline__ void p0_ada_item(Frame& F, int item, LAS float* sil) {
    const int s = item % ADA_STRIPS, ks = item / ADA_STRIPS, k0 = ks * 256, lane = F.lane;
#pragma unroll
    for (int r = 0; r < 5; ++r) { const float* src = (r < 4) ? F.c + r * D : F.cctx; const f32x4 v = *(const f32x4*)(src + k0 + 4 * lane);
        f32x4 o; o.x = silu_f(v.x); o.y = silu_f(v.y); o.z = silu_f(v.z); o.w = silu_f(v.w); *(LAS f32x4*)(sil + r * 256 + 4 * lane) = o; }
    LDS_WAIT(); asm volatile("" ::: "memory");
    f32x4 acc[5];
#pragma unroll
    for (int r = 0; r < 5; ++r) acc[r] = (f32x4){0.f, 0.f, 0.f, 0.f};
    const float* wp = F.w_ada + (size_t)k0 * NMODC + 256 * s + 4 * lane;
#pragma unroll 8
    for (int kk = 0; kk < 256; ++kk) { const f32x4 w = *(const f32x4*)(wp + (size_t)kk * NMODC);
#pragma unroll
        for (int r = 0; r < 5; ++r) acc[r] += w * sil[r * 256 + kk]; }
#pragma unroll
    for (int r = 0; r < 5; ++r) *(f32x4*)(F.part + (size_t)(ks * 5 + r) * NMODC + 256 * s + 4 * lane) = acc[r];
    LDS_WAIT(); asm volatile("" ::: "memory");
}
__device__ __forceinline__ void p0_prologue(Frame& F) {
    LAS float* scr = (LAS float*)(F.lds + RING_OFF + F.wave * 16384);
    LAS float* sil = (LAS float*)(F.lds + RING_OFF + F.wave * 16384 + 8704);
    const int gw = (int)blockIdx.x * NWAVES + F.wave, NGW = F.G * NWAVES;
    constexpr int I_ADA = ADA_KS * ADA_STRIPS;
    constexpr int I_IN = (D / 64) * (DIN / 32), I_OUT = (D / 64) * (D / 32), I_F1 = (D / 64) * (DFF / 32), I_F2 = (DFF / 64) * (D / 32);
    constexpr int NITEMS = I_ADA + I_IN + I_OUT + I_F1 + I_F2;
    for (int it = gw; it < NITEMS; it += NGW) {
        int r = it;
        if (r < I_ADA) { p0_ada_item(F, r, sil); continue; } r -= I_ADA;
        if (r < I_IN) { p0_transpose_item(F.w_in, D, DIN, F.Wt_in, nullptr, nullptr, scr, r, F.lane); continue; } r -= I_IN;
        if (r < I_OUT) { p0_transpose_item(F.w_out, D, D, F.Wt_out, F.gna, F.gsgu, scr, r, F.lane); continue; } r -= I_OUT;
        if (r < I_F1) { p0_transpose_item(F.w_ff1, D, DFF, F.Wt_ff1, nullptr, nullptr, scr, r, F.lane); continue; } r -= I_F1;
        p0_transpose_item(F.w_ff2, DFF, D, F.Wt_ff2, nullptr, nullptr, scr, r, F.lane);
    }
}
__device__ __forceinline__ f32x4 ld4(const float* p) { return *(const f32x4*)p; }
__device__ __forceinline__ f32x4 ld4(const LAS float* p) { return *(const LAS f32x4*)p; }
template <class SP> __device__ __forceinline__ void row_norm_mod(const float* xrow, const float* nw, SP sh, SP sc, bf16* orow, int lane) {
    const f32x4* xr = (const f32x4*)xrow + lane;
    f32x4 v[16]; float ss = 0.f;
#pragma unroll
    for (int j = 0; j < 16; ++j) { v[j] = xr[64 * j]; ss += (v[j].x * v[j].x + v[j].y * v[j].y) + (v[j].z * v[j].z + v[j].w * v[j].w); }
    const float rstd = rsqrtf(wave_sum(ss) * (1.0f / D) + EPS);
#pragma unroll
    for (int j = 0; j < 16; ++j) { const int col = 4 * lane + 256 * j;
        const f32x4 w4 = ld4(nw + col), s4 = ld4(sc + col), h4 = ld4(sh + col);
        const f32x4 o = v[j] * rstd * w4 * (s4 + 1.0f) + h4;
        v2u pk; pk.x = pk2(o.x, o.y); pk.y = pk2(o.z, o.w);
        *(v2u*)(orow + col) = pk; }
}
__device__ __forceinline__ void p1_rows(Frame& F) {
    LAS float* modL = (LAS float*)(F.lds + RING_OFF);
    const int bx = (int)blockIdx.x, b = bx >> 6;
    for (int i = F.tid; i < 2 * D; i += NWAVES * 64) { float s0 = F.b_ada[i], s1 = s0;
#pragma unroll 4
        for (int sp = 0; sp < ADA_KS; ++sp) { s0 += F.part[(size_t)(sp * 5 + b) * NMODC + i]; s1 += F.part[(size_t)(sp * 5 + 4) * NMODC + i]; }
        modL[i] = s0; modL[2 * D + i] = s1; }
    if (F.tid < 480) { const int idx = bx * 480 + F.tid, r = idx / NMODC, j = idx % NMODC; float s = F.b_ada[j];
#pragma unroll 4
        for (int sp = 0; sp < ADA_KS; ++sp) s += F.part[(size_t)(sp * 5 + r) * NMODC + j];
        F.modf[idx] = s; }
    __syncthreads();
    for (int rr = F.wave; rr < 64; rr += NWAVES) { const int row = 64 * bx + rr;
        row_norm_mod<const LAS float*>(F.x + (size_t)row * D, F.norm1_w, modL, modL + D, F.A1 + (size_t)row * D, F.lane); }
    if (F.wave < 4) { const int row = 4 * bx + F.wave;
        row_norm_mod<const LAS float*>(F.ctx + (size_t)row * D, F.norm1_w, modL + 2 * D, modL + 3 * D, F.A1 + (size_t)(M + row) * D, F.lane); }
}
__device__ __forceinline__ void p4_grpnorm(Frame& F) {
    const int gw = (int)blockIdx.x * NWAVES + F.wave, NGW = F.G * NWAVES;
    for (int m = gw; m < M; m += NGW) {
        float sa = 0.f, sg = 0.f;
#pragma unroll
        for (int i = 0; i < 4; ++i) { const f32x4 t = *(const f32x4*)(F.ssna + (size_t)m * 16 + 4 * i); sa += (t.x + t.y) + (t.z + t.w); }
        { const f32x4 t = *(const f32x4*)(F.sssg + (size_t)m * 4); sg = (t.x + t.y) + (t.z + t.w); }
        const float rna = rsqrtf(sa * (1.0f / DNA) + EPS), rsg = rsqrtf(sg * (1.0f / DSGU) + EPS);
        v4u* p = (v4u*)(F.A2 + (size_t)m * D) + F.lane;
#pragma unroll
        for (int j = 0; j < 8; ++j) { v4u w = p[64 * j]; const float r = (j < 4) ? rna : rsg;
            w.x = pk2(bf_lo(w.x) * r, bf_hi(w.x) * r); w.y = pk2(bf_lo(w.y) * r, bf_hi(w.y) * r); w.z = pk2(bf_lo(w.z) * r, bf_hi(w.z) * r); w.w = pk2(bf_lo(w.w) * r, bf_hi(w.w) * r);
            p[64 * j] = w; }
    }
}
__device__ __forceinline__ void p6_rows(Frame& F) {
    const int gw = (int)blockIdx.x * NWAVES + F.wave, NGW = F.G * NWAVES;
    for (int m = gw; m < M; m += NGW) { const float* mf = F.modf + (size_t)(m >> 12) * NMODC;
        row_norm_mod<const float*>(F.out + (size_t)m * D, F.norm2_w, mf + 3 * D, mf + 4 * D, F.A1 + (size_t)m * D, F.lane); }
}
__device__ __forceinline__ void p9_final(Frame& F) {
    const int gw = (int)blockIdx.x * NWAVES + F.wave, NGW = F.G * NWAVES;
    for (int m = gw; m < M; m += NGW) {
        f32x4* xr = (f32x4*)(F.out + (size_t)m * D) + F.lane;
        f32x4 v[16]; float ss = 0.f;
#pragma unroll
        for (int j = 0; j < 16; ++j) { v[j] = xr[64 * j]; ss += (v[j].x * v[j].x + v[j].y * v[j].y) + (v[j].z * v[j].z + v[j].w * v[j].w); }
        const float rstd = rsqrtf(wave_sum(ss) * (1.0f / D) + EPS);
#pragma unroll
        for (int j = 0; j < 16; ++j) xr[64 * j] = v[j] * rstd * ld4(F.fnw + 4 * F.lane + 256 * j);
    }
}
struct SguTile { bf16x8 gf[4]; f32x4 nw; v2u uu; };
__device__ __forceinline__ void sgu_load(SguTile& t, const bf16* gp, const float* nwp, const bf16* up, int ct) {
#pragma unroll
    for (int ks = 0; ks < 4; ++ks) t.gf[ks] = *(const bf16x8*)(gp + (size_t)(16 * ct) * M + ks * 32);
    t.nw = *(const f32x4*)(nwp + 16 * ct); t.uu = *(const v2u*)(up + 16 * ct);
}
__device__ __forceinline__ void sgu_compute(const SguTile& t, const bf16x8 (&wf)[4], float bias, float& ssq, bf16* op, int ct) {
    f32x4 d = (f32x4){0.f, 0.f, 0.f, 0.f};
#pragma unroll
    for (int ks = 0; ks < 4; ++ks) d = __builtin_amdgcn_mfma_f32_16x16x32_bf16(t.gf[ks], wf[ks], d, 0, 0, 0);
    const float o0 = bf_lo(t.uu.x) * (t.nw.x * d[0] + bias), o1 = bf_hi(t.uu.x) * (t.nw.y * d[1] + bias), o2 = bf_lo(t.uu.y) * (t.nw.z * d[2] + bias), o3 = bf_hi(t.uu.y) * (t.nw.w * d[3] + bias);
    ssq += (o0 * o0 + o1 * o1) + (o2 * o2 + o3 * o3);
    v2u pk; pk.x = pk2(o0, o1); pk.y = pk2(o2, o3);
    *(v2u*)(op + 16 * ct) = pk;
}
__device__ __forceinline__ void sgu_unit(Frame& F, int b, int n, int grp) {
    const int lane = F.lane, w = F.wave, l15 = lane & 15, g = lane >> 4;
    const int tok0 = b * SEQ + n * 128, cbase = grp * 512;
    LAS float* part = (LAS float*)(F.lds + RING_OFF);
    LAS float* rgs = part + 16 * 128;
    {
        const int hp = lane >> 5, t4 = 4 * (lane & 31);
        float a0 = 0.f, a1 = 0.f, a2 = 0.f, a3 = 0.f;
        const bf16* gp = F.GT + (size_t)(256 * w + hp) * M + tok0 + t4;
#pragma unroll 32
        for (int cc = 0; cc < 128; ++cc) { const v2u v = *(const v2u*)(gp + (size_t)(2 * cc) * M);
            const float f0 = bf_lo(v.x), f1 = bf_hi(v.x), f2 = bf_lo(v.y), f3 = bf_hi(v.y); a0 += f0 * f0; a1 += f1 * f1; a2 += f2 * f2; a3 += f3 * f3; }
        *(LAS f32x4*)(part + (w * 2 + hp) * 128 + t4) = (f32x4){a0, a1, a2, a3};
    }
    __syncthreads();
    if (F.tid < 128) { float s = 0.f;
#pragma unroll
        for (int i = 0; i < 16; ++i) s += part[i * 128 + F.tid];
        rgs[F.tid] = rsqrtf(s * (1.0f / DSGU) + EPS); }
    __syncthreads();
    const int p = 16 * w + l15, token = tok0 + p;
    bf16x8 wf[4];
#pragma unroll
    for (int ks = 0; ks < 4; ++ks) { const int q0 = ks * 32 + 8 * g; const float* wp = F.sgu_w + (size_t)(grp * 128 + p) * 128 + q0;
        const f32x4 w0 = *(const f32x4*)wp, w1 = *(const f32x4*)(wp + 4); const f32x4 r0 = *(const LAS f32x4*)(rgs + q0), r1 = *(const LAS f32x4*)(rgs + q0 + 4);
        v4u pk; pk.x = pk2(w0.x * r0.x, w0.y * r0.y); pk.y = pk2(w0.z * r0.z, w0.w * r0.w); pk.z = pk2(w1.x * r1.x, w1.y * r1.y); pk.w = pk2(w1.z * r1.z, w1.w * r1.w);
        wf[ks] = __builtin_bit_cast(bf16x8, pk); }
    const float bias = F.sgu_b[grp * 128 + p];
    float ssq = 0.f;
    const bf16* gp = F.GT + (size_t)(cbase + l15) * M + tok0 + 8 * g;
    const float* nwp = F.sgu_norm_w + cbase + 4 * g;
    const bf16* up = F.UB + (size_t)token * DSGU + cbase + 4 * g;
    bf16* op = F.A2 + (size_t)token * D + DNA + cbase + 4 * g;
    SguTile ta, tb, tc, td;
    sgu_load(ta, gp, nwp, up, 0); sgu_load(tb, gp, nwp, up, 1); sgu_load(tc, gp, nwp, up, 2);
    for (int ct = 0; ct < 32; ct += 4) {
        sgu_load(td, gp, nwp, up, ct + 3);
        sgu_compute(ta, wf, bias, ssq, op, ct);
        if (ct + 4 < 32) sgu_load(ta, gp, nwp, up, ct + 4);
        sgu_compute(tb, wf, bias, ssq, op, ct + 1);
        if (ct + 5 < 32) sgu_load(tb, gp, nwp, up, ct + 5);
        sgu_compute(tc, wf, bias, ssq, op, ct + 2);
        if (ct + 6 < 32) sgu_load(tc, gp, nwp, up, ct + 6);
        sgu_compute(td, wf, bias, ssq, op, ct + 3);
    }
    ssq += __shfl_xor(ssq, 16); ssq += __shfl_xor(ssq, 32);
    if (g == 0) F.sssg[(size_t)token * 4 + grp] = ssq;
    __syncthreads();
}
constexpr int CK_STRIDE = 272, CV_STRIDE = 528;
constexpr int CK_OFF = 0, CV_OFF = 256 * CK_STRIDE, RPB_OFF = CV_OFF + 128 * CV_STRIDE + 64, ATT_LDS_END = RPB_OFF + 15 * 31 * 4 + 256;
static_assert(ATT_LDS_END <= LDSCTL_OFF, "attention LDS image below the control words");
__device__ __forceinline__ float xrow16_max(float x) {
    auto s = __builtin_amdgcn_permlane16_swap(__float_as_uint(x), __float_as_uint(x), false, false);
    x = fmaxf(__uint_as_float(s[0]), __uint_as_float(s[1]));
    auto t = __builtin_amdgcn_permlane32_swap(__float_as_uint(x), __float_as_uint(x), false, false);
    return fmaxf(__uint_as_float(t[0]), __uint_as_float(t[1]));
}
__device__ __forceinline__ float xrow16_sum(float x) {
    auto s = __builtin_amdgcn_permlane16_swap(__float_as_uint(x), __float_as_uint(x), false, false);
    x = __uint_as_float(s[0]) + __uint_as_float(s[1]);
    auto t = __builtin_amdgcn_permlane32_swap(__float_as_uint(x), __float_as_uint(x), false, false);
    return __uint_as_float(t[0]) + __uint_as_float(t[1]);
}
__device__ __forceinline__ void win_load_k(bf16x8 (&k)[2][4], const bf16* kb, int T0) {
#pragma unroll
    for (int tt = 0; tt < 2; ++tt)
#pragma unroll
        for (int ds = 0; ds < 4; ++ds) k[tt][ds] = *(const bf16x8*)(kb + (size_t)(T0 + 4 * tt) * DNA + ds * 32);
}
__device__ __forceinline__ void win_load_v(bf16x8 (&v)[8], const bf16* vb, int T0) {
#pragma unroll
    for (int dt = 0; dt < 8; ++dt) v[dt] = *(const bf16x8*)(vb + (size_t)(dt * 16) * MA + T0);
}
__device__ __forceinline__ void attn_scores(const bf16x8 (&k)[2][4], const bf16x8 (&qf)[4], f32x4 (&s)[2]) {
#pragma unroll
    for (int tt = 0; tt < 2; ++tt) { s[tt] = (f32x4){0.f, 0.f, 0.f, 0.f};
#pragma unroll
        for (int ds = 0; ds < 4; ++ds) s[tt] = __builtin_amdgcn_mfma_f32_16x16x32_bf16(k[tt][ds], qf[ds], s[tt], 0, 0, 0); }
}
template <bool WIN> __device__ __forceinline__ bf16x8 attn_softmax(f32x4 (&s)[2], const LAS float* bp, int lo, f32x4 (&o)[8], float& mrun, float& lrun) {
    if (WIN) {
        float bv[8];
#pragma unroll
        for (int i = 0; i < 8; ++i) bv[i] = bp[i];
        asm volatile("" : "+v"(bv[0]), "+v"(bv[1]), "+v"(bv[2]), "+v"(bv[3]), "+v"(bv[4]), "+v"(bv[5]), "+v"(bv[6]), "+v"(bv[7]));
#pragma unroll
        for (int i = 0; i < 8; ++i) { const bool valid = (unsigned)(i - lo) < 16u; s[i >> 2][i & 3] = valid ? s[i >> 2][i & 3] + bv[i] : -1e30f; }
    }
    float mx = fmaxf(fmaxf(fmaxf(s[0][0], s[0][1]), fmaxf(s[0][2], s[0][3])), fmaxf(fmaxf(s[1][0], s[1][1]), fmaxf(s[1][2], s[1][3])));
    mx = xrow16_max(mx);
    if (__builtin_amdgcn_ballot_w64(mx > mrun + 8.0f)) {
        const float mn = fmaxf(mrun, mx), alpha = __builtin_amdgcn_exp2f(mrun - mn); mrun = mn; lrun *= alpha;
#pragma unroll
        for (int dt = 0; dt < 8; ++dt) o[dt] *= alpha;
    }
    float ps = 0.f;
#pragma unroll
    for (int tt = 0; tt < 2; ++tt)
#pragma unroll
        for (int rg = 0; rg < 4; ++rg) { s[tt][rg] = __builtin_amdgcn_exp2f(s[tt][rg] - mrun); ps += s[tt][rg]; }
    lrun += ps;
    v4u pk; pk.x = pk2(s[0][0], s[0][1]); pk.y = pk2(s[0][2], s[0][3]); pk.z = pk2(s[1][0], s[1][1]); pk.w = pk2(s[1][2], s[1][3]);
    return __builtin_bit_cast(bf16x8, pk);
}
__device__ __forceinline__ void attn_pv(const bf16x8 (&v)[8], bf16x8 pf, f32x4 (&o)[8]) {
#pragma unroll
    for (int dt = 0; dt < 8; ++dt) o[dt] = __builtin_amdgcn_mfma_f32_16x16x32_bf16(v[dt], pf, o[dt], 0, 0, 0);
}
__device__ __forceinline__ void attn_pair(Frame& F, int b, int h, int P, int j) {
    const int lane = F.lane, q = lane & 15, g = lane >> 4;
    const int rA = 2 * P, rB = rA + 1;
    const int qcol = 16 * j + q, qtokA = b * SEQ + rA * GW + qcol, qtokB = qtokA + GW;
    int r0A = rA - 4; r0A = r0A < 0 ? 0 : (r0A > 56 ? 56 : r0A);
    int r0B = rB - 4; r0B = r0B < 0 ? 0 : (r0B > 56 ? 56 : r0B);
    const int dB = r0B - r0A;
    int cs = qcol - 8; cs = cs < 0 ? 0 : (cs > 48 ? 48 : cs);
    const int band0 = (j == 0) ? 0 : (j == 1 ? 8 : (j == 2 ? 24 : 32));
    bf16x8 qfA[4], qfB[4];
#pragma unroll
    for (int ds = 0; ds < 4; ++ds) { qfA[ds] = *(const bf16x8*)(F.QB + (size_t)qtokA * DNA + h * HD + ds * 32 + 8 * g); qfB[ds] = *(const bf16x8*)(F.QB + (size_t)qtokB * DNA + h * HD + ds * 32 + 8 * g); }
    f32x4 oA[8], oB[8];
#pragma unroll
    for (int dt = 0; dt < 8; ++dt) { oA[dt] = (f32x4){0.f, 0.f, 0.f, 0.f}; oB[dt] = (f32x4){0.f, 0.f, 0.f, 0.f}; }
    float mA = -1e30f, lA = 0.f, mB = -1e30f, lB = 0.f;
    const bf16* kb = F.KB + (size_t)(8 * (q >> 2) + (q & 3)) * DNA + h * HD + 8 * g;
    const bf16* vb = F.VT + (size_t)(h * HD + q) * MA + 8 * g;
    const int lo = cs - (band0 + 8 * g);
    const LAS float* rpA = (const LAS float*)(F.lds + RPB_OFF) + (r0A - rA + 7) * 31 + (band0 + 8 * g - qcol + 15);
    const int Tw = b * SEQ + r0A * GW + band0;
    const int last = 7 + dB;
    bf16x8 Kf[2][4], Vf[8];
    win_load_k(Kf, kb, Tw); win_load_v(Vf, vb, Tw);
#pragma unroll
    for (int st = 0; st < 9; ++st) {
        if (st == 8 && dB == 0) break;
        const bool doA = st < 8, doB = (st >= 1 || dB == 0) && (st < 8 || dB == 1);
        f32x4 sA[2], sB[2];
        if (doA) attn_scores(Kf, qfA, sA);
        if (doB) attn_scores(Kf, qfB, sB);
        __builtin_amdgcn_sched_barrier(0);
        if (st + 1 <= last) win_load_k(Kf, kb, Tw + (st + 1) * GW);
        bf16x8 pfA, pfB;
        if (doA) pfA = attn_softmax<true>(sA, rpA + st * 31, lo, oA, mA, lA);
        if (doB) pfB = attn_softmax<true>(sB, rpA + (st - 1) * 31, lo, oB, mB, lB);
        if (doA && doB) asm volatile("" : "+v"(pfA), "+v"(pfB));
        if (doA) attn_pv(Vf, pfA, oA);
        if (doB) attn_pv(Vf, pfB, oB);
        __builtin_amdgcn_sched_barrier(0);
        if (st + 1 <= last) win_load_v(Vf, vb, Tw + (st + 1) * GW);
    }
    {
        const LAS unsigned char* ck = F.lds + CK_OFF + q * CK_STRIDE + 16 * g;
        const LAS unsigned char* cv = F.lds + CV_OFF + q * CV_STRIDE + 16 * g;
#pragma unroll 2
        for (int sbk = 0; sbk < 8; ++sbk) {
            bf16x8 kc[2][4], vc[8];
#pragma unroll
            for (int tt = 0; tt < 2; ++tt)
#pragma unroll
                for (int ds = 0; ds < 4; ++ds) kc[tt][ds] = *(const LAS bf16x8*)(ck + (sbk * 32 + tt * 16) * CK_STRIDE + ds * 64);
#pragma unroll
            for (int dt = 0; dt < 8; ++dt) vc[dt] = *(const LAS bf16x8*)(cv + (dt * 16) * CV_STRIDE + sbk * 64);
            f32x4 sA[2], sB[2];
            attn_scores(kc, qfA, sA); attn_scores(kc, qfB, sB);
            bf16x8 pfA = attn_softmax<false>(sA, nullptr, 0, oA, mA, lA);
            bf16x8 pfB = attn_softmax<false>(sB, nullptr, 0, oB, mB, lB);
            asm volatile("" : "+v"(pfA), "+v"(pfB));
            attn_pv(vc, pfA, oA); attn_pv(vc, pfB, oB);
        }
    }
#pragma unroll
    for (int rr = 0; rr < 2; ++rr) {
        f32x4 (&o)[8] = rr ? oB : oA; const int qtok = rr ? qtokB : qtokA;
        const float lsum = xrow16_sum(rr ? lB : lA);
        const float inv = 1.0f / lsum; float ssq = 0.f;
        bf16* op = F.A2 + (size_t)qtok * D + h * HD + 4 * g;
#pragma unroll
        for (int dt = 0; dt < 8; ++dt) { const f32x4 v = o[dt] * inv; ssq += (v.x * v.x + v.y * v.y) + (v.z * v.z + v.w * v.w);
            v2u pk; pk.x = pk2(v.x, v.y); pk.y = pk2(v.z, v.w); *(v2u*)(op + dt * 16) = pk; }
        ssq = xrow16_sum(ssq);
        if (g == 0) F.ssna[(size_t)qtok * 16 + h] = ssq;
    }
}
__device__ __forceinline__ void p3_mixers(Frame& F) {
    __syncthreads();
    for (int rep = 0; rep < REPS(31); ++rep)
    for (int uid = (int)blockIdx.x; uid < BATCH * 32 * 4; uid += F.G) sgu_unit(F, uid >> 7, (uid >> 2) & 31, uid & 3);
    const int xcd = (int)blockIdx.x & 7, li = (int)blockIdx.x >> 3, bh = xcd * 8 + (li >> 2), b = bh >> 4, h = bh & 15, wi = li & 3;
    {
        for (int ch = F.tid; ch < 4096; ch += NWAVES * 64) { const int row = ch >> 4, c16 = ch & 15, k = row & 31;
            const int pos = (row & ~31) + ((k >> 2) & 1) * 16 + 4 * (k >> 3) + (k & 3);
            const v4u v = *(const v4u*)(F.KB + (size_t)(M + b * CTX + row) * DNA + h * HD + c16 * 8);
            *(LAS v4u*)(F.lds + CK_OFF + pos * CK_STRIDE + c16 * 16) = v; }
        for (int ch = F.tid; ch < 4096; ch += NWAVES * 64) { const int row = ch >> 5, c16 = ch & 31;
            const v4u v = *(const v4u*)(F.VT + (size_t)(h * HD + row) * MA + M + b * CTX + c16 * 8);
            *(LAS v4u*)(F.lds + CV_OFF + row * CV_STRIDE + c16 * 16) = v; }
        for (int i = F.tid; i < 15 * 31; i += NWAVES * 64) ((LAS float*)(F.lds + RPB_OFF))[i] = F.rpb[h * 15 * 31 + i] * LOG2E;
    }
    __syncthreads();
    for (int rep = 0; rep < REPS(32); ++rep)
    for (int t = 0; t < 4; ++t) attn_pair(F, b, h, 8 * t + 2 * wi + (F.wave >> 2), F.wave & 3);
}

struct Args { const float* in[19]; float* out; unsigned char* ws; int ph_lo, ph_hi; };
__global__ void __launch_bounds__(NWAVES * 64, 2) mk_fwd(Args args) {
    extern __shared__ __attribute__((aligned(16))) unsigned char lds[];
    Frame F;
    F.lds = (LAS unsigned char*)lds;
    F.MISC = (volatile LAS unsigned*)(F.lds + MISC_OFF);
    F.tid = threadIdx.x; F.lane = F.tid & 63; F.wave = __builtin_amdgcn_readfirstlane(F.tid >> 6);
    F.G = gridDim.x;
    unsigned char* ws = args.ws;
    F.ctl = (gu32*)(ws + WS_CTL);
    F.x = args.in[0]; F.c = args.in[1]; F.ctx = args.in[2]; F.cctx = args.in[3]; F.w_ada = args.in[4]; F.b_ada = args.in[5]; F.norm1_w = args.in[6]; F.w_in = args.in[7]; F.rpb = args.in[8];
    F.sgu_norm_w = args.in[9]; F.sgu_w = args.in[10]; F.sgu_b = args.in[11]; F.gna = args.in[12]; F.gsgu = args.in[13]; F.w_out = args.in[14]; F.norm2_w = args.in[15];
    F.w_ff1 = args.in[16]; F.w_ff2 = args.in[17]; F.fnw = args.in[18]; F.out = args.out;
    F.modf = (float*)(ws + WS_MODF); F.part = (float*)(ws + WS_PART); F.ssna = (float*)(ws + WS_SSNA); F.sssg = (float*)(ws + WS_SSSG);
    F.Wt_in = (bf16*)(ws + WS_WIN); F.Wt_out = (bf16*)(ws + WS_WOUT); F.Wt_ff1 = (bf16*)(ws + WS_WFF1); F.Wt_ff2 = (bf16*)(ws + WS_WFF2);
    F.A1 = (bf16*)(ws + WS_A1); F.QB = (bf16*)(ws + WS_Q); F.KB = (bf16*)(ws + WS_K); F.VT = (bf16*)(ws + WS_VT); F.UB = (bf16*)(ws + WS_U); F.GT = (bf16*)(ws + WS_GT);
    F.A2 = (bf16*)(ws + WS_A2); F.HB = (bf16*)(ws + WS_H);
    for (int u = F.tid; u < (LDS_BYTES - LDSCTL_OFF) / 4; u += NWAVES * 64) ((LAS unsigned*)(F.lds + LDSCTL_OFF))[u] = 0u;
    __syncthreads();
    XcdBarrier bar; bar.bar = (unsigned*)(F.ctl + CW_BAR); bar.x = 0; bar.st = nullptr;
    if (MK_N_LAUNCHES == 1) bar = xcd_barrier_post((unsigned*)(F.ctl + CW_BAR), F.MISC + 8);
    const int lo = args.ph_lo, hi = args.ph_hi;
#define IN(k) (lo <= (k) && (k) < hi)
#define SEAM(k) do { if (IN(k) && IN((k) + 1)) xcd_barrier(bar); } while (0)

    if (IN(0)) { for (int rep = 0; rep < REPS(0); ++rep) p0_prologue(F); } SEAM(0);
    if (IN(1)) { p1_rows(F); } SEAM(1);
    if (IN(2)) {
        pg8::Gemm g{F.A1, F.Wt_in, MA, DIN, D}; pg8::InProjOrder S; S.G = F.G; S.c = (int)blockIdx.x;
        pg8::EpiInProj E{F.QB, WS_SLOT / 2, 0.08838834764831845f * LOG2E};
        pg8::gemm_phase<pg8::EpiInProj, pg8::InProjOrder, true, true>(F.lds + RING_OFF, g, S, E);
    } SEAM(2);
    if (IN(3)) { for (int rep = 0; rep < REPS(3); ++rep) p3_mixers(F); } SEAM(3);
    if (IN(4)) { p4_grpnorm(F); } SEAM(4);
    if (IN(5)) {
        pg8::Gemm g{F.A2, F.Wt_out, M, D, D}; pg8::StdOrder S; S.init(M, D, F.G, (int)blockIdx.x);
        pg8::EpiGatedRes E{F.x, F.out, D, F.modf + 2 * D, NMODC};
        pg8::gemm_phase<pg8::EpiGatedRes, pg8::StdOrder, true, true>(F.lds + RING_OFF, g, S, E);
    } SEAM(5);
    if (IN(6)) { p6_rows(F); } SEAM(6);
    if (IN(7)) for (int rep = 0; rep < REPS(7); ++rep) {
        pg8::Gemm g{F.A1, F.Wt_ff1, M, DFF, D}; pg8::StdOrder S; S.init(M, DFF, F.G, (int)blockIdx.x);
        pg8::EpiRelu2 E{F.HB, DFF};
        pg8::gemm_phase<pg8::EpiRelu2, pg8::StdOrder, true, true>(F.lds + RING_OFF, g, S, E);
    } SEAM(7);
    if (IN(8)) {
        pg8::Gemm g{F.HB, F.Wt_ff2, M, D, DFF}; pg8::StdOrder S; S.init(M, D, F.G, (int)blockIdx.x);
        pg8::EpiGatedRes E{F.out, F.out, D, F.modf + 5 * D, NMODC};
        pg8::gemm_phase<pg8::EpiGatedRes, pg8::StdOrder, true, true>(F.lds + RING_OFF, g, S, E);
    } SEAM(8);
    if (IN(9)) { p9_final(F); }
#undef IN
#undef SEAM
}

extern "C" void kernel_launch(void* const* d_in, const int* in_sizes, int n_in, void* d_out, int out_size, void* d_ws, size_t ws_size, hipStream_t stream) {
    static int grid = 0;
    if (grid == 0) {
        if (n_in != 19 || in_sizes[0] != M * D || out_size != M * D || ws_size < WS_END) { fprintf(stderr, "kernel_launch: unexpected shapes / workspace (%zu)\n", ws_size); grid = -1; return; }
        int dev = 0, cus = 0, per_cu = 0;
        if (hipGetDevice(&dev) != hipSuccess || hipDeviceGetAttribute(&cus, hipDeviceAttributeMultiprocessorCount, dev) != hipSuccess) { grid = -1; return; }
        if (hipFuncSetAttribute((const void*)mk_fwd, hipFuncAttributeMaxDynamicSharedMemorySize, LDS_BYTES) != hipSuccess) { grid = -1; return; }
        if (hipOccupancyMaxActiveBlocksPerMultiprocessor(&per_cu, (const void*)mk_fwd, NWAVES * 64, LDS_BYTES) != hipSuccess || per_cu < 1) { fprintf(stderr, "kernel_launch: occupancy query says %d\n", per_cu); }
        (void)hipGetLastError();
        if (cus < 256) { fprintf(stderr, "kernel_launch: needs 256 CUs, device has %d\n", cus); grid = -1; return; }
        grid = 256;
    }
    if (grid < 0) return;
    if (hipMemsetAsync((char*)d_ws + WS_CTL, 0, CTL_ZERO_BYTES, stream) != hipSuccess) return;
    Args a{};
    for (int i = 0; i < 19; ++i) a.in[i] = (const float*)d_in[i];
    a.out = (float*)d_out; a.ws = (unsigned char*)d_ws;
    if (MK_N_LAUNCHES == 1) { a.ph_lo = 0; a.ph_hi = N_PHASES; hipLaunchKernelGGL(mk_fwd, dim3(grid), dim3(NWAVES * 64), LDS_BYTES, stream, a); }
    else for (int p = 0; p < N_PHASES; ++p) { a.ph_lo = p; a.ph_hi = p + 1; hipLaunchKernelGGL(mk_fwd, dim3(grid), dim3(NWAVES * 64), LDS_BYTES, stream, a); }
}
```

```cpp
#include <hip/hip_runtime.h>
#include <cstdio>
#include <cstdint>
namespace pg8 {
#define PG8_LAS __attribute__((address_space(3)))
typedef unsigned short bf16_t;
typedef short bf16x8 __attribute__((ext_vector_type(8)));
typedef float f32x4 __attribute__((ext_vector_type(4)));
typedef unsigned u32x4 __attribute__((ext_vector_type(4)));
constexpr int BM = 256, BK = 64, HALF = 128, HTB = HALF * BK * 2  , STAGE_BYTES = 8 * HTB, NXCD = 8, WGM = 8;

__host__ __device__ __forceinline__ int lds_byte(int r, int c) { const int st = (r >> 4) * 2 + (c >> 5), rr = r & 15, cc = c & 31, ob = rr * 64 + cc * 2; return st * 1024 + (ob ^ (((ob >> 9) & 1) << 5)); }
__host__ __device__ __forceinline__ void stage_rc(int b, int& R, int& C) { const int st = b / 1024, sb = b % 1024, swz = sb ^ (((sb >> 9) & 1) << 5); R = (st >> 1) * 16 + swz / 64; C = (st & 1) * 32 + (swz % 64) / 2; }
__host__ __device__ __forceinline__ int perm32(int rho) { const int n = rho >> 4, i = rho & 15; return 8 * (i >> 2) + 4 * n + (i & 3); }

struct Unit { int pm, pn; };
struct Gemm { const bf16_t* A; const bf16_t* Bt; int M, N, K; };

__device__ __forceinline__ void std_map(int wgid, int nM, int nN, Unit& u) {
    const int nwg = nM * nN;
    { const int q = nwg / NXCD, r = nwg % NXCD, xcd = wgid % NXCD, off = wgid / NXCD; wgid = (xcd < r ? xcd * (q + 1) : r * (q + 1) + (xcd - r) * q) + off; }
    const int nig = WGM * nN, gid = wgid / nig, fm = gid * WGM, gsz = (nM - fm) < WGM ? (nM - fm) : WGM;
    u.pm = fm + ((wgid % nig) % gsz); u.pn = (wgid % nig) / gsz;
}
struct StdOrder {
    int nM, nN, nwg, G, c;
    __device__ void init(int M, int N, int G_, int c_) { nM = M / BM; nN = N / BM; nwg = nM * nN; G = G_; c = c_; }
    __device__ bool next(int i, Unit& u) const { const long L = (long)i * G + c; if (L >= nwg) return false; std_map((int)L, nM, nN, u); return true; }
    __device__ __forceinline__ void bases(const Unit& u, const Gemm& g, size_t tstep, const char*& a, const char*& b) const { a = (const char*)g.A + (size_t)u.pm * tstep; b = (const char*)g.Bt + (size_t)u.pn * tstep; }
    __device__ __forceinline__ void a_ready(const Unit&) const {}
    __device__ __forceinline__ void done(const Unit&) const {}
};
struct InProjOrder {
    int G, c;
    __device__ bool next(int i, Unit& u) const {
        const long L = (long)i * G + c;
        if (L < 2560) { std_map((int)L, 64, 40, u); return true; }
        if (L < 2624) { const int j = (int)L - 2560; u.pm = 64 + (j >> 4); u.pn = 8 + (j & 15); return true; }
        return false;
    }
    __device__ __forceinline__ void bases(const Unit& u, const Gemm& g, size_t tstep, const char*& a, const char*& b) const {
        const int ty = u.pn >> 3; const bool sw = (ty == 2) || (ty == 4);
        const char* act = (const char*)g.A + (size_t)u.pm * tstep; const char* w = (const char*)g.Bt + (size_t)u.pn * tstep;
        a = sw ? w : act; b = sw ? act : w;
    }
    __device__ __forceinline__ void a_ready(const Unit&) const {}
    __device__ __forceinline__ void done(const Unit&) const {}
};

__device__ __forceinline__ unsigned cvt_pk_bf16(float lo, float hi) { unsigned r; asm volatile("v_cvt_pk_bf16_f32 %0, %1, %2" : "=v"(r) : "v"(lo), "v"(hi)); return r; }
__device__ __forceinline__ f32x4 lds_ld4(const PG8_LAS float* p) { f32x4 v; asm volatile("ds_read_b128 %0, %1\n\ts_waitcnt lgkmcnt(0)" : "=v"(v) : "v"((unsigned)(size_t)p) : "memory"); return v; }
__device__ __forceinline__ float lds_ld1(const PG8_LAS float* p) { float v; asm volatile("ds_read_b32 %0, %1\n\ts_waitcnt lgkmcnt(0)" : "=v"(v) : "v"((unsigned)(size_t)p) : "memory"); return v; }
__device__ __forceinline__ float gelu_t(float x) { const float u = x * (0.7978845608f + 0.0356774081f * x * x); const float t = __builtin_amdgcn_exp2f(-2.8853900818f * u); return x * __builtin_amdgcn_rcpf(1.0f + t); }

struct EpiInProj {
    static constexpr bool PERM = true, AFTER_DRAIN = false, MIDK = false;
    __device__ __forceinline__ void midk(f32x4 (&)[2][2][4][2], int, int) const {}
    bf16_t* base0; size_t slot; float qscale;
    __device__ __forceinline__ void operator()(const f32x4 (&acc)[2][2][4][2], const Unit& u, int wr, int wc, int fr, int fq) const {
        const int ty = u.pn >> 3, sub = (u.pn & 7) * BM, tokb = u.pm * BM;
        bf16_t* base = base0 + (size_t)ty * slot; const bool sw = (ty == 2) || (ty == 4);
        const int ldc = (ty == 2) ? 17408 : ((ty == 4) ? 16384 : 2048), rb = sw ? sub : tokb, cb = sw ? tokb : sub;
        const float sc = (ty == 0) ? qscale : 1.f; const bool act = ty >= 3;
        const int row0 = rb + wr * 64 + fr, col0 = cb + wc * 32 + 8 * fq;
#pragma unroll
        for (int ai = 0; ai < 2; ++ai)
#pragma unroll
            for (int m = 0; m < 4; ++m) { bf16_t* rowp = base + (size_t)(row0 + ai * HALF + m * 16) * ldc + col0;
#pragma unroll
                for (int bj = 0; bj < 2; ++bj) { f32x4 v0 = acc[ai][bj][m][0] * sc, v1 = acc[ai][bj][m][1] * sc;
                    if (act) {
#pragma unroll
                        for (int j = 0; j < 4; ++j) { v0[j] = gelu_t(v0[j]); v1[j] = gelu_t(v1[j]); } }
                    u32x4 w; w.x = cvt_pk_bf16(v0[0], v0[1]); w.y = cvt_pk_bf16(v0[2], v0[3]); w.z = cvt_pk_bf16(v1[0], v1[1]); w.w = cvt_pk_bf16(v1[2], v1[3]);
                    *(u32x4*)(rowp + bj * HALF) = w; } }
    }
};
__device__ __forceinline__ float xrow_sum(float x) {
    auto s = __builtin_amdgcn_permlane16_swap(__float_as_uint(x), __float_as_uint(x), false, false);
    x = __uint_as_float(s[0]) + __uint_as_float(s[1]);
    auto t = __builtin_amdgcn_permlane32_swap(__float_as_uint(x), __float_as_uint(x), false, false);
    return __uint_as_float(t[0]) + __uint_as_float(t[1]);
}
typedef unsigned u32x2 __attribute__((ext_vector_type(2)));
struct EpiRelu2 {
    static constexpr bool PERM = true, AFTER_DRAIN = false, MIDK = false;
    bf16_t* O; int ldc; const PG8_LAS float* cb; const PG8_LAS float* rs;
    __device__ __forceinline__ void midk(f32x4 (&)[2][2][4][2], int, int) const {}
    __device__ __forceinline__ void operator()(const f32x4 (&acc)[2][2][4][2], const Unit& u, int wr, int wc, int fr, int fq) const {
        const int row0 = u.pm * BM + wr * 64 + fr, cin = wc * 32 + 8 * fq, col0 = u.pn * BM + cin;
        const PG8_LAS float* bp = cb + (u.pn >> 2) * BM + cin;
        f32x4 bv[2][2];
#pragma unroll
        for (int bj = 0; bj < 2; ++bj)
#pragma unroll
            for (int n = 0; n < 2; ++n) bv[bj][n] = lds_ld4(bp + bj * HALF + 4 * n);
#pragma unroll
        for (int ai = 0; ai < 2; ++ai)
#pragma unroll
            for (int m = 0; m < 4; ++m) { bf16_t* rowp = O + (size_t)(row0 + ai * HALF + m * 16) * ldc + col0; const float r = lds_ld1(rs + ai * HALF + wr * 64 + m * 16 + fr);
#pragma unroll
                for (int bj = 0; bj < 2; ++bj) { f32x4 v0 = acc[ai][bj][m][0] * r + bv[bj][0], v1 = acc[ai][bj][m][1] * r + bv[bj][1];
#pragma unroll
                    for (int j = 0; j < 4; ++j) { const float a = fmaxf(v0[j], 0.f), b = fmaxf(v1[j], 0.f); v0[j] = a * a; v1[j] = b * b; }
                    u32x4 w; w.x = cvt_pk_bf16(v0[0], v0[1]); w.y = cvt_pk_bf16(v0[2], v0[3]); w.z = cvt_pk_bf16(v1[0], v1[1]); w.w = cvt_pk_bf16(v1[2], v1[3]);
                    *(u32x4*)(rowp + bj * HALF) = w; } }
    }
};
struct EpiOutProj {
    static constexpr bool PERM = true, AFTER_DRAIN = false, MIDK = true;
    const float* x; bf16_t* x1b; bf16_t* a3; float* pss; const PG8_LAS float* gvt; const PG8_LAS float* avt; const PG8_LAS float* tab;
    __device__ __forceinline__ void midk(f32x4 (&acc)[2][2][4][2], int wr, int fr) const {
#pragma unroll
        for (int ai = 0; ai < 2; ++ai)
#pragma unroll
            for (int m = 0; m < 4; ++m) { const float f = lds_ld1(tab + ai * HALF + wr * 64 + m * 16 + fr);
#pragma unroll
                for (int bj = 0; bj < 2; ++bj)
#pragma unroll
                    for (int n = 0; n < 2; ++n) acc[ai][bj][m][n] *= f; }
    }
    __device__ __forceinline__ void operator()(const f32x4 (&acc)[2][2][4][2], const Unit& u, int wr, int wc, int fr, int fq) const {
        const int cin = wc * 32 + 8 * fq, col0 = u.pn * BM + cin, tr0 = wr * 64 + fr, ct0 = (u.pn >> 2) * BM + cin;
        const size_t off0 = (size_t)(u.pm * BM + tr0) * 4096 + col0;
        float ss[2][4];
#pragma unroll
        for (int ai = 0; ai < 2; ++ai)
#pragma unroll
            for (int m = 0; m < 4; ++m) ss[ai][m] = 0.f;
#pragma unroll
        for (int bj = 0; bj < 2; ++bj) {
            const f32x4 g0 = lds_ld4(gvt + ct0 + bj * HALF), g1 = lds_ld4(gvt + ct0 + bj * HALF + 4);
            const f32x4 a0 = lds_ld4(avt + ct0 + bj * HALF), a1 = lds_ld4(avt + ct0 + bj * HALF + 4);
#pragma unroll
            for (int ai = 0; ai < 2; ++ai)
#pragma unroll
                for (int m = 0; m < 4; ++m) { const size_t off = off0 + (size_t)(ai * HALF + m * 16) * 4096 + bj * HALF; const float r = lds_ld1(tab + 256 + ai * HALF + m * 16 + tr0);
                    const f32x4 v0 = *(const f32x4*)(x + off) + g0 * (acc[ai][bj][m][0] * r), v1 = *(const f32x4*)(x + off + 4) + g1 * (acc[ai][bj][m][1] * r);
                    { u32x4 w1; w1.x = cvt_pk_bf16(v0.x, v0.y); w1.y = cvt_pk_bf16(v0.z, v0.w); w1.z = cvt_pk_bf16(v1.x, v1.y); w1.w = cvt_pk_bf16(v1.z, v1.w); *(u32x4*)(x1b + off) = w1; }
                    ss[ai][m] += ((v0.x * v0.x + v0.y * v0.y) + (v0.z * v0.z + v0.w * v0.w)) + ((v1.x * v1.x + v1.y * v1.y) + (v1.z * v1.z + v1.w * v1.w));
                    const f32x4 b0 = v0 * a0, b1 = v1 * a1; u32x4 w; w.x = cvt_pk_bf16(b0.x, b0.y); w.y = cvt_pk_bf16(b0.z, b0.w); w.z = cvt_pk_bf16(b1.x, b1.y); w.w = cvt_pk_bf16(b1.z, b1.w);
                    *(u32x4*)(a3 + off) = w; }
            asm volatile("" ::: "memory"); }
#pragma unroll
        for (int ai = 0; ai < 2; ++ai)
#pragma unroll
            for (int m = 0; m < 4; ++m) { const float s = xrow_sum(ss[ai][m]);
                if (fq == 0) pss[(size_t)(u.pm * BM + ai * HALF + m * 16 + tr0) * 64 + u.pn * 4 + wc] = s; }
    }
};
struct EpiGatedRes {
    static constexpr bool PERM = true, AFTER_DRAIN = false, MIDK = false;
    bf16_t* xb; const PG8_LAS float* gvt;
    __device__ __forceinline__ void midk(f32x4 (&)[2][2][4][2], int, int) const {}
    __device__ __forceinline__ void operator()(const f32x4 (&acc)[2][2][4][2], const Unit& u, int wr, int wc, int fr, int fq) const {
        const int cin = wc * 32 + 8 * fq, col0 = u.pn * BM + cin, ct0 = (u.pn >> 2) * BM + cin;
        const size_t off0 = (size_t)(u.pm * BM + wr * 64 + fr) * 4096 + col0;
#pragma unroll
        for (int bj = 0; bj < 2; ++bj) {
            const f32x4 g0 = lds_ld4(gvt + ct0 + bj * HALF), g1 = lds_ld4(gvt + ct0 + bj * HALF + 4);
#pragma unroll
            for (int ai = 0; ai < 2; ++ai)
#pragma unroll
                for (int m = 0; m < 4; ++m) { const size_t off = off0 + (size_t)(ai * HALF + m * 16) * 4096 + bj * HALF;
                    const u32x4 b = *(const u32x4*)(xb + off);
                    const f32x4 v0 = (f32x4){__uint_as_float(b.x << 16), __uint_as_float(b.x & 0xffff0000u), __uint_as_float(b.y << 16), __uint_as_float(b.y & 0xffff0000u)} + g0 * acc[ai][bj][m][0];
                    const f32x4 v1 = (f32x4){__uint_as_float(b.z << 16), __uint_as_float(b.z & 0xffff0000u), __uint_as_float(b.w << 16), __uint_as_float(b.w & 0xffff0000u)} + g1 * acc[ai][bj][m][1];
                    u32x4 w; w.x = cvt_pk_bf16(v0.x, v0.y); w.y = cvt_pk_bf16(v0.z, v0.w); w.z = cvt_pk_bf16(v1.x, v1.y); w.w = cvt_pk_bf16(v1.z, v1.w);
                    *(u32x4*)(xb + off) = w; }
            asm volatile("" ::: "memory"); }
    }
};

template <class Epi, class Sched, bool ALIGN_EPI = false, bool SP2 = false>
__device__ __forceinline__ void gemm_phase(PG8_LAS unsigned char* lds, const Gemm g, const Sched& S, const Epi& E) {
    const int tid = threadIdx.x, wid = __builtin_amdgcn_readfirstlane(tid >> 6), lane = tid & 63, wr = wid >> 2, wc = wid & 3, fr = lane & 15, fq = lane >> 4;
    const int K = g.K, nt = K / BK;
    unsigned voffA[2], voffB[2];
#pragma unroll
    for (int i = 0; i < 2; ++i) { int R, C; stage_rc(tid * 16 + i * 8192, R, C); const int Rb = Epi::PERM ? ((R & ~31) + perm32(R & 31)) : R;
        voffA[i] = (unsigned)(R * K + C) * 2u; voffB[i] = (unsigned)(Rb * K + C) * 2u; }
    const size_t kstep = (size_t)(BK * 2);
    const size_t hstep = (size_t)HALF * K * 2;
    const size_t tstep = 2 * hstep;
    const unsigned ldsw = (unsigned)wid * 1024u;
    const int aoff = lds_byte(wr * 64 + fr, fq * 8), boff = lds_byte(wc * 32 + fr, fq * 8);
#define PG8_SA(b, h) (((b) * 2 + (h)) * HTB)
#define PG8_SB(b, h) ((4 + (b) * 2 + (h)) * HTB)
#define PG8_STAGE(bufoff, gbase, voff) do { _Pragma("unroll") for (int _i = 0; _i < 2; ++_i) \
        __builtin_amdgcn_global_load_lds((const unsigned*)((const char*)(gbase) + (voff)[_i]), (PG8_LAS unsigned*)(lds + (bufoff) + ldsw + _i * 8192), 16, 0, 0); } while (0)
#define PG8_LDA(dst, b, h) do { _Pragma("unroll") for (int m = 0; m < 4; ++m) _Pragma("unroll") for (int k = 0; k < 2; ++k) dst[m][k] = *(const PG8_LAS bf16x8*)(lds + PG8_SA(b, h) + aoff + m * 2048 + k * 1024); } while (0)
#define PG8_LDB(dst, b, h) do { _Pragma("unroll") for (int n = 0; n < 2; ++n) _Pragma("unroll") for (int k = 0; k < 2; ++k) dst[n][k] = *(const PG8_LAS bf16x8*)(lds + PG8_SB(b, h) + boff + n * 2048 + k * 1024); } while (0)
#define PG8_MMA(ai, bj, At, Bt) do { __builtin_amdgcn_s_setprio(1); _Pragma("unroll") for (int m = 0; m < 4; ++m) _Pragma("unroll") for (int n = 0; n < 2; ++n) _Pragma("unroll") for (int k = 0; k < 2; ++k) \
        acc[ai][bj][m][n] = __builtin_amdgcn_mfma_f32_16x16x32_bf16(Bt[n][k], At[m][k], acc[ai][bj][m][n], 0, 0, 0); __builtin_amdgcn_s_setprio(0); } while (0)
#define PG8_WAIT_V(n) asm volatile("s_waitcnt vmcnt(" #n ")" ::: "memory")
#define PG8_WAIT_L(n) asm volatile("s_waitcnt lgkmcnt(" #n ")" ::: "memory")
#define PG8_BAR __builtin_amdgcn_s_barrier()
#define PG8_SCHED __builtin_amdgcn_sched_barrier(0)
    Unit cur, nxt; int ui = 0;
    if (!S.next(0, cur)) return;
    f32x4 acc[2][2][4][2];
#pragma unroll
    for (int a = 0; a < 2; ++a)
#pragma unroll
        for (int b = 0; b < 2; ++b)
#pragma unroll
            for (int m = 0; m < 4; ++m)
#pragma unroll
                for (int n = 0; n < 2; ++n) acc[a][b][m][n] = (f32x4){0.f, 0.f, 0.f, 0.f};
    bf16x8 At[4][2], B0[2][2], B1[2][2];
    const char* cA; const char* cB; S.bases(cur, g, tstep, cA, cB);
    S.a_ready(cur);
    if constexpr (SP2) {
        PG8_STAGE(PG8_SB(0, 0), cB, voffB); PG8_STAGE(PG8_SB(0, 1), cB + hstep, voffB); PG8_STAGE(PG8_SA(0, 0), cA, voffA); PG8_STAGE(PG8_SA(0, 1), cA + hstep, voffA);
        if (wr == 1) PG8_BAR;
        PG8_WAIT_V(2); PG8_BAR;
        PG8_STAGE(PG8_SB(1, 0), cB + kstep, voffB); PG8_STAGE(PG8_SA(1, 0), cA + kstep, voffA); PG8_STAGE(PG8_SB(1, 1), cB + hstep + kstep, voffB);
        PG8_WAIT_V(6); PG8_BAR;
    } else {
        PG8_STAGE(PG8_SB(0, 0), cB, voffB); PG8_STAGE(PG8_SA(0, 0), cA, voffA); PG8_STAGE(PG8_SB(0, 1), cB + hstep, voffB); PG8_STAGE(PG8_SA(0, 1), cA + hstep, voffA);
        if (wr == 1) PG8_BAR;
        PG8_WAIT_V(4); PG8_BAR;
        PG8_STAGE(PG8_SB(1, 0), cB + kstep, voffB); PG8_STAGE(PG8_SA(1, 0), cA + kstep, voffA); PG8_STAGE(PG8_SB(1, 1), cB + hstep + kstep, voffB);
        PG8_WAIT_V(6); PG8_BAR;
    }
    for (;;) {
        const bool has_next = S.next(ui + 1, nxt);
        const char* nA = cA; const char* nB = cB; if (has_next) S.bases(nxt, g, tstep, nA, nB);
        for (int t = 0; t < nt; t += 2) {
            const bool last = (t == nt - 2);
            const char* a1 = cA + (size_t)(t + 1) * kstep;
            const char* a2 = last ? nA : cA + (size_t)(t + 2) * kstep; const char* b2 = last ? nB : cB + (size_t)(t + 2) * kstep;
            const char* a3 = a2 + kstep; const char* b3 = b2 + kstep;
            if (last && has_next) S.a_ready(nxt);
            if constexpr (Epi::MIDK) { if (t == (nt >> 1)) { E.midk(acc, wr, fr); asm volatile("s_waitcnt lgkmcnt(0)" ::: "memory"); } }
            if constexpr (SP2) {
            PG8_LDB(B0, 0, 0); PG8_LDB(B1, 0, 1); PG8_SCHED; PG8_LDA(At, 0, 0); PG8_STAGE(PG8_SA(1, 1), a1 + hstep, voffA);
            PG8_WAIT_V(8); PG8_WAIT_L(0); PG8_BAR; PG8_MMA(0, 0, At, B0); PG8_MMA(0, 1, At, B1); PG8_BAR; PG8_SCHED;
            PG8_LDA(At, 0, 1); PG8_STAGE(PG8_SB(0, 0), b2, voffB); PG8_STAGE(PG8_SB(0, 1), b2 + hstep, voffB); PG8_STAGE(PG8_SA(0, 0), a2, voffA);
            PG8_WAIT_V(8); PG8_WAIT_L(0); PG8_BAR; PG8_MMA(1, 0, At, B0); PG8_MMA(1, 1, At, B1); PG8_BAR; PG8_SCHED;
            PG8_LDB(B0, 1, 0); PG8_LDB(B1, 1, 1); PG8_SCHED; PG8_LDA(At, 1, 0); PG8_STAGE(PG8_SA(0, 1), a2 + hstep, voffA);
            PG8_WAIT_V(8); PG8_WAIT_L(0); PG8_BAR; PG8_MMA(0, 0, At, B0); PG8_MMA(0, 1, At, B1); PG8_BAR; PG8_SCHED;
            PG8_LDA(At, 1, 1); PG8_STAGE(PG8_SB(1, 0), b3, voffB); PG8_STAGE(PG8_SB(1, 1), b3 + hstep, voffB); PG8_STAGE(PG8_SA(1, 0), a3, voffA);
            PG8_WAIT_V(8); PG8_WAIT_L(0); PG8_BAR; PG8_MMA(1, 0, At, B0); PG8_MMA(1, 1, At, B1); PG8_BAR; PG8_SCHED;
            } else {
            PG8_LDB(B0, 0, 0); PG8_SCHED; PG8_LDA(At, 0, 0); PG8_STAGE(PG8_SA(1, 1), a1 + hstep, voffA);
            PG8_WAIT_L(8); PG8_BAR; PG8_WAIT_L(0); PG8_MMA(0, 0, At, B0); PG8_BAR; PG8_SCHED;
            PG8_LDB(B1, 0, 1); PG8_STAGE(PG8_SB(0, 0), b2, voffB);
            PG8_BAR; PG8_WAIT_L(0); PG8_MMA(0, 1, At, B1); PG8_BAR;
            PG8_LDA(At, 0, 1); PG8_STAGE(PG8_SA(0, 0), a2, voffA);
            PG8_BAR; PG8_WAIT_L(0); PG8_MMA(1, 0, At, B0); PG8_BAR; PG8_SCHED;
            PG8_STAGE(PG8_SB(0, 1), b2 + hstep, voffB);
            PG8_WAIT_V(6); PG8_BAR; PG8_MMA(1, 1, At, B1); PG8_BAR;
            PG8_LDB(B0, 1, 0); PG8_SCHED; PG8_LDA(At, 1, 0); PG8_STAGE(PG8_SA(0, 1), a2 + hstep, voffA);
            PG8_WAIT_L(8); PG8_BAR; PG8_WAIT_L(0); PG8_MMA(0, 0, At, B0); PG8_BAR; PG8_SCHED;
            PG8_LDB(B1, 1, 1); PG8_STAGE(PG8_SB(1, 0), b3, voffB);
            PG8_BAR; PG8_WAIT_L(0); PG8_MMA(0, 1, At, B1); PG8_BAR;
            PG8_LDA(At, 1, 1); PG8_STAGE(PG8_SA(1, 0), a3, voffA);
            PG8_BAR; PG8_WAIT_L(0); PG8_MMA(1, 0, At, B0); PG8_BAR; PG8_SCHED;
            PG8_STAGE(PG8_SB(1, 1), b3 + hstep, voffB);
            PG8_WAIT_V(6); PG8_BAR; PG8_MMA(1, 1, At, B1); PG8_BAR;
            }
        }
        if constexpr (ALIGN_EPI) { if (wr == 0) PG8_BAR; }
        if constexpr (!Epi::AFTER_DRAIN) { E(acc, cur, wr, wc, fr, fq); S.done(cur); }
        if (!has_next) break;
#pragma unroll
        for (int a = 0; a < 2; ++a)
#pragma unroll
            for (int b = 0; b < 2; ++b)
#pragma unroll
                for (int m = 0; m < 4; ++m)
#pragma unroll
                    for (int n = 0; n < 2; ++n) acc[a][b][m][n] = (f32x4){0.f, 0.f, 0.f, 0.f};
        cur = nxt; cA = nA; cB = nB; ++ui;
        if constexpr (ALIGN_EPI) { if (wr == 1) PG8_BAR; }
    }
    PG8_WAIT_V(0);
    if constexpr (!ALIGN_EPI) { if (wr == 0) PG8_BAR; }
    PG8_BAR;
    if constexpr (Epi::AFTER_DRAIN) { E.fused(acc, cur, wr, wc, fr, fq, lds, wid, lane); S.done(cur); }
#undef PG8_SA
#undef PG8_SB
#undef PG8_STAGE
#undef PG8_LDA
#undef PG8_LDB
#undef PG8_MMA
#undef PG8_WAIT_V
#undef PG8_WAIT_L
#undef PG8_BAR
#undef PG8_SCHED
}
}

constexpr int NWAVES = 8;
#ifndef MK_N_LAUNCHES
#define MK_N_LAUNCHES 1
#endif
constexpr int N_PHASES = 8;
#ifndef REP_PHASE
#define REP_PHASE -1
#endif
#define REPS(k) (((k) == REP_PHASE) ? 2 : 1)
#ifndef DBG_MULT
#define DBG_MULT 4
#endif
#ifndef DBG_SLOT
#define DBG_SLOT -1
#endif
constexpr int D = 4096, BATCH = 4, SEQ = 4096, GW = 64, CTX = 256;
constexpr int NH = 16, HD = 128, DNA = 2048, DSGU = 2048, DIN = 10240, DFF = 16384, NMODC = 6 * D;
constexpr int M = BATCH * SEQ, MC = BATCH * CTX, MA = M + MC;
constexpr float EPS = 1e-6f;
constexpr float LOG2E = 1.4426950408889634f;
constexpr int ADA_KS = 16, ADA_STRIPS = NMODC / 256;

constexpr size_t MiB = 1u << 20;
constexpr size_t WS_CTL = 0, CTL_ZERO_BYTES = 1 * MiB;
constexpr size_t WS_MODF = 1 * MiB;
constexpr size_t WS_PART = 2 * MiB;
constexpr size_t WS_SSNA = 10 * MiB;
constexpr size_t WS_SSSG = 11 * MiB;
constexpr size_t WS_CBIAS = 11 * MiB + 512 * 1024;
constexpr size_t WS_PSS = 12 * MiB;
constexpr size_t WS_WIN = 16 * MiB;
constexpr size_t WS_WOUT = 96 * MiB;
constexpr size_t WS_WFF1 = 128 * MiB;
constexpr size_t WS_WFF2 = 256 * MiB;
constexpr size_t WS_A1 = 384 * MiB;
constexpr size_t WS_SLOT = 68 * MiB;
constexpr size_t WS_Q = 520 * MiB;
constexpr size_t WS_K = WS_Q + 1 * WS_SLOT;
constexpr size_t WS_VT = WS_Q + 2 * WS_SLOT;
constexpr size_t WS_U = WS_Q + 3 * WS_SLOT;
constexpr size_t WS_GT = WS_Q + 4 * WS_SLOT;
constexpr size_t WS_A2 = WS_Q + 5 * WS_SLOT;
constexpr size_t WS_H = 520 * MiB;
constexpr size_t WS_XB = 1032 * MiB;
constexpr size_t WS_END = 1160 * MiB;
static_assert(WS_A1 + (size_t)MA * D * 2 <= WS_Q && WS_K + (size_t)MA * DNA * 2 <= WS_VT && WS_VT + (size_t)DNA * MA * 2 <= WS_U && WS_GT + (size_t)DSGU * M * 2 <= WS_A2 && WS_A2 + (size_t)M * D * 2 <= WS_END && WS_H + (size_t)M * DFF * 2 <= WS_XB && WS_XB + (size_t)M * D * 2 <= WS_END, "d_ws map");
constexpr int CW_BAR = 4096;

constexpr int RING_OFF = 0, RING_BYTES = 131072;
constexpr int ROWTAB_OFF = RING_BYTES, COLTAB_OFF = ROWTAB_OFF + 2048;
constexpr int LDSCTL_OFF = 149504, MISC_OFF = LDSCTL_OFF + 320;
constexpr int LDS_BYTES = 150528;
static_assert(COLTAB_OFF + 16384 <= LDSCTL_OFF && MISC_OFF + 128 <= LDS_BYTES, "LDS map");

#define GAS __attribute__((address_space(1)))
#define LAS __attribute__((address_space(3)))
typedef unsigned short bf16;
typedef unsigned v4u __attribute__((ext_vector_type(4)));
typedef unsigned v2u __attribute__((ext_vector_type(2)));
typedef float f32x4 __attribute__((ext_vector_type(4)));
typedef short bf16x8 __attribute__((ext_vector_type(8)));
typedef GAS unsigned gu32;
#define RLX_AGENT __ATOMIC_RELAXED, __HIP_MEMORY_SCOPE_AGENT
#define LDS_WAIT() asm volatile("s_waitcnt lgkmcnt(0)" ::: "memory")
#define VM_WAIT() asm volatile("s_waitcnt vmcnt(0)" ::: "memory")
__device__ __forceinline__ unsigned pk2(float lo, float hi) { return pg8::cvt_pk_bf16(lo, hi); }
__device__ __forceinline__ float bf_lo(unsigned w) { return __builtin_bit_cast(float, w << 16); }
__device__ __forceinline__ float bf_hi(unsigned w) { return __builtin_bit_cast(float, w & 0xffff0000u); }

#define XB_TMO      128
#define XB_XCNT(j)  (256  + 64 * (j))
#define XB_XSUB(j)  (1280 + 64 * (j))
#define XB_XGEN(j)  (2304 + 64 * (j))
#define XB_TOP      3328
#define XB_TOPGEN   3392
#define XCD_BAR_WORDS 3456
#define XB_SPIN_CAP (1u << 18)

__device__ __forceinline__ unsigned xb_ld(unsigned* p)              { return __hip_atomic_load(p, __ATOMIC_RELAXED, __HIP_MEMORY_SCOPE_AGENT); }
__device__ __forceinline__ unsigned xb_add(unsigned* p, unsigned v) { return __hip_atomic_fetch_add(p, v, __ATOMIC_RELAXED, __HIP_MEMORY_SCOPE_AGENT); }
__device__ __forceinline__ unsigned xb_xcc_id() { return (unsigned)__builtin_amdgcn_s_getreg((3 << 11) | 20) & 0xFu; }
#define XB_SPIN(cond, bar) do { unsigned _sp = 0; while (cond) { __builtin_amdgcn_s_sleep(1); \
    if ((++_sp & 255u) == 0u) { if (xb_ld(&(bar)[XB_TMO])) break; if (_sp > XB_SPIN_CAP) { atomicAdd(&(bar)[XB_TMO], 1u); break; } } } } while (0)

struct XcdBarrier {
    unsigned* bar; unsigned x;
    volatile LAS unsigned* st;
};

__device__ __forceinline__ XcdBarrier xcd_barrier_post(unsigned* bar, volatile LAS unsigned* st) {
    XcdBarrier b; b.bar = bar; b.x = xb_xcc_id(); b.st = st;
    if (threadIdx.x == 0) (void)xb_add(&bar[XB_XCNT(b.x)], 1u);
    return b;
}
__device__ __forceinline__ void xcd_barrier_complete(unsigned* bar, unsigned x, unsigned& nloc, unsigned& nx) {
    const unsigned G = gridDim.x * gridDim.y * gridDim.z;
    unsigned sum, cnt, mine, sp = 0u;
    for (;;) {
        sum = 0u; cnt = 0u; mine = 0u;
#pragma unroll
        for (unsigned j = 0; j < 16; ++j) { const unsigned c = xb_ld(&bar[XB_XCNT(j)]); sum += c; cnt += (c > 0u) ? 1u : 0u; mine = (j == x) ? c : mine; }
        if (sum == G) break;
        __builtin_amdgcn_s_sleep(1);
        if ((++sp & 255u) == 0u) { if (xb_ld(&bar[XB_TMO])) break; if (sp > XB_SPIN_CAP) { atomicAdd(&bar[XB_TMO], 1u); break; } }
    }
    nloc = mine > 0u ? mine : 1u; nx = cnt > 0u ? cnt : 1u;
}

__device__ __forceinline__ void xcd_barrier(const XcdBarrier& b) {
    asm volatile("s_waitcnt vmcnt(0)" ::: "memory");
    __syncthreads();
    if (threadIdx.x == 0) {
        unsigned* bar = b.bar;
        __builtin_amdgcn_s_waitcnt(0);
        unsigned nloc = b.st[0], nx = b.st[1];
        if (nloc == 0u) { xcd_barrier_complete(bar, b.x, nloc, nx); b.st[0] = nloc; b.st[1] = nx; }
        const unsigned old = xb_add(&bar[XB_XSUB(b.x)], 1u);
        const unsigned gen = old / nloc;
        if (old + 1u == (gen + 1u) * nloc) {
            __builtin_amdgcn_fence(__ATOMIC_RELEASE, "agent");
            asm volatile("s_waitcnt vmcnt(0)" ::: "memory");
            const unsigned og = xb_add(&bar[XB_TOP], 1u);
            const unsigned tg = og / nx;
            if (og + 1u == (tg + 1u) * nx) xb_add(&bar[XB_TOPGEN], 1u);
            else XB_SPIN(xb_ld(&bar[XB_TOPGEN]) == tg, bar);
            __builtin_amdgcn_fence(__ATOMIC_ACQUIRE, "agent");
            xb_add(&bar[XB_XGEN(b.x)], 1u);
            asm volatile("s_waitcnt vmcnt(0)" ::: "memory");
        } else {
            XB_SPIN(xb_ld(&bar[XB_XGEN(b.x)]) == gen, bar);
            __builtin_amdgcn_fence(__ATOMIC_ACQUIRE, "agent");
            asm volatile("s_waitcnt vmcnt(0)" ::: "memory");
        }
    }
    __syncthreads();
}

struct Frame {
    LAS unsigned char* lds;
    volatile LAS unsigned* MISC;
    gu32* ctl;
    int tid, lane, wave, G;
    const float *x, *c, *ctx, *cctx, *w_ada, *b_ada, *norm1_w, *w_in, *rpb, *sgu_norm_w, *sgu_w, *sgu_b, *gna, *gsgu, *w_out, *norm2_w, *w_ff1, *w_ff2, *fnw;
    float* out;
    float *modf, *part, *ssna, *sssg, *cbias, *pss;
    bf16 *Wt_in, *Wt_out, *Wt_ff1, *Wt_ff2, *A1, *QB, *KB, *VT, *UB, *GT, *A2, *HB, *XB;
};
constexpr int CW_DBG = 8192;
#define DBG_BEGIN(t) unsigned long long t = 0; if (DBG_SLOT >= 0) t = __builtin_amdgcn_s_memrealtime()
#define DBG_MARK(t) do { if (DBG_SLOT >= 0) t = __builtin_amdgcn_s_memrealtime(); } while (0)
#define DBG_END(F, slot, t) do { if (DBG_SLOT >= 0 && (F).tid == 0) atomicMax((unsigned*)((F).ctl + CW_DBG + 64 * (slot)), (unsigned)(__builtin_amdgcn_s_memrealtime() - (t))); } while (0)
__device__ __forceinline__ float wave_sum(float v) {
#pragma unroll
    for (int o = 1; o < 64; o <<= 1) v += __shfl_xor(v, o);
    return v;
}
constexpr int I_IN = (D / 64) * (DIN / 32), I_OUT = (D / 64) * (D / 32), I_F1 = (D / 64) * (DFF / 32), I_F2 = (DFF / 64) * (D / 32), I_TR = I_IN + I_OUT + I_F1 + I_F2;
struct TIt { const float* src; bf16* dst; const float* kg; int N, K; };
__device__ __forceinline__ void p0_titem(Frame& F, int t, TIt& r) {
    int x = t; const float* W = F.w_in; bf16* WT = F.Wt_in; int K = D, N = DIN; bool gain = false;
    if (x >= I_IN) { x -= I_IN; W = F.w_out; WT = F.Wt_out; N = D; gain = true;
        if (x >= I_OUT) { x -= I_OUT; W = F.w_ff1; WT = F.Wt_ff1; N = DFF; gain = false;
            if (x >= I_F1) { x -= I_F1; W = F.w_ff2; WT = F.Wt_ff2; K = DFF; N = D; } } }
    const int nblk = N >> 5, kb = x / nblk, nb = x - kb * nblk, k0 = 64 * kb, n0 = 32 * nb;
    r.src = W + (size_t)k0 * N + n0; r.dst = WT + (size_t)n0 * K + k0; r.N = N; r.K = K;
    r.kg = gain ? (k0 < 2048 ? F.gna + k0 : F.gsgu + (k0 - 2048)) : nullptr;
}
__device__ __forceinline__ void p0_tload(const TIt& r, float (&v)[32], int lane) {
    const float* p = r.src + (size_t)(lane >> 5) * r.N + (lane & 31);
#pragma unroll
    for (int i = 0; i < 32; ++i) v[i] = p[(size_t)(2 * i) * r.N];
}
__device__ __forceinline__ void p0_tstore(const TIt& r, const float (&v)[32], LAS float* scr, int lane) {
#pragma unroll
    for (int i = 0; i < 32; ++i) { const int kk = 2 * i + (lane >> 5); float x = v[i]; if (r.kg) x *= r.kg[kk]; scr[kk * 33 + (lane & 31)] = x; }
    LDS_WAIT(); asm volatile("" ::: "memory");
    const int c = lane & 7;
#pragma unroll
    for (int j = 0; j < 4; ++j) { const int n = (lane >> 3) + 8 * j; const LAS float* s = scr + (8 * c) * 33 + n;
        v4u o; o.x = pk2(s[0 * 33], s[1 * 33]); o.y = pk2(s[2 * 33], s[3 * 33]); o.z = pk2(s[4 * 33], s[5 * 33]); o.w = pk2(s[6 * 33], s[7 * 33]);
        *(GAS v4u*)(r.dst + (size_t)n * r.K + 8 * c) = o; }
    LDS_WAIT(); asm volatile("" ::: "memory");
}
__device__ __forceinline__ float silu_f(float v) { return v / (1.0f + __expf(-v)); }
__device__ __forceinline__ void p0_ada_item(Frame& F, int item, LAS float* sil) {
    const int s = item % ADA_STRIPS, ks = item / ADA_STRIPS, k0 = ks * 256, lane = F.lane;
#pragma unroll
    for (int r = 0; r < 5; ++r) { const float* src = (r < 4) ? F.c + r * D : F.cctx; const f32x4 v = *(const f32x4*)(src + k0 + 4 * lane);
        f32x4 o; o.x = silu_f(v.x); o.y = silu_f(v.y); o.z = silu_f(v.z); o.w = silu_f(v.w); *(LAS f32x4*)(sil + r * 256 + 4 * lane) = o; }
    LDS_WAIT(); asm volatile("" ::: "memory");
    f32x4 acc[5];
#pragma unroll
    for (int r = 0; r < 5; ++r) acc[r] = (f32x4){0.f, 0.f, 0.f, 0.f};
    const float* wp = F.w_ada + (size_t)k0 * NMODC + 256 * s + 4 * lane;
#pragma unroll 16
    for (int kk = 0; kk < 256; ++kk) { const f32x4 w = *(const f32x4*)(wp + (size_t)kk * NMODC);
#pragma unroll
        for (int r = 0; r < 5; ++r) acc[r] += w * sil[r * 256 + kk]; }
#pragma unroll
    for (int r = 0; r < 5; ++r) *(f32x4*)(F.part + (size_t)(ks * 5 + r) * NMODC + 256 * s + 4 * lane) = acc[r];
    LDS_WAIT(); asm volatile("" ::: "memory");
}
__device__ __forceinline__ void p0_prologue(Frame& F) {
    LAS float* scr = (LAS float*)(F.lds + RING_OFF + F.wave * 16384);
    LAS float* sil = (LAS float*)(F.lds + RING_OFF + F.wave * 16384 + 8704);
    const int gw = (int)blockIdx.x * NWAVES + F.wave;
    constexpr int I_ADA = ADA_KS * ADA_STRIPS, NA = 41, NB = 61;
    static_assert(I_ADA == 1536 && I_ADA * NA + (2048 - I_ADA) * NB == I_TR, "P0 work split");
    int t0, ts, nt;
    if (gw < I_ADA) { p0_ada_item(F, gw, sil); t0 = gw; ts = I_ADA; nt = NA; } else { t0 = I_ADA * NA + (gw - I_ADA); ts = 2048 - I_ADA; nt = NB; }
    TIt ia, ib; float va[32], vb[32];
    p0_titem(F, t0, ia); p0_tload(ia, va, F.lane);
    for (int k = 0; k < nt; k += 2) {
        if (k + 1 < nt) { p0_titem(F, t0 + (k + 1) * ts, ib); p0_tload(ib, vb, F.lane); }
        p0_tstore(ia, va, scr, F.lane);
        if (k + 2 < nt) { p0_titem(F, t0 + (k + 2) * ts, ia); p0_tload(ia, va, F.lane); }
        if (k + 1 < nt) p0_tstore(ib, vb, scr, F.lane);
    }
}
__device__ __forceinline__ f32x4 ld4(const float* p) { return *(const f32x4*)p; }
__device__ __forceinline__ f32x4 ld4(const LAS float* p) { return *(const LAS f32x4*)p; }
template <class SP> __device__ __forceinline__ void row_norm_mod(const float* xrow, const float* nw, SP sh, SP sc, bf16* orow, int lane) {
    const f32x4* xr = (const f32x4*)xrow + lane;
    f32x4 v[16]; float ss = 0.f;
#pragma unroll
    for (int j = 0; j < 16; ++j) { v[j] = xr[64 * j]; ss += (v[j].x * v[j].x + v[j].y * v[j].y) + (v[j].z * v[j].z + v[j].w * v[j].w); }
    const float rstd = rsqrtf(wave_sum(ss) * (1.0f / D) + EPS);
#pragma unroll
    for (int j = 0; j < 16; ++j) { const int col = 4 * lane + 256 * j;
        const f32x4 w4 = ld4(nw + col), s4 = ld4(sc + col), h4 = ld4(sh + col);
        const f32x4 o = v[j] * rstd * w4 * (s4 + 1.0f) + h4;
        v2u pk; pk.x = pk2(o.x, o.y); pk.y = pk2(o.z, o.w);
        *(v2u*)(orow + col) = pk; }
}
__device__ __forceinline__ void p1_rows(Frame& F) {
    LAS float* modL = (LAS float*)(F.lds + RING_OFF);
    const int bx = (int)blockIdx.x, b = bx >> 6;
    for (int i4 = F.tid; i4 < 2 * D / 4; i4 += NWAVES * 64) { const int i = 4 * i4;
        f32x4 p0[ADA_KS], p1[ADA_KS];
#pragma unroll
        for (int sp = 0; sp < ADA_KS; ++sp) { p0[sp] = *(const f32x4*)(F.part + (size_t)(sp * 5 + b) * NMODC + i); p1[sp] = *(const f32x4*)(F.part + (size_t)(sp * 5 + 4) * NMODC + i); }
        f32x4 s0 = *(const f32x4*)(F.b_ada + i), s1 = s0;
#pragma unroll
        for (int sp = 0; sp < ADA_KS; ++sp) { s0 += p0[sp]; s1 += p1[sp]; }
        *(LAS f32x4*)(modL + i) = s0; *(LAS f32x4*)(modL + 2 * D + i) = s1; }
    if (F.tid < 120) { const int idx = bx * 480 + 4 * F.tid, r = idx / NMODC, j = idx % NMODC;
        f32x4 p0[ADA_KS];
#pragma unroll
        for (int sp = 0; sp < ADA_KS; ++sp) p0[sp] = *(const f32x4*)(F.part + (size_t)(sp * 5 + r) * NMODC + j);
        f32x4 s = *(const f32x4*)(F.b_ada + j);
#pragma unroll
        for (int sp = 0; sp < ADA_KS; ++sp) s += p0[sp];
        *(f32x4*)(F.modf + idx) = s; }
    __syncthreads();
    for (int rr = F.wave; rr < 64; rr += NWAVES) { const int row = 64 * bx + rr;
        row_norm_mod<const LAS float*>(F.x + (size_t)row * D, F.norm1_w, modL, modL + D, F.A1 + (size_t)row * D, F.lane); }
    if (F.wave < 4) { const int row = 4 * bx + F.wave;
        row_norm_mod<const LAS float*>(F.ctx + (size_t)row * D, F.norm1_w, modL + 2 * D, modL + 3 * D, F.A1 + (size_t)(M + row) * D, F.lane); }
}
__device__ __forceinline__ void p3_cbias(Frame& F) {
    const int b = F.wave & 3, n0 = 2 * (int)blockIdx.x + (F.wave >> 2);
    float sh[64];
    const float* sp = F.modf + (size_t)b * NMODC + 3 * D + 8 * F.lane;
#pragma unroll
    for (int i = 0; i < 8; ++i) { const f32x4 a0 = *(const f32x4*)(sp + 512 * i), a1 = *(const f32x4*)(sp + 512 * i + 4);
        sh[8 * i] = a0.x; sh[8 * i + 1] = a0.y; sh[8 * i + 2] = a0.z; sh[8 * i + 3] = a0.w; sh[8 * i + 4] = a1.x; sh[8 * i + 5] = a1.y; sh[8 * i + 6] = a1.z; sh[8 * i + 7] = a1.w; }
    const v4u* wp = (const v4u*)(F.Wt_ff1 + (size_t)n0 * D) + F.lane;
    v4u wa[8], wb[8];
#pragma unroll
    for (int i = 0; i < 8; ++i) wa[i] = wp[64 * i];
#define CB_ROW(WV, n) { float s = 0.f; _Pragma("unroll") for (int i = 0; i < 8; ++i) { const v4u q_ = WV[i]; \
        s += (bf_lo(q_.x) * sh[8 * i] + bf_hi(q_.x) * sh[8 * i + 1]) + (bf_lo(q_.y) * sh[8 * i + 2] + bf_hi(q_.y) * sh[8 * i + 3]) \
           + (bf_lo(q_.z) * sh[8 * i + 4] + bf_hi(q_.z) * sh[8 * i + 5]) + (bf_lo(q_.w) * sh[8 * i + 6] + bf_hi(q_.w) * sh[8 * i + 7]); } \
        s = wave_sum(s); if (F.lane == 0) F.cbias[(size_t)b * DFF + (n)] = s; }
    for (int r = 0; r < 32; r += 2) {
        const v4u* wq = wp + (size_t)(r + 1) * 512 * (D / 8);
#pragma unroll
        for (int i = 0; i < 8; ++i) wb[i] = wq[64 * i];
        CB_ROW(wa, n0 + 512 * r)
        if (r + 2 < 32) { const v4u* wr2 = wp + (size_t)(r + 2) * 512 * (D / 8);
#pragma unroll
            for (int i = 0; i < 8; ++i) wa[i] = wr2[64 * i]; }
        CB_ROW(wb, n0 + 512 * (r + 1))
    }
#undef CB_ROW
}
__device__ __forceinline__ void fill_tab_outproj(Frame& F, int pm, int cc) {
    LAS float* tab = (LAS float*)(F.lds + ROWTAB_OFF); LAS float* ct = (LAS float*)(F.lds + COLTAB_OFF);
    if (F.tid < 256) { const int m = pm * 256 + F.tid; float sa = 0.f, sg = 0.f;
#pragma unroll
        for (int i = 0; i < 4; ++i) { const f32x4 t = *(const f32x4*)(F.ssna + (size_t)m * 16 + 4 * i); sa += (t.x + t.y) + (t.z + t.w); }
        { const f32x4 t = *(const f32x4*)(F.sssg + (size_t)m * 4); sg = (t.x + t.y) + (t.z + t.w); }
        const float rna = rsqrtf(sa * (1.0f / DNA) + EPS), rsg = rsqrtf(sg * (1.0f / DSGU) + EPS);
        tab[F.tid] = rna / rsg; tab[256 + F.tid] = rsg; }
    const float* mf = F.modf + (size_t)(pm >> 4) * NMODC;
    for (int i = F.tid; i < 1024; i += NWAVES * 64) { const int col = (4 * (i >> 8) + cc) * 256 + (i & 255);
        ct[i] = mf[2 * D + col]; ct[1024 + i] = F.norm2_w[col] * (1.0f + mf[4 * D + col]); }
    __syncthreads();
}
__device__ __forceinline__ void fill_tab_ff1(Frame& F, int pm, int cc) {
    LAS float* tab = (LAS float*)(F.lds + ROWTAB_OFF); LAS float* ct = (LAS float*)(F.lds + COLTAB_OFF);
    if (F.tid < 256) { const int m = pm * 256 + F.tid; float s = 0.f;
#pragma unroll
        for (int i = 0; i < 16; ++i) { const f32x4 t = *(const f32x4*)(F.pss + (size_t)m * 64 + 4 * i); s += (t.x + t.y) + (t.z + t.w); }
        tab[F.tid] = rsqrtf(s * (1.0f / D) + EPS); }
    const float* cbp = F.cbias + (size_t)(pm >> 4) * DFF;
    for (int i = F.tid; i < 4096; i += NWAVES * 64) ct[i] = cbp[(4 * (i >> 8) + cc) * 256 + (i & 255)];
    __syncthreads();
}
__device__ __forceinline__ void fill_tab_ff2(Frame& F, int pm, int cc) {
    LAS float* ct = (LAS float*)(F.lds + COLTAB_OFF);
    const float* mf = F.modf + (size_t)(pm >> 4) * NMODC + 5 * D;
    for (int i = F.tid; i < 1024; i += NWAVES * 64) ct[i] = mf[(4 * (i >> 8) + cc) * 256 + (i & 255)];
    __syncthreads();
}
__device__ __forceinline__ void p9_final(Frame& F) {
    const int gw = (int)blockIdx.x * NWAVES + F.wave, NGW = F.G * NWAVES;
    for (int m = gw; m < M; m += NGW) {
        const v4u* xr = (const v4u*)(F.XB + (size_t)m * D) + F.lane;
        v4u v[8]; float ss = 0.f;
#pragma unroll
        for (int j = 0; j < 8; ++j) { v[j] = xr[64 * j];
            const float a0 = bf_lo(v[j].x), a1 = bf_hi(v[j].x), a2 = bf_lo(v[j].y), a3 = bf_hi(v[j].y), a4 = bf_lo(v[j].z), a5 = bf_hi(v[j].z), a6 = bf_lo(v[j].w), a7 = bf_hi(v[j].w);
            ss += ((a0 * a0 + a1 * a1) + (a2 * a2 + a3 * a3)) + ((a4 * a4 + a5 * a5) + (a6 * a6 + a7 * a7)); }
        const float rstd = rsqrtf(wave_sum(ss) * (1.0f / D) + EPS);
        float* orow = F.out + (size_t)m * D;
#pragma unroll
        for (int j = 0; j < 8; ++j) { const int col = 8 * (F.lane + 64 * j);
            const f32x4 w0 = ld4(F.fnw + col), w1 = ld4(F.fnw + col + 4);
            *(f32x4*)(orow + col) = (f32x4){bf_lo(v[j].x), bf_hi(v[j].x), bf_lo(v[j].y), bf_hi(v[j].y)} * rstd * w0;
            *(f32x4*)(orow + col + 4) = (f32x4){bf_lo(v[j].z), bf_hi(v[j].z), bf_lo(v[j].w), bf_hi(v[j].w)} * rstd * w1; }
    }
}
struct SguTile { bf16x8 gf[4]; f32x4 nw; v2u uu; };
__device__ __forceinline__ void sgu_load(SguTile& t, const bf16* gp, const float* nwp, const bf16* up, int ct) {
#pragma unroll
    for (int ks = 0; ks < 4; ++ks) t.gf[ks] = *(const bf16x8*)(gp + (size_t)(16 * ct) * M + ks * 32);
    t.nw = *(const f32x4*)(nwp + 16 * ct); t.uu = *(const v2u*)(up + 16 * ct);
}
__device__ __forceinline__ void sgu_compute(const SguTile& t, const bf16x8 (&wf)[4], float bias, float& ssq, bf16* op, int ct) {
    f32x4 d = (f32x4){0.f, 0.f, 0.f, 0.f};
#pragma unroll
    for (int ks = 0; ks < 4; ++ks) d = __builtin_amdgcn_mfma_f32_16x16x32_bf16(t.gf[ks], wf[ks], d, 0, 0, 0);
    const float o0 = bf_lo(t.uu.x) * (t.nw.x * d[0] + bias), o1 = bf_hi(t.uu.x) * (t.nw.y * d[1] + bias), o2 = bf_lo(t.uu.y) * (t.nw.z * d[2] + bias), o3 = bf_hi(t.uu.y) * (t.nw.w * d[3] + bias);
    ssq += (o0 * o0 + o1 * o1) + (o2 * o2 + o3 * o3);
    v2u pk; pk.x = pk2(o0, o1); pk.y = pk2(o2, o3);
    *(v2u*)(op + 16 * ct) = pk;
}
__device__ __forceinline__ void sgu_unit(Frame& F, int b, int n, int grp) {
    const int lane = F.lane, w = F.wave, l15 = lane & 15, g = lane >> 4;
    const int tok0 = b * SEQ + n * 128, cbase = grp * 512;
    LAS float* part = (LAS float*)(F.lds + RING_OFF);
    LAS float* rgs = part + 16 * 128;
    {
        const int hp = lane >> 5, t4 = 4 * (lane & 31);
        float a0 = 0.f, a1 = 0.f, a2 = 0.f, a3 = 0.f;
        const bf16* gp = F.GT + (size_t)(256 * w + hp) * M + tok0 + t4;
#pragma unroll 32
        for (int cc = 0; cc < 128; ++cc) { const v2u v = *(const v2u*)(gp + (size_t)(2 * cc) * M);
            const float f0 = bf_lo(v.x), f1 = bf_hi(v.x), f2 = bf_lo(v.y), f3 = bf_hi(v.y); a0 += f0 * f0; a1 += f1 * f1; a2 += f2 * f2; a3 += f3 * f3; }
        *(LAS f32x4*)(part + (w * 2 + hp) * 128 + t4) = (f32x4){a0, a1, a2, a3};
    }
    __syncthreads();
    if (F.tid < 128) { float s = 0.f;
#pragma unroll
        for (int i = 0; i < 16; ++i) s += part[i * 128 + F.tid];
        rgs[F.tid] = rsqrtf(s * (1.0f / DSGU) + EPS); }
    __syncthreads();
    const int p = 16 * w + l15, token = tok0 + p;
    bf16x8 wf[4];
#pragma unroll
    for (int ks = 0; ks < 4; ++ks) { const int q0 = ks * 32 + 8 * g; const float* wp = F.sgu_w + (size_t)(grp * 128 + p) * 128 + q0;
        const f32x4 w0 = *(const f32x4*)wp, w1 = *(const f32x4*)(wp + 4); const f32x4 r0 = *(const LAS f32x4*)(rgs + q0), r1 = *(const LAS f32x4*)(rgs + q0 + 4);
        v4u pk; pk.x = pk2(w0.x * r0.x, w0.y * r0.y); pk.y = pk2(w0.z * r0.z, w0.w * r0.w); pk.z = pk2(w1.x * r1.x, w1.y * r1.y); pk.w = pk2(w1.z * r1.z, w1.w * r1.w);
        wf[ks] = __builtin_bit_cast(bf16x8, pk); }
    const float bias = F.sgu_b[grp * 128 + p];
    float ssq = 0.f;
    const bf16* gp = F.GT + (size_t)(cbase + l15) * M + tok0 + 8 * g;
    const float* nwp = F.sgu_norm_w + cbase + 4 * g;
    const bf16* up = F.UB + (size_t)token * DSGU + cbase + 4 * g;
    bf16* op = F.A2 + (size_t)token * D + DNA + cbase + 4 * g;
    SguTile ta, tb, tc, td;
    sgu_load(ta, gp, nwp, up, 0); sgu_load(tb, gp, nwp, up, 1); sgu_load(tc, gp, nwp, up, 2);
    for (int ct = 0; ct < 32; ct += 4) {
        sgu_load(td, gp, nwp, up, ct + 3);
        sgu_compute(ta, wf, bias, ssq, op, ct);
        if (ct + 4 < 32) sgu_load(ta, gp, nwp, up, ct + 4);
        sgu_compute(tb, wf, bias, ssq, op, ct + 1);
        if (ct + 5 < 32) sgu_load(tb, gp, nwp, up, ct + 5);
        sgu_compute(tc, wf, bias, ssq, op, ct + 2);
        if (ct + 6 < 32) sgu_load(tc, gp, nwp, up, ct + 6);
        sgu_compute(td, wf, bias, ssq, op, ct + 3);
    }
    ssq += __shfl_xor(ssq, 16); ssq += __shfl_xor(ssq, 32);
    if (g == 0) F.sssg[(size_t)token * 4 + grp] = ssq;
    __syncthreads();
}
constexpr int AT_TILE = 32768;
constexpr int AT_NBUF = 4;
constexpr int RPB_OFF = AT_NBUF * AT_TILE + 64, ATT_LDS_END = RPB_OFF + 15 * 31 * 4 + 256;
static_assert(ATT_LDS_END <= LDSCTL_OFF, "attention LDS image below the control words");
__device__ __forceinline__ float xrow16_max(float x) {
    auto s = __builtin_amdgcn_permlane16_swap(__float_as_uint(x), __float_as_uint(x), false, false);
    x = fmaxf(__uint_as_float(s[0]), __uint_as_float(s[1]));
    auto t = __builtin_amdgcn_permlane32_swap(__float_as_uint(x), __float_as_uint(x), false, false);
    return fmaxf(__uint_as_float(t[0]), __uint_as_float(t[1]));
}
__device__ __forceinline__ float xrow16_sum(float x) {
    auto s = __builtin_amdgcn_permlane16_swap(__float_as_uint(x), __float_as_uint(x), false, false);
    x = __uint_as_float(s[0]) + __uint_as_float(s[1]);
    auto t = __builtin_amdgcn_permlane32_swap(__float_as_uint(x), __float_as_uint(x), false, false);
    return __uint_as_float(t[0]) + __uint_as_float(t[1]);
}
__device__ __forceinline__ void attn_scores(const bf16x8 (&k)[2][4], const bf16x8 (&qf)[4], f32x4 (&s)[2]) {
#pragma unroll
    for (int tt = 0; tt < 2; ++tt) { s[tt] = (f32x4){0.f, 0.f, 0.f, 0.f};
#pragma unroll
        for (int ds = 0; ds < 4; ++ds) s[tt] = __builtin_amdgcn_mfma_f32_16x16x32_bf16(k[tt][ds], qf[ds], s[tt], 0, 0, 0); }
}
template <bool WIN> __device__ __forceinline__ bf16x8 attn_softmax(f32x4 (&s)[2], const LAS float* bp, int lo, f32x4 (&o)[8], float& mrun, float& lrun) {
    if (WIN) {
        float bv[8];
#pragma unroll
        for (int i = 0; i < 8; ++i) bv[i] = bp[i];
        asm volatile("" : "+v"(bv[0]), "+v"(bv[1]), "+v"(bv[2]), "+v"(bv[3]), "+v"(bv[4]), "+v"(bv[5]), "+v"(bv[6]), "+v"(bv[7]));
#pragma unroll
        for (int i = 0; i < 8; ++i) { const bool valid = (unsigned)(i - lo) < 16u; s[i >> 2][i & 3] = valid ? s[i >> 2][i & 3] + bv[i] : -1e30f; }
    }
    float mx = fmaxf(fmaxf(fmaxf(s[0][0], s[0][1]), fmaxf(s[0][2], s[0][3])), fmaxf(fmaxf(s[1][0], s[1][1]), fmaxf(s[1][2], s[1][3])));
    mx = xrow16_max(mx);
    if (__builtin_amdgcn_ballot_w64(mx > mrun + 8.0f)) {
        const float mn = fmaxf(mrun, mx), alpha = __builtin_amdgcn_exp2f(mrun - mn); mrun = mn; lrun *= alpha;
#pragma unroll
        for (int dt = 0; dt < 8; ++dt) o[dt] *= alpha;
    }
    float ps = 0.f;
#pragma unroll
    for (int tt = 0; tt < 2; ++tt)
#pragma unroll
        for (int rg = 0; rg < 4; ++rg) { s[tt][rg] = __builtin_amdgcn_exp2f(s[tt][rg] - mrun); ps += s[tt][rg]; }
    lrun += ps;
    v4u pk; pk.x = pk2(s[0][0], s[0][1]); pk.y = pk2(s[0][2], s[0][3]); pk.z = pk2(s[1][0], s[1][1]); pk.w = pk2(s[1][2], s[1][3]);
    return __builtin_bit_cast(bf16x8, pk);
}
__device__ __forceinline__ void attn_pv(const bf16x8 (&v)[8], bf16x8 pf, f32x4 (&o)[8]) {
#pragma unroll
    for (int dt = 0; dt < 8; ++dt) o[dt] = __builtin_amdgcn_mfma_f32_16x16x32_bf16(v[dt], pf, o[dt], 0, 0, 0);
}
__device__ __forceinline__ void glds16(const void* gsrc, unsigned lds_dst) { unsigned keep;
    asm volatile("s_mov_b32 %0, m0\n\ts_mov_b32 m0, %2\n\ts_nop 0\n\tglobal_load_lds_dwordx4 %1, off\n\ts_mov_b32 m0, %0" : "=&s"(keep) : "v"(gsrc), "s"(lds_dst) : "memory"); }
__device__ __forceinline__ void attn_stage(Frame& F, int h, int T, int buf) {
    const int w = F.wave, L = F.lane;
    const unsigned base = (unsigned)(size_t)(F.lds + buf * AT_TILE);
#pragma unroll
    for (int i = 0; i < 2; ++i) { const int p = w + 8 * i, row = 4 * p + (L >> 4), f = (row & 3) | (((row >> 3) & 3) << 2), c = (L & 15) ^ f;
        glds16(F.KB + (size_t)(T + row) * DNA + h * HD + c * 8, (unsigned)__builtin_amdgcn_readfirstlane((int)(base + p * 1024))); }
#pragma unroll
    for (int i = 0; i < 2; ++i) { const int p = w + 8 * i, row = 8 * p + (L >> 3), c = (L & 7) ^ ((row >> 1) & 7);
        glds16(F.VT + (size_t)(h * HD + row) * MA + T + c * 8, (unsigned)__builtin_amdgcn_readfirstlane((int)(base + 16384 + p * 1024))); }
}
__device__ __forceinline__ void attn_kfrags(const LAS unsigned char* tile, int kb0, int q, int g, bf16x8 (&k)[2][4]) {
    const int a = q >> 2, cc = q & 3, fh = ((kb0 >> 3) + a) & 3;
    const LAS unsigned char* kr = tile + (kb0 + 8 * a + cc) * 256 + ((g ^ cc) << 4);
#pragma unroll
    for (int ds = 0; ds < 4; ++ds) { const int off = (ds ^ fh) << 6;
#pragma unroll
        for (int tt = 0; tt < 2; ++tt) k[tt][ds] = *(const LAS bf16x8*)(kr + tt * 1024 + off); }
}
__device__ __forceinline__ void attn_vfrags(const LAS unsigned char* tile, int kb0, int q, int g, bf16x8 (&v)[8]) {
    const int pc = ((kb0 >> 3) + g) ^ ((q >> 1) & 7);
    const LAS unsigned char* vr = tile + 16384 + q * 128 + (pc << 4);
#pragma unroll
    for (int dt = 0; dt < 8; ++dt) v[dt] = *(const LAS bf16x8*)(vr + dt * 2048);
}
template <bool A, bool B> __device__ __forceinline__ void attn_pv2(const LAS unsigned char* tile, int kb0, int q, int g, bf16x8 pfA, bf16x8 pfB, f32x4 (&oA)[8], f32x4 (&oB)[8]) {
    const int pc = ((kb0 >> 3) + g) ^ ((q >> 1) & 7);
    const LAS unsigned char* vr = tile + 16384 + q * 128 + (pc << 4);
#pragma unroll
    for (int hf = 0; hf < 2; ++hf) {
        bf16x8 v[4];
#pragma unroll
        for (int i = 0; i < 4; ++i) v[i] = *(const LAS bf16x8*)(vr + (4 * hf + i) * 2048);
#pragma unroll
        for (int i = 0; i < 4; ++i) { if (A) oA[4 * hf + i] = __builtin_amdgcn_mfma_f32_16x16x32_bf16(v[i], pfA, oA[4 * hf + i], 0, 0, 0);
                                      if (B) oB[4 * hf + i] = __builtin_amdgcn_mfma_f32_16x16x32_bf16(v[i], pfB, oB[4 * hf + i], 0, 0, 0); }
        __builtin_amdgcn_sched_barrier(0);
    }
}
#define ATT_KEEP2(pa, pb) asm volatile("s_nop 7" :: "v"(pa), "v"(pb))
#define ATT_KEEP1(pa) asm volatile("s_nop 7" :: "v"(pa))
__device__ __forceinline__ void attn_finish(Frame& F, f32x4 (&o)[8], float lrun, int qtok, int h, int g) {
    const float inv = 1.0f / xrow16_sum(lrun); float ssq = 0.f;
    bf16* op = F.A2 + (size_t)qtok * D + h * HD + 4 * g;
#pragma unroll
    for (int dt = 0; dt < 8; ++dt) { const f32x4 v = o[dt] * inv; ssq += (v.x * v.x + v.y * v.y) + (v.z * v.z + v.w * v.w);
        v2u pk; pk.x = pk2(v.x, v.y); pk.y = pk2(v.z, v.w); *(v2u*)(op + dt * 16) = pk; }
    ssq = xrow16_sum(ssq);
    if (g == 0) F.ssna[(size_t)qtok * 16 + h] = ssq;
}
__device__ __forceinline__ void attn_subpass(Frame& F, int b, int h, int R) {
    const int lane = F.lane, q = lane & 15, g = lane >> 4, w = F.wave, j = w & 3;
    const int r = R + (w >> 2);
    const int qcol = 16 * j + q, qtok = b * SEQ + r * GW + qcol;
    int r0 = r - 4; r0 = r0 < 0 ? 0 : (r0 > 56 ? 56 : r0);
    int krlo = R - 4; krlo = krlo < 0 ? 0 : (krlo > 56 ? 56 : krlo);
    int krhi = R - 3; krhi = (krhi < 0 ? 0 : (krhi > 56 ? 56 : krhi)) + 7;
    const int nwin = krhi - krlo + 1, nst = nwin + 4;
    int cs = qcol - 8; cs = cs < 0 ? 0 : (cs > 48 ? 48 : cs);
    const int band0 = (j == 0) ? 0 : (j == 1 ? 8 : (j == 2 ? 24 : 32));
    const int lo = cs - (band0 + 8 * g);
    const LAS float* rpb = (const LAS float*)(F.lds + RPB_OFF) + (band0 + 8 * g - qcol + 15);
    bf16x8 qf[4];
#pragma unroll
    for (int ds = 0; ds < 4; ++ds) qf[ds] = *(const bf16x8*)(F.QB + (size_t)qtok * DNA + h * HD + ds * 32 + 8 * g);
    f32x4 o[8];
#pragma unroll
    for (int dt = 0; dt < 8; ++dt) o[dt] = (f32x4){0.f, 0.f, 0.f, 0.f};
    float mrun = -1e30f, lrun = 0.f;
    const int Tw0 = b * SEQ + krlo * GW, Tc0 = M + b * CTX;
#define ATT_TILE_T(t) (((t) < nwin) ? Tw0 + (t) * GW : Tc0 + 64 * ((t) - nwin))
    asm volatile("" :: "v"(qf[0]), "v"(qf[1]), "v"(qf[2]), "v"(qf[3]));
    attn_stage(F, h, ATT_TILE_T(0), 0); attn_stage(F, h, ATT_TILE_T(1), 1); attn_stage(F, h, ATT_TILE_T(2), 2);
    for (int s = 0; s < nst; ++s) {
        if (s + 2 < nst) asm volatile("s_waitcnt vmcnt(8)" ::: "memory"); else if (s + 1 < nst) asm volatile("s_waitcnt vmcnt(4)" ::: "memory"); else asm volatile("s_waitcnt vmcnt(0)" ::: "memory");
        __builtin_amdgcn_s_barrier(); asm volatile("" ::: "memory");
        if (s + 3 < nst) attn_stage(F, h, ATT_TILE_T(s + 3), (s + 3) & (AT_NBUF - 1));
        const LAS unsigned char* tile = F.lds + (s & (AT_NBUF - 1)) * AT_TILE;
        if (s < nwin) {
            const int kr = krlo + s;
            if ((kr >= r0) && (kr < r0 + 8)) {
                bf16x8 kf[2][4], vf[8]; f32x4 sc[2];
                attn_kfrags(tile, band0, q, g, kf); attn_vfrags(tile, band0, q, g, vf);
                attn_scores(kf, qf, sc);
                bf16x8 pf = attn_softmax<true>(sc, rpb + (kr - r + 7) * 31, lo, o, mrun, lrun);
                attn_pv(vf, pf, o); ATT_KEEP1(pf);
            }
        } else {
#pragma unroll
            for (int hh = 0; hh < 2; ++hh) {
                bf16x8 kf[2][4], vf[8]; f32x4 sc[2];
                attn_kfrags(tile, 32 * hh, q, g, kf); attn_vfrags(tile, 32 * hh, q, g, vf);
                attn_scores(kf, qf, sc);
                bf16x8 pf = attn_softmax<false>(sc, nullptr, 0, o, mrun, lrun);
                attn_pv(vf, pf, o); ATT_KEEP1(pf);
            }
        }
    }
#undef ATT_TILE_T
    __builtin_amdgcn_s_barrier(); asm volatile("" ::: "memory");
    attn_finish(F, o, lrun, qtok, h, g);
}
__device__ __forceinline__ void p3_mixers(Frame& F) {
    __syncthreads();
    DBG_BEGIN(ts_);
    for (int rep = 0; rep < REPS(31); ++rep)
    for (int uid = (int)blockIdx.x; uid < BATCH * 32 * 4; uid += F.G) sgu_unit(F, uid >> 7, (uid >> 2) & 31, uid & 3);
    DBG_END(F, 10, ts_); DBG_BEGIN(ta_);
    const int xcd = (int)blockIdx.x & 7, li = (int)blockIdx.x >> 3;
    for (int rep = 0; rep < REPS(32); ++rep)
    for (int bhi = 0; bhi < 8; ++bhi) {
        const int bh = xcd * 8 + bhi, b = bh >> 4, h = bh & 15;
        for (int i = F.tid; i < 15 * 31; i += NWAVES * 64) ((LAS float*)(F.lds + RPB_OFF))[i] = F.rpb[h * 15 * 31 + i] * LOG2E;
        asm volatile("s_waitcnt lgkmcnt(0)" ::: "memory");
        attn_subpass(F, b, h, 2 * li);
    }
    DBG_END(F, 11, ta_);
}
struct Args { const float* in[19]; float* out; unsigned char* ws; int ph_lo, ph_hi; };
__global__ void __launch_bounds__(NWAVES * 64, 2) mk_fwd(Args args) {
    extern __shared__ __attribute__((aligned(16))) unsigned char lds[];
    Frame F;
    F.lds = (LAS unsigned char*)lds;
    F.MISC = (volatile LAS unsigned*)(F.lds + MISC_OFF);
    F.tid = threadIdx.x; F.lane = F.tid & 63; F.wave = __builtin_amdgcn_readfirstlane(F.tid >> 6);
    F.G = gridDim.x;
    unsigned char* ws = args.ws;
    F.ctl = (gu32*)(ws + WS_CTL);
    F.x = args.in[0]; F.c = args.in[1]; F.ctx = args.in[2]; F.cctx = args.in[3]; F.w_ada = args.in[4]; F.b_ada = args.in[5]; F.norm1_w = args.in[6]; F.w_in = args.in[7]; F.rpb = args.in[8];
    F.sgu_norm_w = args.in[9]; F.sgu_w = args.in[10]; F.sgu_b = args.in[11]; F.gna = args.in[12]; F.gsgu = args.in[13]; F.w_out = args.in[14]; F.norm2_w = args.in[15];
    F.w_ff1 = args.in[16]; F.w_ff2 = args.in[17]; F.fnw = args.in[18]; F.out = args.out;
    F.modf = (float*)(ws + WS_MODF); F.part = (float*)(ws + WS_PART); F.ssna = (float*)(ws + WS_SSNA); F.sssg = (float*)(ws + WS_SSSG); F.cbias = (float*)(ws + WS_CBIAS); F.pss = (float*)(ws + WS_PSS);
    F.Wt_in = (bf16*)(ws + WS_WIN); F.Wt_out = (bf16*)(ws + WS_WOUT); F.Wt_ff1 = (bf16*)(ws + WS_WFF1); F.Wt_ff2 = (bf16*)(ws + WS_WFF2);
    F.A1 = (bf16*)(ws + WS_A1); F.QB = (bf16*)(ws + WS_Q); F.KB = (bf16*)(ws + WS_K); F.VT = (bf16*)(ws + WS_VT); F.UB = (bf16*)(ws + WS_U); F.GT = (bf16*)(ws + WS_GT);
    F.A2 = (bf16*)(ws + WS_A2); F.HB = (bf16*)(ws + WS_H); F.XB = (bf16*)(ws + WS_XB);
    for (int u = F.tid; u < (LDS_BYTES - LDSCTL_OFF) / 4; u += NWAVES * 64) ((LAS unsigned*)(F.lds + LDSCTL_OFF))[u] = 0u;
    __syncthreads();
    XcdBarrier bar; bar.bar = (unsigned*)(F.ctl + CW_BAR); bar.x = 0; bar.st = nullptr;
    if (MK_N_LAUNCHES == 1) bar = xcd_barrier_post((unsigned*)(F.ctl + CW_BAR), F.MISC + 8);
    const int lo = args.ph_lo, hi = args.ph_hi;
#define IN(k) (lo <= (k) && (k) < hi)
#define SEAM(k) do { if (IN(k) && IN((k) + 1)) { DBG_BEGIN(tb_); xcd_barrier(bar); DBG_END(F, 16 + (k), tb_); } } while (0)

    DBG_BEGIN(tp_);
    if (IN(0)) { for (int rep = 0; rep < REPS(0); ++rep) p0_prologue(F); } DBG_END(F, 0, tp_); SEAM(0);
    DBG_MARK(tp_); if (IN(1)) { p1_rows(F); } DBG_END(F, 1, tp_); SEAM(1);
    DBG_MARK(tp_);
    if (IN(2)) {
        pg8::Gemm g{F.A1, F.Wt_in, MA, DIN, D}; pg8::InProjOrder S; S.G = F.G; S.c = (int)blockIdx.x;
        pg8::EpiInProj E{F.QB, WS_SLOT / 2, 0.08838834764831845f * LOG2E};
        pg8::gemm_phase<pg8::EpiInProj, pg8::InProjOrder, true, true>(F.lds + RING_OFF, g, S, E);
    } DBG_END(F, 2, tp_); SEAM(2);
    DBG_MARK(tp_);
    if (IN(3)) { { DBG_BEGIN(tc_); p3_cbias(F); DBG_END(F, 12, tc_); } for (int rep = 0; rep < REPS(3); ++rep) p3_mixers(F); } DBG_END(F, 3, tp_); SEAM(3);
    DBG_MARK(tp_);
    if (IN(4)) {
        pg8::Gemm g{F.A2, F.Wt_out, M, D, D}; pg8::StdOrder S; S.init(M, D, F.G, (int)blockIdx.x);
        pg8::Unit u0; S.next(0, u0); fill_tab_outproj(F, u0.pm, u0.pn & 3);
        pg8::EpiOutProj E{F.x, F.XB, F.A1, F.pss, (const LAS float*)(F.lds + COLTAB_OFF), (const LAS float*)(F.lds + COLTAB_OFF) + 1024, (const LAS float*)(F.lds + ROWTAB_OFF)};
        pg8::gemm_phase<pg8::EpiOutProj, pg8::StdOrder, true, true>(F.lds + RING_OFF, g, S, E);
    } DBG_END(F, 4, tp_); SEAM(4);
    DBG_MARK(tp_);
    if (IN(5)) for (int rep = 0; rep < REPS(5); ++rep) {
        pg8::Gemm g{F.A1, F.Wt_ff1, M, DFF, D}; pg8::StdOrder S; S.init(M, DFF, F.G, (int)blockIdx.x);
        pg8::Unit u0; S.next(0, u0); fill_tab_ff1(F, u0.pm, u0.pn & 3);
        pg8::EpiRelu2 E{F.HB, DFF, (const LAS float*)(F.lds + COLTAB_OFF), (const LAS float*)(F.lds + ROWTAB_OFF)};
        pg8::gemm_phase<pg8::EpiRelu2, pg8::StdOrder, true, true>(F.lds + RING_OFF, g, S, E);
    } DBG_END(F, 5, tp_); SEAM(5);
    DBG_MARK(tp_);
    if (IN(6)) {
        pg8::Gemm g{F.HB, F.Wt_ff2, M, D, DFF}; pg8::StdOrder S; S.init(M, D, F.G, (int)blockIdx.x);
        pg8::Unit u0; S.next(0, u0); fill_tab_ff2(F, u0.pm, u0.pn & 3);
        pg8::EpiGatedRes E{F.XB, (const LAS float*)(F.lds + COLTAB_OFF)};
        pg8::gemm_phase<pg8::EpiGatedRes, pg8::StdOrder, true, true>(F.lds + RING_OFF, g, S, E);
    } DBG_END(F, 6, tp_); SEAM(6);
    DBG_MARK(tp_);
    if (IN(7)) { p9_final(F); } DBG_END(F, 7, tp_);
    if (DBG_SLOT >= 0) {
        __syncthreads();
        if (blockIdx.x == 0 && F.tid == 0) { const unsigned long long v = (unsigned long long)__hip_atomic_load((unsigned*)(F.ctl + CW_DBG + 64 * (DBG_SLOT >= 0 ? DBG_SLOT : 0)), RLX_AGENT) * DBG_MULT;
            const unsigned long long t0 = __builtin_amdgcn_s_memrealtime(); while (__builtin_amdgcn_s_memrealtime() - t0 < v) __builtin_amdgcn_s_sleep(8); }
    }
#undef IN
#undef SEAM
}

extern "C" void kernel_launch(void* const* d_in, const int* in_sizes, int n_in, void* d_out, int out_size, void* d_ws, size_t ws_size, hipStream_t stream) {
    static int grid = 0;
    if (grid == 0) {
        if (n_in != 19 || in_sizes[0] != M * D || out_size != M * D || ws_size < WS_END) { fprintf(stderr, "kernel_launch: unexpected shapes / workspace (%zu)\n", ws_size); grid = -1; return; }
        int dev = 0, cus = 0, per_cu = 0;
        if (hipGetDevice(&dev) != hipSuccess || hipDeviceGetAttribute(&cus, hipDeviceAttributeMultiprocessorCount, dev) != hipSuccess) { grid = -1; return; }
        if (hipFuncSetAttribute((const void*)mk_fwd, hipFuncAttributeMaxDynamicSharedMemorySize, LDS_BYTES) != hipSuccess) { grid = -1; return; }
        if (hipOccupancyMaxActiveBlocksPerMultiprocessor(&per_cu, (const void*)mk_fwd, NWAVES * 64, LDS_BYTES) != hipSuccess || per_cu < 1) { fprintf(stderr, "kernel_launch: occupancy query says %d\n", per_cu); }
        (void)hipGetLastError();
        if (cus < 256) { fprintf(stderr, "kernel_launch: needs 256 CUs, device has %d\n", cus); grid = -1; return; }
        grid = 256;
    }
    if (grid < 0) return;
    if (hipMemsetAsync((char*)d_ws + WS_CTL, 0, CTL_ZERO_BYTES, stream) != hipSuccess) return;
    Args a{};
    for (int i = 0; i < 19; ++i) a.in[i] = (const float*)d_in[i];
    a.out = (float*)d_out; a.ws = (unsigned char*)d_ws;
    if (MK_N_LAUNCHES == 1) { a.ph_lo = 0; a.ph_hi = N_PHASES; hipLaunchKernelGGL(mk_fwd, dim3(grid), dim3(NWAVES * 64), LDS_BYTES, stream, a); }
    else for (int p = 0; p < N_PHASES; ++p) { a.ph_lo = p; a.ph_hi = p + 1; hipLaunchKernelGGL(mk_fwd, dim3(grid), dim3(NWAVES * 64), LDS_BYTES, stream, a); }
}
```

```cpp
#include <hip/hip_runtime.h>
#include <cstdio>
#include <cstdint>
namespace pg8 {
#define PG8_LAS __attribute__((address_space(3)))
typedef unsigned short bf16_t;
typedef short bf16x8 __attribute__((ext_vector_type(8)));
typedef float f32x4 __attribute__((ext_vector_type(4)));
typedef unsigned u32x4 __attribute__((ext_vector_type(4)));
constexpr int BM = 256, BK = 64, HALF = 128, HTB = HALF * BK * 2  , STAGE_BYTES = 8 * HTB, NXCD = 8, WGM = 8;

__host__ __device__ __forceinline__ int lds_byte(int r, int c) { const int st = (r >> 4) * 2 + (c >> 5), rr = r & 15, cc = c & 31, ob = rr * 64 + cc * 2; return st * 1024 + (ob ^ (((ob >> 9) & 1) << 5)); }
__host__ __device__ __forceinline__ void stage_rc(int b, int& R, int& C) { const int st = b / 1024, sb = b % 1024, swz = sb ^ (((sb >> 9) & 1) << 5); R = (st >> 1) * 16 + swz / 64; C = (st & 1) * 32 + (swz % 64) / 2; }
__host__ __device__ __forceinline__ int perm32(int rho) { const int n = rho >> 4, i = rho & 15; return 8 * (i >> 2) + 4 * n + (i & 3); }

struct Unit { int pm, pn, ui; };
struct Gemm { const bf16_t* A; const bf16_t* Bt; int M, N, K, ld; };

__device__ __forceinline__ void std_map(int wgid, int nM, int nN, Unit& u, int wgm = WGM) {
    const int nwg = nM * nN;
    { const int q = nwg / NXCD, r = nwg % NXCD, xcd = wgid % NXCD, off = wgid / NXCD; wgid = (xcd < r ? xcd * (q + 1) : r * (q + 1) + (xcd - r) * q) + off; }
    const int nig = wgm * nN, gid = wgid / nig, fm = gid * wgm, gsz = (nM - fm) < wgm ? (nM - fm) : wgm;
    u.pm = fm + ((wgid % nig) % gsz); u.pn = (wgid % nig) / gsz;
}
struct StdOrder {
    int nM, nN, nwg, G, c, wgm;
    __device__ void init(int M, int N, int G_, int c_, int wgm_ = WGM) { nM = M / BM; nN = N / BM; nwg = nM * nN; G = G_; c = c_; wgm = wgm_; }
    __device__ bool next(int i, Unit& u) const { const long L = (long)i * G + c; if (L >= nwg) return false; std_map((int)L, nM, nN, u, wgm); u.ui = i; return true; }
    __device__ __forceinline__ void bases(const Unit& u, const Gemm& g, size_t tstep, const char*& a, const char*& b) const { a = (const char*)g.A + (size_t)u.pm * tstep; b = (const char*)g.Bt + (size_t)u.pn * tstep; }
    __device__ __forceinline__ void a_ready(const Unit&) const {}
    __device__ __forceinline__ void done(const Unit&) const {}
};
struct InProjOrder {
    int G, c;
    __device__ bool next(int i, Unit& u) const {
        const long L = (long)i * G + c;
        u.ui = i;
        if (L < 2560) { std_map((int)L, 64, 40, u); return true; }
        if (L < 2624) { const int j = (int)L - 2560; u.pm = 64 + (j >> 4); u.pn = 8 + (j & 15); return true; }
        return false;
    }
    __device__ __forceinline__ void bases(const Unit& u, const Gemm& g, size_t tstep, const char*& a, const char*& b) const {
        const int ty = u.pn >> 3; const bool sw = (ty == 2) || (ty == 4);
        const char* act = (const char*)g.A + (size_t)u.pm * tstep; const char* w = (const char*)g.Bt + (size_t)u.pn * tstep;
        a = sw ? w : act; b = sw ? act : w;
    }
    __device__ __forceinline__ void a_ready(const Unit&) const {}
    __device__ __forceinline__ void done(const Unit&) const {}
};

__device__ __forceinline__ unsigned cvt_pk_bf16(float lo, float hi) { unsigned r; asm volatile("v_cvt_pk_bf16_f32 %0, %1, %2" : "=v"(r) : "v"(lo), "v"(hi)); return r; }
__device__ __forceinline__ f32x4 lds_ld4(const PG8_LAS float* p) { f32x4 v; asm volatile("ds_read_b128 %0, %1\n\ts_waitcnt lgkmcnt(0)" : "=v"(v) : "v"((unsigned)(size_t)p) : "memory"); return v; }
__device__ __forceinline__ float lds_ld1(const PG8_LAS float* p) { float v; asm volatile("ds_read_b32 %0, %1\n\ts_waitcnt lgkmcnt(0)" : "=v"(v) : "v"((unsigned)(size_t)p) : "memory"); return v; }
__device__ __forceinline__ float gelu_t(float x) { const float u = x * (0.7978845608f + 0.0356774081f * x * x); const float t = __builtin_amdgcn_exp2f(-2.8853900818f * u); return x * __builtin_amdgcn_rcpf(1.0f + t); }

template <int CTRL> __device__ __forceinline__ float dpp_f(float x) { return __builtin_bit_cast(float, __builtin_amdgcn_mov_dpp(__builtin_bit_cast(int, x), CTRL, 0xf, 0xf, true)); }
__device__ __forceinline__ float row16_sum(float s) {
    s += dpp_f<0xB1>(s); s += dpp_f<0x4E>(s); s += dpp_f<0x124>(s); s += dpp_f<0x128>(s); return s; }
struct EpiInProj {
    static constexpr bool PERM = true, AFTER_DRAIN = false, MIDK = false;
    __device__ __forceinline__ void midk(f32x4 (&)[2][2][4][2], int, int) const {}
    bf16_t* base0; size_t slot; float qscale; float* ssg;
    __device__ __forceinline__ void operator()(const f32x4 (&acc)[2][2][4][2], const Unit& u, int wr, int wc, int fr, int fq) const {
        const int ty = u.pn >> 3, sub = (u.pn & 7) * BM, tokb = u.pm * BM;
        bf16_t* base = base0 + (size_t)ty * slot; const bool sw = (ty == 2) || (ty == 4);
        const int ldc = (ty == 2) ? 17408 : ((ty == 4) ? 16384 : 2048), rb = sw ? sub : tokb, cb = sw ? tokb : sub;
        const float sc = (ty == 0) ? qscale : 1.f; const bool act = ty >= 3;
        const int row0 = rb + wr * 64 + fr, col0 = cb + wc * 32 + 8 * fq;
        f32x4 sq[2][2];
#pragma unroll
        for (int bj = 0; bj < 2; ++bj) { sq[bj][0] = (f32x4){0.f, 0.f, 0.f, 0.f}; sq[bj][1] = (f32x4){0.f, 0.f, 0.f, 0.f}; }
#pragma unroll
        for (int ai = 0; ai < 2; ++ai)
#pragma unroll
            for (int m = 0; m < 4; ++m) { bf16_t* rowp = base + (size_t)(row0 + ai * HALF + m * 16) * ldc + col0;
#pragma unroll
                for (int bj = 0; bj < 2; ++bj) { f32x4 v0 = acc[ai][bj][m][0] * sc, v1 = acc[ai][bj][m][1] * sc;
                    if (act) {
#pragma unroll
                        for (int j = 0; j < 4; ++j) { v0[j] = gelu_t(v0[j]); v1[j] = gelu_t(v1[j]); }
                        sq[bj][0] += v0 * v0; sq[bj][1] += v1 * v1; }
                    u32x4 w; w.x = cvt_pk_bf16(v0[0], v0[1]); w.y = cvt_pk_bf16(v0[2], v0[3]); w.z = cvt_pk_bf16(v1[0], v1[1]); w.w = cvt_pk_bf16(v1[2], v1[3]);
                    *(u32x4*)(rowp + bj * HALF) = w; } }
        if (ty == 4) {
            float* sp = ssg + (size_t)(col0) * 16 + (u.pn & 7) * 2 + wr;
#pragma unroll
            for (int bj = 0; bj < 2; ++bj)
#pragma unroll
                for (int n = 0; n < 2; ++n)
#pragma unroll
                    for (int j = 0; j < 4; ++j) { const float s = row16_sum(sq[bj][n][j]); if (fr == 0) sp[(size_t)(bj * HALF + 4 * n + j) * 16] = s; }
        }
    }
};
__device__ __forceinline__ float xrow_sum(float x) {
    auto s = __builtin_amdgcn_permlane16_swap(__float_as_uint(x), __float_as_uint(x), false, false);
    x = __uint_as_float(s[0]) + __uint_as_float(s[1]);
    auto t = __builtin_amdgcn_permlane32_swap(__float_as_uint(x), __float_as_uint(x), false, false);
    return __uint_as_float(t[0]) + __uint_as_float(t[1]);
}
typedef unsigned u32x2 __attribute__((ext_vector_type(2)));
struct EpiRelu2 {
    static constexpr bool PERM = true, AFTER_DRAIN = false, MIDK = false;
    bf16_t* O; int ldc; const PG8_LAS float* cb; const PG8_LAS float* rs;
    __device__ __forceinline__ void midk(f32x4 (&)[2][2][4][2], int, int) const {}
    __device__ __forceinline__ void operator()(const f32x4 (&acc)[2][2][4][2], const Unit& u, int wr, int wc, int fr, int fq) const {
        const int row0 = u.pm * BM + wr * 64 + fr, cin = wc * 32 + 8 * fq, col0 = u.pn * BM + cin;
        const PG8_LAS float* bp = cb + (u.pn >> 2) * BM + cin;
        f32x4 bv[2][2];
#pragma unroll
        for (int bj = 0; bj < 2; ++bj)
#pragma unroll
            for (int n = 0; n < 2; ++n) bv[bj][n] = lds_ld4(bp + bj * HALF + 4 * n);
#pragma unroll
        for (int ai = 0; ai < 2; ++ai)
#pragma unroll
            for (int m = 0; m < 4; ++m) { bf16_t* rowp = O + (size_t)(row0 + ai * HALF + m * 16) * ldc + col0; const float r = lds_ld1(rs + ai * HALF + wr * 64 + m * 16 + fr);
#pragma unroll
                for (int bj = 0; bj < 2; ++bj) { f32x4 v0 = acc[ai][bj][m][0] * r + bv[bj][0], v1 = acc[ai][bj][m][1] * r + bv[bj][1];
#pragma unroll
                    for (int j = 0; j < 4; ++j) { const float a = fmaxf(v0[j], 0.f), b = fmaxf(v1[j], 0.f); v0[j] = a * a; v1[j] = b * b; }
                    u32x4 w; w.x = cvt_pk_bf16(v0[0], v0[1]); w.y = cvt_pk_bf16(v0[2], v0[3]); w.z = cvt_pk_bf16(v1[0], v1[1]); w.w = cvt_pk_bf16(v1[2], v1[3]);
                    *(u32x4*)(rowp + bj * HALF) = w; } }
    }
};
struct EpiOutProj {
    static constexpr bool PERM = true, AFTER_DRAIN = false, MIDK = true;
    const float* x; bf16_t* x1b; bf16_t* a3; int lda3; float* pss; const PG8_LAS float* gvt; const PG8_LAS float* avt; const PG8_LAS float* tab;
    __device__ __forceinline__ void midk(f32x4 (&acc)[2][2][4][2], int wr, int fr) const {
#pragma unroll
        for (int ai = 0; ai < 2; ++ai)
#pragma unroll
            for (int m = 0; m < 4; ++m) { const float f = lds_ld1(tab + ai * HALF + wr * 64 + m * 16 + fr);
#pragma unroll
                for (int bj = 0; bj < 2; ++bj)
#pragma unroll
                    for (int n = 0; n < 2; ++n) acc[ai][bj][m][n] *= f; }
    }
    __device__ __forceinline__ void operator()(const f32x4 (&acc)[2][2][4][2], const Unit& u, int wr, int wc, int fr, int fq) const {
        const int cin = wc * 32 + 8 * fq, col0 = u.pn * BM + cin, tr0 = wr * 64 + fr, ct0 = (u.pn >> 2) * BM + cin;
        const size_t off0 = (size_t)(u.pm * BM + tr0) * 4096 + col0;
        float ss[2][4];
#pragma unroll
        for (int ai = 0; ai < 2; ++ai)
#pragma unroll
            for (int m = 0; m < 4; ++m) ss[ai][m] = 0.f;
#pragma unroll
        for (int bj = 0; bj < 2; ++bj) {
            const f32x4 g0 = lds_ld4(gvt + ct0 + bj * HALF), g1 = lds_ld4(gvt + ct0 + bj * HALF + 4);
            const f32x4 a0 = lds_ld4(avt + ct0 + bj * HALF), a1 = lds_ld4(avt + ct0 + bj * HALF + 4);
#pragma unroll
            for (int ai = 0; ai < 2; ++ai)
#pragma unroll
                for (int m = 0; m < 4; ++m) { const size_t off = off0 + (size_t)(ai * HALF + m * 16) * 4096 + bj * HALF; const float r = lds_ld1(tab + 256 + ai * HALF + m * 16 + tr0);
                    const f32x4 v0 = *(const f32x4*)(x + off) + g0 * (acc[ai][bj][m][0] * r), v1 = *(const f32x4*)(x + off + 4) + g1 * (acc[ai][bj][m][1] * r);
                    { u32x4 w1; w1.x = cvt_pk_bf16(v0.x, v0.y); w1.y = cvt_pk_bf16(v0.z, v0.w); w1.z = cvt_pk_bf16(v1.x, v1.y); w1.w = cvt_pk_bf16(v1.z, v1.w); *(u32x4*)(x1b + off) = w1; }
                    ss[ai][m] += ((v0.x * v0.x + v0.y * v0.y) + (v0.z * v0.z + v0.w * v0.w)) + ((v1.x * v1.x + v1.y * v1.y) + (v1.z * v1.z + v1.w * v1.w));
                    const f32x4 b0 = v0 * a0, b1 = v1 * a1; u32x4 w; w.x = cvt_pk_bf16(b0.x, b0.y); w.y = cvt_pk_bf16(b0.z, b0.w); w.z = cvt_pk_bf16(b1.x, b1.y); w.w = cvt_pk_bf16(b1.z, b1.w);
                    *(u32x4*)(a3 + (size_t)(u.pm * BM + tr0 + ai * HALF + m * 16) * lda3 + col0 + bj * HALF) = w; }
            asm volatile("" ::: "memory"); }
#pragma unroll
        for (int ai = 0; ai < 2; ++ai)
#pragma unroll
            for (int m = 0; m < 4; ++m) { const float s = xrow_sum(ss[ai][m]);
                if (fq == 0) pss[(size_t)(u.pm * BM + ai * HALF + m * 16 + tr0) * 64 + u.pn * 4 + wc] = s; }
    }
};
struct EpiGatedRes {
    static constexpr bool PERM = true, AFTER_DRAIN = false, MIDK = false;
    bf16_t* xb; const PG8_LAS float* gvt;
    __device__ __forceinline__ void midk(f32x4 (&)[2][2][4][2], int, int) const {}
    __device__ __forceinline__ void operator()(const f32x4 (&acc)[2][2][4][2], const Unit& u, int wr, int wc, int fr, int fq) const {
        const int cin = wc * 32 + 8 * fq, col0 = u.pn * BM + cin, ct0 = u.ui * BM + cin;
        const size_t off0 = (size_t)(u.pm * BM + wr * 64 + fr) * 4096 + col0;
#pragma unroll
        for (int bj = 0; bj < 2; ++bj) {
            const f32x4 g0 = lds_ld4(gvt + ct0 + bj * HALF), g1 = lds_ld4(gvt + ct0 + bj * HALF + 4);
#pragma unroll
            for (int ai = 0; ai < 2; ++ai)
#pragma unroll
                for (int m = 0; m < 4; ++m) { const size_t off = off0 + (size_t)(ai * HALF + m * 16) * 4096 + bj * HALF;
                    const u32x4 b = *(const u32x4*)(xb + off);
                    const f32x4 v0 = (f32x4){__uint_as_float(b.x << 16), __uint_as_float(b.x & 0xffff0000u), __uint_as_float(b.y << 16), __uint_as_float(b.y & 0xffff0000u)} + g0 * acc[ai][bj][m][0];
                    const f32x4 v1 = (f32x4){__uint_as_float(b.z << 16), __uint_as_float(b.z & 0xffff0000u), __uint_as_float(b.w << 16), __uint_as_float(b.w & 0xffff0000u)} + g1 * acc[ai][bj][m][1];
                    u32x4 w; w.x = cvt_pk_bf16(v0.x, v0.y); w.y = cvt_pk_bf16(v0.z, v0.w); w.z = cvt_pk_bf16(v1.x, v1.y); w.w = cvt_pk_bf16(v1.z, v1.w);
                    *(u32x4*)(xb + off) = w; }
            asm volatile("" ::: "memory"); }
    }
};

template <class Epi, class Sched, bool ALIGN_EPI = false, bool SP2 = false>
__device__ __forceinline__ void gemm_phase(PG8_LAS unsigned char* lds, const Gemm g, const Sched& S, const Epi& E) {
    const int tid = threadIdx.x, wid = __builtin_amdgcn_readfirstlane(tid >> 6), lane = tid & 63, wr = wid >> 2, wc = wid & 3, fr = lane & 15, fq = lane >> 4;
    const int K = g.K, nt = K / BK;
    unsigned voffA[2], voffB[2];
#pragma unroll
    for (int i = 0; i < 2; ++i) { int R, C; stage_rc(tid * 16 + i * 8192, R, C); const int Rb = Epi::PERM ? ((R & ~31) + perm32(R & 31)) : R;
        voffA[i] = (unsigned)(R * g.ld + C) * 2u; voffB[i] = (unsigned)(Rb * g.ld + C) * 2u; }
    const size_t kstep = (size_t)(BK * 2);
    const size_t hstep = (size_t)HALF * g.ld * 2;
    const size_t tstep = 2 * hstep;
    const unsigned ldsw = (unsigned)wid * 1024u;
    const int aoff = lds_byte(wr * 64 + fr, fq * 8), boff = lds_byte(wc * 32 + fr, fq * 8);
#define PG8_SA(b, h) (((b) * 2 + (h)) * HTB)
#define PG8_SB(b, h) ((4 + (b) * 2 + (h)) * HTB)
#define PG8_STAGE(bufoff, gbase, voff) do { _Pragma("unroll") for (int _i = 0; _i < 2; ++_i) \
        __builtin_amdgcn_global_load_lds((const unsigned*)((const char*)(gbase) + (voff)[_i]), (PG8_LAS unsigned*)(lds + (bufoff) + ldsw + _i * 8192), 16, 0, 0); } while (0)
#define PG8_LDA(dst, b, h) do { _Pragma("unroll") for (int m = 0; m < 4; ++m) _Pragma("unroll") for (int k = 0; k < 2; ++k) dst[m][k] = *(const PG8_LAS bf16x8*)(lds + PG8_SA(b, h) + aoff + m * 2048 + k * 1024); } while (0)
#define PG8_LDB(dst, b, h) do { _Pragma("unroll") for (int n = 0; n < 2; ++n) _Pragma("unroll") for (int k = 0; k < 2; ++k) dst[n][k] = *(const PG8_LAS bf16x8*)(lds + PG8_SB(b, h) + boff + n * 2048 + k * 1024); } while (0)
#define PG8_MMA(ai, bj, At, Bt) do { __builtin_amdgcn_s_setprio(1); _Pragma("unroll") for (int m = 0; m < 4; ++m) _Pragma("unroll") for (int n = 0; n < 2; ++n) _Pragma("unroll") for (int k = 0; k < 2; ++k) \
        acc[ai][bj][m][n] = __builtin_amdgcn_mfma_f32_16x16x32_bf16(Bt[n][k], At[m][k], acc[ai][bj][m][n], 0, 0, 0); __builtin_amdgcn_s_setprio(0); } while (0)
#define PG8_WAIT_V(n) asm volatile("s_waitcnt vmcnt(" #n ")" ::: "memory")
#define PG8_WAIT_L(n) asm volatile("s_waitcnt lgkmcnt(" #n ")" ::: "memory")
#define PG8_BAR __builtin_amdgcn_s_barrier()
#define PG8_SCHED __builtin_amdgcn_sched_barrier(0)
    Unit cur, nxt; int ui = 0;
    if (!S.next(0, cur)) return;
    f32x4 acc[2][2][4][2];
#pragma unroll
    for (int a = 0; a < 2; ++a)
#pragma unroll
        for (int b = 0; b < 2; ++b)
#pragma unroll
            for (int m = 0; m < 4; ++m)
#pragma unroll
                for (int n = 0; n < 2; ++n) acc[a][b][m][n] = (f32x4){0.f, 0.f, 0.f, 0.f};
    bf16x8 At[4][2], B0[2][2], B1[2][2];
    const char* cA; const char* cB; S.bases(cur, g, tstep, cA, cB);
    S.a_ready(cur);
    if constexpr (SP2) {
        PG8_STAGE(PG8_SB(0, 0), cB, voffB); PG8_STAGE(PG8_SB(0, 1), cB + hstep, voffB); PG8_STAGE(PG8_SA(0, 0), cA, voffA); PG8_STAGE(PG8_SA(0, 1), cA + hstep, voffA);
        if (wr == 1) PG8_BAR;
        PG8_WAIT_V(2); PG8_BAR;
        PG8_STAGE(PG8_SB(1, 0), cB + kstep, voffB); PG8_STAGE(PG8_SA(1, 0), cA + kstep, voffA); PG8_STAGE(PG8_SB(1, 1), cB + hstep + kstep, voffB);
        PG8_WAIT_V(6); PG8_BAR;
    } else {
        PG8_STAGE(PG8_SB(0, 0), cB, voffB); PG8_STAGE(PG8_SA(0, 0), cA, voffA); PG8_STAGE(PG8_SB(0, 1), cB + hstep, voffB); PG8_STAGE(PG8_SA(0, 1), cA + hstep, voffA);
        if (wr == 1) PG8_BAR;
        PG8_WAIT_V(4); PG8_BAR;
        PG8_STAGE(PG8_SB(1, 0), cB + kstep, voffB); PG8_STAGE(PG8_SA(1, 0), cA + kstep, voffA); PG8_STAGE(PG8_SB(1, 1), cB + hstep + kstep, voffB);
        PG8_WAIT_V(6); PG8_BAR;
    }
    for (;;) {
        const bool has_next = S.next(ui + 1, nxt);
        const char* nA = cA; const char* nB = cB; if (has_next) S.bases(nxt, g, tstep, nA, nB);
        for (int t = 0; t < nt; t += 2) {
            const bool last = (t == nt - 2);
            const char* a1 = cA + (size_t)(t + 1) * kstep;
            const char* a2 = last ? nA : cA + (size_t)(t + 2) * kstep; const char* b2 = last ? nB : cB + (size_t)(t + 2) * kstep;
            const char* a3 = a2 + kstep; const char* b3 = b2 + kstep;
            if (last && has_next) S.a_ready(nxt);
            if constexpr (Epi::MIDK) { if (t == (nt >> 1)) { E.midk(acc, wr, fr); asm volatile("s_waitcnt lgkmcnt(0)" ::: "memory"); } }
            if constexpr (SP2) {
            PG8_LDB(B0, 0, 0); PG8_LDB(B1, 0, 1); PG8_SCHED; PG8_LDA(At, 0, 0); PG8_STAGE(PG8_SA(1, 1), a1 + hstep, voffA);
            PG8_WAIT_V(8); PG8_WAIT_L(0); PG8_BAR; PG8_MMA(0, 0, At, B0); PG8_MMA(0, 1, At, B1); PG8_BAR; PG8_SCHED;
            PG8_LDA(At, 0, 1); PG8_STAGE(PG8_SB(0, 0), b2, voffB); PG8_STAGE(PG8_SB(0, 1), b2 + hstep, voffB); PG8_STAGE(PG8_SA(0, 0), a2, voffA);
            PG8_WAIT_V(8); PG8_WAIT_L(0); PG8_BAR; PG8_MMA(1, 0, At, B0); PG8_MMA(1, 1, At, B1); PG8_BAR; PG8_SCHED;
            PG8_LDB(B0, 1, 0); PG8_LDB(B1, 1, 1); PG8_SCHED; PG8_LDA(At, 1, 0); PG8_STAGE(PG8_SA(0, 1), a2 + hstep, voffA);
            PG8_WAIT_V(8); PG8_WAIT_L(0); PG8_BAR; PG8_MMA(0, 0, At, B0); PG8_MMA(0, 1, At, B1); PG8_BAR; PG8_SCHED;
            PG8_LDA(At, 1, 1); PG8_STAGE(PG8_SB(1, 0), b3, voffB); PG8_STAGE(PG8_SB(1, 1), b3 + hstep, voffB); PG8_STAGE(PG8_SA(1, 0), a3, voffA);
            PG8_WAIT_V(8); PG8_WAIT_L(0); PG8_BAR; PG8_MMA(1, 0, At, B0); PG8_MMA(1, 1, At, B1); PG8_BAR; PG8_SCHED;
            } else {
            PG8_LDB(B0, 0, 0); PG8_SCHED; PG8_LDA(At, 0, 0); PG8_STAGE(PG8_SA(1, 1), a1 + hstep, voffA);
            PG8_WAIT_L(8); PG8_BAR; PG8_WAIT_L(0); PG8_MMA(0, 0, At, B0); PG8_BAR; PG8_SCHED;
            PG8_LDB(B1, 0, 1); PG8_STAGE(PG8_SB(0, 0), b2, voffB);
            PG8_BAR; PG8_WAIT_L(0); PG8_MMA(0, 1, At, B1); PG8_BAR;
            PG8_LDA(At, 0, 1); PG8_STAGE(PG8_SA(0, 0), a2, voffA);
            PG8_BAR; PG8_WAIT_L(0); PG8_MMA(1, 0, At, B0); PG8_BAR; PG8_SCHED;
            PG8_STAGE(PG8_SB(0, 1), b2 + hstep, voffB);
            PG8_WAIT_V(6); PG8_BAR; PG8_MMA(1, 1, At, B1); PG8_BAR;
            PG8_LDB(B0, 1, 0); PG8_SCHED; PG8_LDA(At, 1, 0); PG8_STAGE(PG8_SA(0, 1), a2 + hstep, voffA);
            PG8_WAIT_L(8); PG8_BAR; PG8_WAIT_L(0); PG8_MMA(0, 0, At, B0); PG8_BAR; PG8_SCHED;
            PG8_LDB(B1, 1, 1); PG8_STAGE(PG8_SB(1, 0), b3, voffB);
            PG8_BAR; PG8_WAIT_L(0); PG8_MMA(0, 1, At, B1); PG8_BAR;
            PG8_LDA(At, 1, 1); PG8_STAGE(PG8_SA(1, 0), a3, voffA);
            PG8_BAR; PG8_WAIT_L(0); PG8_MMA(1, 0, At, B0); PG8_BAR; PG8_SCHED;
            PG8_STAGE(PG8_SB(1, 1), b3 + hstep, voffB);
            PG8_WAIT_V(6); PG8_BAR; PG8_MMA(1, 1, At, B1); PG8_BAR;
            }
        }
        if constexpr (ALIGN_EPI) { if (wr == 0) PG8_BAR; }
        if constexpr (!Epi::AFTER_DRAIN) { E(acc, cur, wr, wc, fr, fq); S.done(cur); }
        if (!has_next) break;
#pragma unroll
        for (int a = 0; a < 2; ++a)
#pragma unroll
            for (int b = 0; b < 2; ++b)
#pragma unroll
                for (int m = 0; m < 4; ++m)
#pragma unroll
                    for (int n = 0; n < 2; ++n) acc[a][b][m][n] = (f32x4){0.f, 0.f, 0.f, 0.f};
        cur = nxt; cA = nA; cB = nB; ++ui;
        if constexpr (ALIGN_EPI) { if (wr == 1) PG8_BAR; }
    }
    PG8_WAIT_V(0);
    if constexpr (!ALIGN_EPI) { if (wr == 0) PG8_BAR; }
    PG8_BAR;
    if constexpr (Epi::AFTER_DRAIN) { E.fused(acc, cur, wr, wc, fr, fq, lds, wid, lane); S.done(cur); }
#undef PG8_SA
#undef PG8_SB
#undef PG8_STAGE
#undef PG8_LDA
#undef PG8_LDB
#undef PG8_MMA
#undef PG8_WAIT_V
#undef PG8_WAIT_L
#undef PG8_BAR
#undef PG8_SCHED
}
}

constexpr int NWAVES = 8;
#ifndef MK_N_LAUNCHES
#define MK_N_LAUNCHES 1
#endif
constexpr int N_PHASES = 8;
#ifndef FF2_WGM
#define FF2_WGM 4
#endif
#ifndef REP_PHASE
#define REP_PHASE -1
#endif
#define REPS(k) (((k) == REP_PHASE) ? 2 : 1)
#ifndef DBG_MULT
#define DBG_MULT 4
#endif
#ifndef DBG_SLOT
#define DBG_SLOT -1
#endif
constexpr int D = 4096, BATCH = 4, SEQ = 4096, GW = 64, CTX = 256;
constexpr int NH = 16, HD = 128, DNA = 2048, DSGU = 2048, DIN = 10240, DFF = 16384, NMODC = 6 * D;
constexpr int LDK = D;
constexpr int LDF2 = DFF + 64;
constexpr int M = BATCH * SEQ, MC = BATCH * CTX, MA = M + MC;
constexpr float EPS = 1e-6f;
constexpr float LOG2E = 1.4426950408889634f;
constexpr int ADA_KS = 16, ADA_STRIPS = NMODC / 256;

constexpr size_t MiB = 1u << 20;
constexpr size_t WS_CTL = 0, CTL_ZERO_BYTES = 1 * MiB;
constexpr size_t WS_MODF = 1 * MiB;
constexpr size_t WS_PART = 2 * MiB;
constexpr size_t WS_SSNA = 10 * MiB;
constexpr size_t WS_SSGP = 2 * MiB;
constexpr size_t WS_SSSG = 11 * MiB;
constexpr size_t WS_CBIAS = 11 * MiB + 512 * 1024;
constexpr size_t WS_PSS = 12 * MiB;
constexpr size_t WS_WIN = 16 * MiB;
constexpr size_t WS_WOUT = 96 * MiB;
constexpr size_t WS_WFF1 = 128 * MiB;
constexpr size_t WS_WFF2 = 260 * MiB;
constexpr size_t WS_A1 = 390 * MiB;
constexpr size_t WS_SLOT = 68 * MiB;
constexpr size_t WS_Q = 526 * MiB;
constexpr size_t WS_K = WS_Q + 1 * WS_SLOT;
constexpr size_t WS_VT = WS_Q + 2 * WS_SLOT;
constexpr size_t WS_U = WS_Q + 3 * WS_SLOT;
constexpr size_t WS_GT = WS_Q + 4 * WS_SLOT;
constexpr size_t WS_A2 = WS_Q + 5 * WS_SLOT;
constexpr size_t WS_H = 526 * MiB;
constexpr size_t WS_XB = 1040 * MiB;
constexpr size_t WS_END = 1168 * MiB;
static_assert(WS_A1 + (size_t)MA * D * 2 <= WS_Q && WS_K + (size_t)MA * DNA * 2 <= WS_VT && WS_VT + (size_t)DNA * MA * 2 <= WS_U && WS_GT + (size_t)DSGU * M * 2 <= WS_A2 && WS_A2 + (size_t)M * D * 2 <= WS_END && WS_H + (size_t)M * LDF2 * 2 <= WS_XB && WS_WFF2 + (size_t)D * LDF2 * 2 <= WS_A1 && WS_WFF1 + (size_t)DFF * LDK * 2 <= WS_WFF2 && WS_A1 + (size_t)M * LDK * 2 <= WS_Q && WS_XB + (size_t)M * D * 2 <= WS_END, "d_ws map");
constexpr int CW_BAR = 4096;

constexpr int RING_OFF = 0, RING_BYTES = 131072;
constexpr int ROWTAB_OFF = RING_BYTES, COLTAB_OFF = ROWTAB_OFF + 2048;
constexpr int LDSCTL_OFF = 149504, MISC_OFF = LDSCTL_OFF + 320;
constexpr int LDS_BYTES = 150528;
static_assert(COLTAB_OFF + 16384 <= LDSCTL_OFF && MISC_OFF + 128 <= LDS_BYTES, "LDS map");

#define GAS __attribute__((address_space(1)))
#define LAS __attribute__((address_space(3)))
typedef unsigned short bf16;
typedef unsigned v4u __attribute__((ext_vector_type(4)));
typedef unsigned v2u __attribute__((ext_vector_type(2)));
typedef float f32x4 __attribute__((ext_vector_type(4)));
typedef short bf16x8 __attribute__((ext_vector_type(8)));
typedef GAS unsigned gu32;
#define RLX_AGENT __ATOMIC_RELAXED, __HIP_MEMORY_SCOPE_AGENT
#define LDS_WAIT() asm volatile("s_waitcnt lgkmcnt(0)" ::: "memory")
#define VM_WAIT() asm volatile("s_waitcnt vmcnt(0)" ::: "memory")
__device__ __forceinline__ unsigned pk2(float lo, float hi) { return pg8::cvt_pk_bf16(lo, hi); }
__device__ __forceinline__ float bf_lo(unsigned w) { return __builtin_bit_cast(float, w << 16); }
__device__ __forceinline__ float bf_hi(unsigned w) { return __builtin_bit_cast(float, w & 0xffff0000u); }

#define XB_TMO      128
#define XB_XCNT(j)  (256  + 64 * (j))
#define XB_XSUB(j)  (1280 + 64 * (j))
#define XB_XGEN(j)  (2304 + 64 * (j))
#define XB_TOP      3328
#define XB_TOPGEN   3392
#define XCD_BAR_WORDS 3456
#define XB_SPIN_CAP (1u << 18)

__device__ __forceinline__ unsigned xb_ld(unsigned* p)              { return __hip_atomic_load(p, __ATOMIC_RELAXED, __HIP_MEMORY_SCOPE_AGENT); }
__device__ __forceinline__ unsigned xb_add(unsigned* p, unsigned v) { return __hip_atomic_fetch_add(p, v, __ATOMIC_RELAXED, __HIP_MEMORY_SCOPE_AGENT); }
__device__ __forceinline__ unsigned xb_xcc_id() { return (unsigned)__builtin_amdgcn_s_getreg((3 << 11) | 20) & 0xFu; }
#define XB_SPIN(cond, bar) do { unsigned _sp = 0; while (cond) { __builtin_amdgcn_s_sleep(1); \
    if ((++_sp & 255u) == 0u) { if (xb_ld(&(bar)[XB_TMO])) break; if (_sp > XB_SPIN_CAP) { atomicAdd(&(bar)[XB_TMO], 1u); break; } } } } while (0)

struct XcdBarrier {
    unsigned* bar; unsigned x;
    volatile LAS unsigned* st;
};

__device__ __forceinline__ XcdBarrier xcd_barrier_post(unsigned* bar, volatile LAS unsigned* st) {
    XcdBarrier b; b.bar = bar; b.x = xb_xcc_id(); b.st = st;
    if (threadIdx.x == 0) (void)xb_add(&bar[XB_XCNT(b.x)], 1u);
    return b;
}
__device__ __forceinline__ void xcd_barrier_complete(unsigned* bar, unsigned x, unsigned& nloc, unsigned& nx) {
    const unsigned G = gridDim.x * gridDim.y * gridDim.z;
    unsigned sum, cnt, mine, sp = 0u;
    for (;;) {
        sum = 0u; cnt = 0u; mine = 0u;
#pragma unroll
        for (unsigned j = 0; j < 16; ++j) { const unsigned c = xb_ld(&bar[XB_XCNT(j)]); sum += c; cnt += (c > 0u) ? 1u : 0u; mine = (j == x) ? c : mine; }
        if (sum == G) break;
        __builtin_amdgcn_s_sleep(1);
        if ((++sp & 255u) == 0u) { if (xb_ld(&bar[XB_TMO])) break; if (sp > XB_SPIN_CAP) { atomicAdd(&bar[XB_TMO], 1u); break; } }
    }
    nloc = mine > 0u ? mine : 1u; nx = cnt > 0u ? cnt : 1u;
}

__device__ __forceinline__ void xcd_barrier(const XcdBarrier& b) {
    asm volatile("s_waitcnt vmcnt(0)" ::: "memory");
    __syncthreads();
    if (threadIdx.x == 0) {
        unsigned* bar = b.bar;
        __builtin_amdgcn_s_waitcnt(0);
        unsigned nloc = b.st[0], nx = b.st[1];
        if (nloc == 0u) { xcd_barrier_complete(bar, b.x, nloc, nx); b.st[0] = nloc; b.st[1] = nx; }
        const unsigned old = xb_add(&bar[XB_XSUB(b.x)], 1u);
        const unsigned gen = old / nloc;
        if (old + 1u == (gen + 1u) * nloc) {
            __builtin_amdgcn_fence(__ATOMIC_RELEASE, "agent");
            asm volatile("s_waitcnt vmcnt(0)" ::: "memory");
            const unsigned og = xb_add(&bar[XB_TOP], 1u);
            const unsigned tg = og / nx;
            if (og + 1u == (tg + 1u) * nx) xb_add(&bar[XB_TOPGEN], 1u);
            else XB_SPIN(xb_ld(&bar[XB_TOPGEN]) == tg, bar);
            __builtin_amdgcn_fence(__ATOMIC_ACQUIRE, "agent");
            xb_add(&bar[XB_XGEN(b.x)], 1u);
            asm volatile("s_waitcnt vmcnt(0)" ::: "memory");
        } else {
            XB_SPIN(xb_ld(&bar[XB_XGEN(b.x)]) == gen, bar);
            __builtin_amdgcn_fence(__ATOMIC_ACQUIRE, "agent");
            asm volatile("s_waitcnt vmcnt(0)" ::: "memory");
        }
    }
    __syncthreads();
}

struct Frame {
    LAS unsigned char* lds;
    volatile LAS unsigned* MISC;
    gu32* ctl;
    int tid, lane, wave, G;
    const float *x, *c, *ctx, *cctx, *w_ada, *b_ada, *norm1_w, *w_in, *rpb, *sgu_norm_w, *sgu_w, *sgu_b, *gna, *gsgu, *w_out, *norm2_w, *w_ff1, *w_ff2, *fnw;
    float* out;
    float *modf, *part, *ssna, *sssg, *cbias, *pss, *ssgp;
    bf16 *Wt_in, *Wt_out, *Wt_ff1, *Wt_ff2, *A1, *QB, *KB, *VT, *UB, *GT, *A2, *HB, *XB;
};
constexpr int CW_DBG = 8192;
#define DBG_BEGIN(t) unsigned long long t = 0; if (DBG_SLOT >= 0) t = __builtin_amdgcn_s_memrealtime()
#define DBG_MARK(t) do { if (DBG_SLOT >= 0) t = __builtin_amdgcn_s_memrealtime(); } while (0)
#define DBG_END(F, slot, t) do { if (DBG_SLOT >= 0 && (F).tid == 0) atomicMax((unsigned*)((F).ctl + CW_DBG + 64 * (slot)), (unsigned)(__builtin_amdgcn_s_memrealtime() - (t))); } while (0)
__device__ __forceinline__ float wave_sum(float v) {
#pragma unroll
    for (int o = 1; o < 64; o <<= 1) v += __shfl_xor(v, o);
    return v;
}
constexpr int I_IN = (D / 64) * (DIN / 32), I_OUT = (D / 64) * (D / 32), I_F1 = (D / 64) * (DFF / 32), I_F2 = (DFF / 64) * (D / 32), I_TR = I_IN + I_OUT + I_F1 + I_F2;
struct TIt { const float* src; bf16* dst; const float* kg; int N, K; };
__device__ __forceinline__ void p0_titem(Frame& F, int t, TIt& r) {
    int x = t; const float* W = F.w_in; bf16* WT = F.Wt_in; int K = D, N = DIN; bool gain = false;
    if (x >= I_IN) { x -= I_IN; W = F.w_out; WT = F.Wt_out; N = D; gain = true;
        if (x >= I_OUT) { x -= I_OUT; W = F.w_ff1; WT = F.Wt_ff1; N = DFF; K = LDK; gain = false;
            if (x >= I_F1) { x -= I_F1; W = F.w_ff2; WT = F.Wt_ff2; K = LDF2; N = D; } } }
    const int nblk = N >> 5, kb = x / nblk, nb = x - kb * nblk, k0 = 64 * kb, n0 = 32 * nb;
    r.src = W + (size_t)k0 * N + n0; r.dst = WT + (size_t)n0 * K + k0; r.N = N; r.K = K;
    r.kg = gain ? (k0 < 2048 ? F.gna + k0 : F.gsgu + (k0 - 2048)) : nullptr;
}
__device__ __forceinline__ void p0_tload(const TIt& r, float (&v)[32], int lane) {
    const float* p = r.src + (size_t)(lane >> 5) * r.N + (lane & 31);
#pragma unroll
    for (int i = 0; i < 32; ++i) v[i] = p[(size_t)(2 * i) * r.N];
}
__device__ __forceinline__ void p0_tstore(const TIt& r, const float (&v)[32], LAS float* scr, int lane) {
#pragma unroll
    for (int i = 0; i < 32; ++i) { const int kk = 2 * i + (lane >> 5); float x = v[i]; if (r.kg) x *= r.kg[kk]; scr[kk * 33 + (lane & 31)] = x; }
    LDS_WAIT(); asm volatile("" ::: "memory");
    const int c = lane & 7;
#pragma unroll
    for (int j = 0; j < 4; ++j) { const int n = (lane >> 3) + 8 * j; const LAS float* s = scr + (8 * c) * 33 + n;
        v4u o; o.x = pk2(s[0 * 33], s[1 * 33]); o.y = pk2(s[2 * 33], s[3 * 33]); o.z = pk2(s[4 * 33], s[5 * 33]); o.w = pk2(s[6 * 33], s[7 * 33]);
        *(GAS v4u*)(r.dst + (size_t)n * r.K + 8 * c) = o; }
    LDS_WAIT(); asm volatile("" ::: "memory");
}
__device__ __forceinline__ float silu_f(float v) { return v / (1.0f + __expf(-v)); }
__device__ __forceinline__ void p0_ada_item(Frame& F, int item, LAS float* sil) {
    const int s = item % ADA_STRIPS, ks = item / ADA_STRIPS, k0 = ks * 256, lane = F.lane;
#pragma unroll
    for (int r = 0; r < 5; ++r) { const float* src = (r < 4) ? F.c + r * D : F.cctx; const f32x4 v = *(const f32x4*)(src + k0 + 4 * lane);
        f32x4 o; o.x = silu_f(v.x); o.y = silu_f(v.y); o.z = silu_f(v.z); o.w = silu_f(v.w); *(LAS f32x4*)(sil + r * 256 + 4 * lane) = o; }
    LDS_WAIT(); asm volatile("" ::: "memory");
    f32x4 acc[5];
#pragma unroll
    for (int r = 0; r < 5; ++r) acc[r] = (f32x4){0.f, 0.f, 0.f, 0.f};
    const float* wp = F.w_ada + (size_t)k0 * NMODC + 256 * s + 4 * lane;
#pragma unroll 16
    for (int kk = 0; kk < 256; ++kk) { const f32x4 w = *(const f32x4*)(wp + (size_t)kk * NMODC);
#pragma unroll
        for (int r = 0; r < 5; ++r) acc[r] += w * sil[r * 256 + kk]; }
#pragma unroll
    for (int r = 0; r < 5; ++r) *(f32x4*)(F.part + (size_t)(ks * 5 + r) * NMODC + 256 * s + 4 * lane) = acc[r];
    LDS_WAIT(); asm volatile("" ::: "memory");
}
__device__ __forceinline__ void p0_prologue(Frame& F) {
    LAS float* scr = (LAS float*)(F.lds + RING_OFF + F.wave * 16384);
    LAS float* sil = (LAS float*)(F.lds + RING_OFF + F.wave * 16384 + 8704);
    const int gw = (int)blockIdx.x * NWAVES + F.wave;
    constexpr int I_ADA = ADA_KS * ADA_STRIPS, NA = 41, NB = 61;
    static_assert(I_ADA == 1536 && I_ADA * NA + (2048 - I_ADA) * NB == I_TR, "P0 work split");
    int t0, ts, nt;
    if (gw < I_ADA) { p0_ada_item(F, gw, sil); t0 = gw; ts = I_ADA; nt = NA; } else { t0 = I_ADA * NA + (gw - I_ADA); ts = 2048 - I_ADA; nt = NB; }
    TIt ia, ib, ic; float va[32], vb[32], vc[32];
    p0_titem(F, t0, ia); p0_tload(ia, va, F.lane);
    p0_titem(F, t0 + ts, ib); p0_tload(ib, vb, F.lane);
    for (int k = 0; k < nt; k += 3) {
        if (k + 2 < nt) { p0_titem(F, t0 + (k + 2) * ts, ic); p0_tload(ic, vc, F.lane); }
        p0_tstore(ia, va, scr, F.lane);
        if (k + 3 < nt) { p0_titem(F, t0 + (k + 3) * ts, ia); p0_tload(ia, va, F.lane); }
        if (k + 1 < nt) p0_tstore(ib, vb, scr, F.lane);
        if (k + 4 < nt) { p0_titem(F, t0 + (k + 4) * ts, ib); p0_tload(ib, vb, F.lane); }
        if (k + 2 < nt) p0_tstore(ic, vc, scr, F.lane);
    }
}
__device__ __forceinline__ f32x4 ld4(const float* p) { return *(const f32x4*)p; }
__device__ __forceinline__ f32x4 ld4(const LAS float* p) { return *(const LAS f32x4*)p; }
template <class SP> __device__ __forceinline__ void row_norm_mod(const float* xrow, const float* nw, SP sh, SP sc, bf16* orow, int lane) {
    const f32x4* xr = (const f32x4*)xrow + lane;
    f32x4 v[16]; float ss = 0.f;
#pragma unroll
    for (int j = 0; j < 16; ++j) { v[j] = xr[64 * j]; ss += (v[j].x * v[j].x + v[j].y * v[j].y) + (v[j].z * v[j].z + v[j].w * v[j].w); }
    const float rstd = rsqrtf(wave_sum(ss) * (1.0f / D) + EPS);
#pragma unroll
    for (int j = 0; j < 16; ++j) { const int col = 4 * lane + 256 * j;
        const f32x4 w4 = ld4(nw + col), s4 = ld4(sc + col), h4 = ld4(sh + col);
        const f32x4 o = v[j] * rstd * w4 * (s4 + 1.0f) + h4;
        v2u pk; pk.x = pk2(o.x, o.y); pk.y = pk2(o.z, o.w);
        *(v2u*)(orow + col) = pk; }
}
__device__ __forceinline__ void p1_rows(Frame& F) {
    LAS float* modL = (LAS float*)(F.lds + RING_OFF);
    const int bx = (int)blockIdx.x, b = bx >> 6;
    for (int i4 = F.tid; i4 < 2 * D / 4; i4 += NWAVES * 64) { const int i = 4 * i4;
        f32x4 p0[ADA_KS], p1[ADA_KS];
#pragma unroll
        for (int sp = 0; sp < ADA_KS; ++sp) { p0[sp] = *(const f32x4*)(F.part + (size_t)(sp * 5 + b) * NMODC + i); p1[sp] = *(const f32x4*)(F.part + (size_t)(sp * 5 + 4) * NMODC + i); }
        f32x4 s0 = *(const f32x4*)(F.b_ada + i), s1 = s0;
#pragma unroll
        for (int sp = 0; sp < ADA_KS; ++sp) { s0 += p0[sp]; s1 += p1[sp]; }
        *(LAS f32x4*)(modL + i) = s0; *(LAS f32x4*)(modL + 2 * D + i) = s1; }
    if (F.tid < 120) { const int idx = bx * 480 + 4 * F.tid, r = idx / NMODC, j = idx % NMODC;
        f32x4 p0[ADA_KS];
#pragma unroll
        for (int sp = 0; sp < ADA_KS; ++sp) p0[sp] = *(const f32x4*)(F.part + (size_t)(sp * 5 + r) * NMODC + j);
        f32x4 s = *(const f32x4*)(F.b_ada + j);
#pragma unroll
        for (int sp = 0; sp < ADA_KS; ++sp) s += p0[sp];
        *(f32x4*)(F.modf + idx) = s; }
    __syncthreads();
    for (int rr = F.wave; rr < 64; rr += NWAVES) { const int row = 64 * bx + rr;
        row_norm_mod<const LAS float*>(F.x + (size_t)row * D, F.norm1_w, modL, modL + D, F.A1 + (size_t)row * D, F.lane); }
    if (F.wave < 4) { const int row = 4 * bx + F.wave;
        row_norm_mod<const LAS float*>(F.ctx + (size_t)row * D, F.norm1_w, modL + 2 * D, modL + 3 * D, F.A1 + (size_t)(M + row) * D, F.lane); }
}
__device__ __forceinline__ void p2_cbias(Frame& F) {
    const int b = F.wave & 3, n0 = 2 * ((int)blockIdx.x - 64) + (F.wave >> 2);
    constexpr int NS = 384, NR = (DFF + NS - 1) / NS;
    float sh[64];
    const float* sp = F.modf + (size_t)b * NMODC + 3 * D + 8 * F.lane;
#pragma unroll
    for (int i = 0; i < 8; ++i) { const f32x4 a0 = *(const f32x4*)(sp + 512 * i), a1 = *(const f32x4*)(sp + 512 * i + 4);
        sh[8 * i] = a0.x; sh[8 * i + 1] = a0.y; sh[8 * i + 2] = a0.z; sh[8 * i + 3] = a0.w; sh[8 * i + 4] = a1.x; sh[8 * i + 5] = a1.y; sh[8 * i + 6] = a1.z; sh[8 * i + 7] = a1.w; }
    const v4u* wp = (const v4u*)(F.Wt_ff1 + (size_t)n0 * LDK) + F.lane;
    v4u wa[8], wb[8];
#pragma unroll
    for (int i = 0; i < 8; ++i) wa[i] = wp[64 * i];
#define CB_ROW(WV, n) { float s = 0.f; _Pragma("unroll") for (int i = 0; i < 8; ++i) { const v4u q_ = WV[i]; \
        s += (bf_lo(q_.x) * sh[8 * i] + bf_hi(q_.x) * sh[8 * i + 1]) + (bf_lo(q_.y) * sh[8 * i + 2] + bf_hi(q_.y) * sh[8 * i + 3]) \
           + (bf_lo(q_.z) * sh[8 * i + 4] + bf_hi(q_.z) * sh[8 * i + 5]) + (bf_lo(q_.w) * sh[8 * i + 6] + bf_hi(q_.w) * sh[8 * i + 7]); } \
        s = wave_sum(s); if (F.lane == 0) F.cbias[(size_t)b * DFF + (n)] = s; }
    for (int r = 0; r < NR; r += 2) {
        const bool h1 = n0 + NS * (r + 1) < DFF, h2 = n0 + NS * (r + 2) < DFF;
        if (h1) { const v4u* wq = wp + (size_t)(r + 1) * NS * (LDK / 8);
#pragma unroll
            for (int i = 0; i < 8; ++i) wb[i] = wq[64 * i]; }
        if (n0 + NS * r < DFF) CB_ROW(wa, n0 + NS * r)
        if (h2) { const v4u* wr2 = wp + (size_t)(r + 2) * NS * (LDK / 8);
#pragma unroll
            for (int i = 0; i < 8; ++i) wa[i] = wr2[64 * i]; }
        if (h1) CB_ROW(wb, n0 + NS * (r + 1))
    }
#undef CB_ROW
}
__device__ __forceinline__ void fill_tab_outproj(Frame& F, int pm, int cc) {
    LAS float* tab = (LAS float*)(F.lds + ROWTAB_OFF); LAS float* ct = (LAS float*)(F.lds + COLTAB_OFF);
    if (F.tid < 256) { const int m = pm * 256 + F.tid; float sa = 0.f, sg = 0.f;
#pragma unroll
        for (int i = 0; i < 4; ++i) { const f32x4 t = *(const f32x4*)(F.ssna + (size_t)m * 16 + 4 * i); sa += (t.x + t.y) + (t.z + t.w); }
        { const f32x4 t = *(const f32x4*)(F.sssg + (size_t)m * 4); sg = (t.x + t.y) + (t.z + t.w); }
        const float rna = rsqrtf(sa * (1.0f / DNA) + EPS), rsg = rsqrtf(sg * (1.0f / DSGU) + EPS);
        tab[F.tid] = rna / rsg; tab[256 + F.tid] = rsg; }
    const float* mf = F.modf + (size_t)(pm >> 4) * NMODC;
    for (int i = F.tid; i < 1024; i += NWAVES * 64) { const int col = (4 * (i >> 8) + cc) * 256 + (i & 255);
        ct[i] = mf[2 * D + col]; ct[1024 + i] = F.norm2_w[col] * (1.0f + mf[4 * D + col]); }
    __syncthreads();
}
__device__ __forceinline__ void fill_tab_ff1(Frame& F, int pm, int cc) {
    LAS float* tab = (LAS float*)(F.lds + ROWTAB_OFF); LAS float* ct = (LAS float*)(F.lds + COLTAB_OFF);
    if (F.tid < 256) { const int m = pm * 256 + F.tid; float s = 0.f;
#pragma unroll
        for (int i = 0; i < 16; ++i) { const f32x4 t = *(const f32x4*)(F.pss + (size_t)m * 64 + 4 * i); s += (t.x + t.y) + (t.z + t.w); }
        tab[F.tid] = rsqrtf(s * (1.0f / D) + EPS); }
    const float* cbp = F.cbias + (size_t)(pm >> 4) * DFF;
    for (int i = F.tid; i < 4096; i += NWAVES * 64) ct[i] = cbp[(4 * (i >> 8) + cc) * 256 + (i & 255)];
    __syncthreads();
}
template <class Sched> __device__ __forceinline__ void fill_tab_ff2(Frame& F, const Sched& S) {
    LAS float* ct = (LAS float*)(F.lds + COLTAB_OFF);
    for (int i = 0; i < 4; ++i) { pg8::Unit u; if (!S.next(i, u)) break;
        const float* mf = F.modf + (size_t)(u.pm >> 4) * NMODC + 5 * D + u.pn * 256;
        for (int j = F.tid; j < 256; j += NWAVES * 64) ct[i * 256 + j] = mf[j]; }
    __syncthreads();
}
__device__ __forceinline__ void p9_final(Frame& F) {
    const int gw = (int)blockIdx.x * NWAVES + F.wave, NGW = F.G * NWAVES;
    for (int m = gw; m < M; m += NGW) {
        const v4u* xr = (const v4u*)(F.XB + (size_t)m * D) + F.lane;
        v4u v[8]; float ss = 0.f;
#pragma unroll
        for (int j = 0; j < 8; ++j) { v[j] = xr[64 * j];
            const float a0 = bf_lo(v[j].x), a1 = bf_hi(v[j].x), a2 = bf_lo(v[j].y), a3 = bf_hi(v[j].y), a4 = bf_lo(v[j].z), a5 = bf_hi(v[j].z), a6 = bf_lo(v[j].w), a7 = bf_hi(v[j].w);
            ss += ((a0 * a0 + a1 * a1) + (a2 * a2 + a3 * a3)) + ((a4 * a4 + a5 * a5) + (a6 * a6 + a7 * a7)); }
        const float rstd = rsqrtf(wave_sum(ss) * (1.0f / D) + EPS);
        float* orow = F.out + (size_t)m * D;
#pragma unroll
        for (int j = 0; j < 8; ++j) { const int col = 8 * (F.lane + 64 * j);
            const f32x4 w0 = ld4(F.fnw + col), w1 = ld4(F.fnw + col + 4);
            *(f32x4*)(orow + col) = (f32x4){bf_lo(v[j].x), bf_hi(v[j].x), bf_lo(v[j].y), bf_hi(v[j].y)} * rstd * w0;
            *(f32x4*)(orow + col + 4) = (f32x4){bf_lo(v[j].z), bf_hi(v[j].z), bf_lo(v[j].w), bf_hi(v[j].w)} * rstd * w1; }
    }
}
__device__ __forceinline__ float xrow16_max(float x) {
    auto s = __builtin_amdgcn_permlane16_swap(__float_as_uint(x), __float_as_uint(x), false, false);
    x = fmaxf(__uint_as_float(s[0]), __uint_as_float(s[1]));
    auto t = __builtin_amdgcn_permlane32_swap(__float_as_uint(x), __float_as_uint(x), false, false);
    return fmaxf(__uint_as_float(t[0]), __uint_as_float(t[1]));
}
__device__ __forceinline__ float xrow16_sum(float x) {
    auto s = __builtin_amdgcn_permlane16_swap(__float_as_uint(x), __float_as_uint(x), false, false);
    x = __uint_as_float(s[0]) + __uint_as_float(s[1]);
    auto t = __builtin_amdgcn_permlane32_swap(__float_as_uint(x), __float_as_uint(x), false, false);
    return __uint_as_float(t[0]) + __uint_as_float(t[1]);
}
__device__ __forceinline__ void glds16(const void* gsrc, unsigned lds_dst) { unsigned keep;
    asm volatile("s_mov_b32 %0, m0\n\ts_mov_b32 m0, %2\n\ts_nop 0\n\tglobal_load_lds_dwordx4 %1, off\n\ts_mov_b32 m0, %0" : "=&s"(keep) : "v"(gsrc), "s"(lds_dst) : "memory"); }
constexpr int SG_BUF = 65536, SG_NW_OFF = 2 * SG_BUF, SG_RG_OFF = SG_NW_OFF + 8192;
static_assert(SG_RG_OFF + 512 <= LDSCTL_OFF, "SGU LDS image below the control words");
__device__ __forceinline__ void sgu_stage(Frame& F, int tok0, int cq, int buf) {
    const int w = F.wave, L = F.lane;
    const unsigned base = (unsigned)(size_t)(F.lds + buf * SG_BUF);
#pragma unroll
    for (int i = 0; i < 4; ++i) { const int p = w + 8 * i, row = 4 * p + (L >> 4), c = (L & 15) ^ (row & 15);
        glds16(F.GT + (size_t)(cq + row) * M + tok0 + c * 8, (unsigned)__builtin_amdgcn_readfirstlane((int)(base + p * 1024))); }
#pragma unroll
    for (int i = 0; i < 4; ++i) { const int p = w + 8 * i, row = 4 * p + (L >> 4), c = (L & 15) ^ (row & 15);
        glds16(F.UB + (size_t)(tok0 + row) * DSGU + cq + c * 8, (unsigned)__builtin_amdgcn_readfirstlane((int)(base + 32768 + p * 1024))); }
}
__device__ __forceinline__ void sgu_wg(Frame& F) {
    const int lane = F.lane, w = F.wave, l15 = lane & 15, g = lane >> 4;
    LAS float* nwl = (LAS float*)(F.lds + SG_NW_OFF); LAS float* rgs = (LAS float*)(F.lds + SG_RG_OFF);
    for (int i = F.tid; i < DSGU / 4; i += NWAVES * 64) *(LAS f32x4*)(nwl + 4 * i) = *(const f32x4*)(F.sgu_norm_w + 4 * i);
    const int uid0 = (int)blockIdx.x, uid1 = uid0 + F.G;
    bf16x8 wf[4]; float bias = 0.f, ssq = 0.f; int tok0 = 0, grp = 0;
    sgu_stage(F, (uid0 >> 7) * SEQ + ((uid0 >> 2) & 31) * 128, (uid0 & 3) * 512, 0);
    for (int k = 0; k < 8; ++k) {
        const int uid = (k < 4) ? uid0 : uid1, qq = k & 3;
        if (qq == 0) {
            tok0 = (uid >> 7) * SEQ + ((uid >> 2) & 31) * 128; grp = uid & 3; ssq = 0.f;
            __syncthreads();
            if (F.tid < 128) { const float* sp = F.ssgp + (size_t)(tok0 + F.tid) * 16; float s = 0.f;
#pragma unroll
                for (int i = 0; i < 4; ++i) { const f32x4 t = *(const f32x4*)(sp + 4 * i); s += (t.x + t.y) + (t.z + t.w); }
                rgs[F.tid] = rsqrtf(s * (1.0f / DSGU) + EPS); }
            __syncthreads();
            const int p = 16 * w + l15;
#pragma unroll
            for (int ks = 0; ks < 4; ++ks) { const int q0 = ks * 32 + 8 * g; const float* wp = F.sgu_w + (size_t)(grp * 128 + p) * 128 + q0;
                const f32x4 w0 = *(const f32x4*)wp, w1 = *(const f32x4*)(wp + 4); const f32x4 r0 = *(const LAS f32x4*)(rgs + q0), r1 = *(const LAS f32x4*)(rgs + q0 + 4);
                v4u pk; pk.x = pk2(w0.x * r0.x, w0.y * r0.y); pk.y = pk2(w0.z * r0.z, w0.w * r0.w); pk.z = pk2(w1.x * r1.x, w1.y * r1.y); pk.w = pk2(w1.z * r1.z, w1.w * r1.w);
                wf[ks] = __builtin_bit_cast(bf16x8, pk); }
            bias = F.sgu_b[grp * 128 + p];
            asm volatile("" :: "v"(wf[0]), "v"(wf[1]), "v"(wf[2]), "v"(wf[3]), "v"(bias));
        }
        asm volatile("s_waitcnt vmcnt(0)" ::: "memory"); __builtin_amdgcn_s_barrier(); asm volatile("" ::: "memory");
        if (k + 1 < 8) { const int un = (k + 1 < 4) ? uid0 : uid1; sgu_stage(F, (un >> 7) * SEQ + ((un >> 2) & 31) * 128, (un & 3) * 512 + ((k + 1) & 3) * 128, (k + 1) & 1); }
        const LAS unsigned char* gb = F.lds + (k & 1) * SG_BUF; LAS unsigned char* ub = F.lds + (k & 1) * SG_BUF + 32768;
        const int p = 16 * w + l15;
#pragma unroll 2
        for (int ct = 0; ct < 8; ++ct) {
            f32x4 d = (f32x4){0.f, 0.f, 0.f, 0.f};
            const LAS unsigned char* gr = gb + (16 * ct + l15) * 256;
#pragma unroll
            for (int ks = 0; ks < 4; ++ks) { const bf16x8 gf = *(const LAS bf16x8*)(gr + (((4 * ks + g) ^ l15) << 4)); d = __builtin_amdgcn_mfma_f32_16x16x32_bf16(gf, wf[ks], d, 0, 0, 0); }
            LAS unsigned char* ua = ub + p * 256 + (((2 * ct + (g >> 1)) ^ l15) << 4) + ((g & 1) << 3);
            const v2u uu = *(const LAS v2u*)ua;
            const f32x4 nw = *(const LAS f32x4*)(nwl + grp * 512 + qq * 128 + 16 * ct + 4 * g);
            const float o0 = bf_lo(uu.x) * (nw.x * d[0] + bias), o1 = bf_hi(uu.x) * (nw.y * d[1] + bias), o2 = bf_lo(uu.y) * (nw.z * d[2] + bias), o3 = bf_hi(uu.y) * (nw.w * d[3] + bias);
            ssq += (o0 * o0 + o1 * o1) + (o2 * o2 + o3 * o3);
            v2u pk; pk.x = pk2(o0, o1); pk.y = pk2(o2, o3);
            *(LAS v2u*)ua = pk;
        }
        asm volatile("s_waitcnt lgkmcnt(0)" ::: "memory"); __builtin_amdgcn_s_barrier(); asm volatile("" ::: "memory");
        {
            bf16* ob = F.A2 + (size_t)tok0 * D + DNA + grp * 512 + qq * 128;
#pragma unroll
            for (int i = 0; i < 4; ++i) { const int id = F.tid + 512 * i, row = id >> 4, slot = id & 15, c = slot ^ (row & 15);
                const v4u v = *(const LAS v4u*)(ub + row * 256 + (slot << 4));
                *(v4u*)(ob + (size_t)row * D + c * 8) = v; }
        }
        if (qq == 3) { const float s = xrow16_sum(ssq); if (g == 0) F.sssg[(size_t)(tok0 + 16 * w + l15) * 4 + grp] = s; }
    }
    __syncthreads();
}
constexpr int AT_TILE = 32768;
constexpr int AT_NBUF = 4;
constexpr int RPB_OFF = AT_NBUF * AT_TILE + 64, ATT_LDS_END = RPB_OFF + 15 * 31 * 4 + 256;
static_assert(ATT_LDS_END <= LDSCTL_OFF, "attention LDS image below the control words");
__device__ __forceinline__ void attn_scores(const bf16x8 (&k)[2][4], const bf16x8 (&qf)[4], f32x4 (&s)[2]) {
#pragma unroll
    for (int tt = 0; tt < 2; ++tt) { s[tt] = (f32x4){0.f, 0.f, 0.f, 0.f};
#pragma unroll
        for (int ds = 0; ds < 4; ++ds) s[tt] = __builtin_amdgcn_mfma_f32_16x16x32_bf16(k[tt][ds], qf[ds], s[tt], 0, 0, 0); }
}
template <bool WIN> __device__ __forceinline__ bf16x8 attn_softmax(f32x4 (&s)[2], const LAS float* bp, int lo, f32x4 (&o)[8], float& mrun, float& lrun) {
    if (WIN) {
        float bv[8];
#pragma unroll
        for (int i = 0; i < 8; ++i) bv[i] = bp[i];
        asm volatile("" : "+v"(bv[0]), "+v"(bv[1]), "+v"(bv[2]), "+v"(bv[3]), "+v"(bv[4]), "+v"(bv[5]), "+v"(bv[6]), "+v"(bv[7]));
#pragma unroll
        for (int i = 0; i < 8; ++i) { const bool valid = (unsigned)(i - lo) < 16u; s[i >> 2][i & 3] = valid ? s[i >> 2][i & 3] + bv[i] : -1e30f; }
    }
    float mx = fmaxf(fmaxf(fmaxf(s[0][0], s[0][1]), fmaxf(s[0][2], s[0][3])), fmaxf(fmaxf(s[1][0], s[1][1]), fmaxf(s[1][2], s[1][3])));
    mx = xrow16_max(mx);
    if (__builtin_amdgcn_ballot_w64(mx > mrun + 8.0f)) {
        const float mn = fmaxf(mrun, mx), alpha = __builtin_amdgcn_exp2f(mrun - mn); mrun = mn; lrun *= alpha;
#pragma unroll
        for (int dt = 0; dt < 8; ++dt) o[dt] *= alpha;
    }
    float ps = 0.f;
#pragma unroll
    for (int tt = 0; tt < 2; ++tt)
#pragma unroll
        for (int rg = 0; rg < 4; ++rg) { s[tt][rg] = __builtin_amdgcn_exp2f(s[tt][rg] - mrun); ps += s[tt][rg]; }
    lrun += ps;
    v4u pk; pk.x = pk2(s[0][0], s[0][1]); pk.y = pk2(s[0][2], s[0][3]); pk.z = pk2(s[1][0], s[1][1]); pk.w = pk2(s[1][2], s[1][3]);
    return __builtin_bit_cast(bf16x8, pk);
}
__device__ __forceinline__ void attn_pv(const bf16x8 (&v)[8], bf16x8 pf, f32x4 (&o)[8]) {
#pragma unroll
    for (int dt = 0; dt < 8; ++dt) o[dt] = __builtin_amdgcn_mfma_f32_16x16x32_bf16(v[dt], pf, o[dt], 0, 0, 0);
}
__device__ __forceinline__ void attn_stage(Frame& F, int h, int T, int buf) {
    const int w = F.wave, L = F.lane;
    const unsigned base = (unsigned)(size_t)(F.lds + buf * AT_TILE);
#pragma unroll
    for (int i = 0; i < 2; ++i) { const int p = w + 8 * i, row = 4 * p + (L >> 4), f = (row & 3) | (((row >> 3) & 3) << 2), c = (L & 15) ^ f;
        glds16(F.KB + (size_t)(T + row) * DNA + h * HD + c * 8, (unsigned)__builtin_amdgcn_readfirstlane((int)(base + p * 1024))); }
#pragma unroll
    for (int i = 0; i < 2; ++i) { const int p = w + 8 * i, row = 8 * p + (L >> 3), c = (L & 7) ^ ((row >> 1) & 7);
        glds16(F.VT + (size_t)(h * HD + row) * MA + T + c * 8, (unsigned)__builtin_amdgcn_readfirstlane((int)(base + 16384 + p * 1024))); }
}
__device__ __forceinline__ void attn_kfrags(const LAS unsigned char* tile, int kb0, int q, int g, bf16x8 (&k)[2][4]) {
    const int a = q >> 2, cc = q & 3, fh = ((kb0 >> 3) + a) & 3;
    const LAS unsigned char* kr = tile + (kb0 + 8 * a + cc) * 256 + ((g ^ cc) << 4);
#pragma unroll
    for (int ds = 0; ds < 4; ++ds) { const int off = (ds ^ fh) << 6;
#pragma unroll
        for (int tt = 0; tt < 2; ++tt) k[tt][ds] = *(const LAS bf16x8*)(kr + tt * 1024 + off); }
}
__device__ __forceinline__ void attn_vfrags(const LAS unsigned char* tile, int kb0, int q, int g, bf16x8 (&v)[8]) {
    const int pc = ((kb0 >> 3) + g) ^ ((q >> 1) & 7);
    const LAS unsigned char* vr = tile + 16384 + q * 128 + (pc << 4);
#pragma unroll
    for (int dt = 0; dt < 8; ++dt) v[dt] = *(const LAS bf16x8*)(vr + dt * 2048);
}
template <bool A, bool B> __device__ __forceinline__ void attn_pv2(const LAS unsigned char* tile, int kb0, int q, int g, bf16x8 pfA, bf16x8 pfB, f32x4 (&oA)[8], f32x4 (&oB)[8]) {
    const int pc = ((kb0 >> 3) + g) ^ ((q >> 1) & 7);
    const LAS unsigned char* vr = tile + 16384 + q * 128 + (pc << 4);
#pragma unroll
    for (int hf = 0; hf < 2; ++hf) {
        bf16x8 v[4];
#pragma unroll
        for (int i = 0; i < 4; ++i) v[i] = *(const LAS bf16x8*)(vr + (4 * hf + i) * 2048);
#pragma unroll
        for (int i = 0; i < 4; ++i) { if (A) oA[4 * hf + i] = __builtin_amdgcn_mfma_f32_16x16x32_bf16(v[i], pfA, oA[4 * hf + i], 0, 0, 0);
                                      if (B) oB[4 * hf + i] = __builtin_amdgcn_mfma_f32_16x16x32_bf16(v[i], pfB, oB[4 * hf + i], 0, 0, 0); }
        __builtin_amdgcn_sched_barrier(0);
    }
}
#define ATT_KEEP2(pa, pb) asm volatile("s_nop 7" :: "v"(pa), "v"(pb))
#define ATT_KEEP1(pa) asm volatile("s_nop 7" :: "v"(pa))
__device__ __forceinline__ void attn_finish(Frame& F, f32x4 (&o)[8], float lrun, int qtok, int h, int g) {
    const float inv = 1.0f / xrow16_sum(lrun); float ssq = 0.f;
    bf16* op = F.A2 + (size_t)qtok * D + h * HD + 4 * g;
#pragma unroll
    for (int dt = 0; dt < 8; ++dt) { const f32x4 v = o[dt] * inv; ssq += (v.x * v.x + v.y * v.y) + (v.z * v.z + v.w * v.w);
        v2u pk; pk.x = pk2(v.x, v.y); pk.y = pk2(v.z, v.w); *(v2u*)(op + dt * 16) = pk; }
    ssq = xrow16_sum(ssq);
    if (g == 0) F.ssna[(size_t)qtok * 16 + h] = ssq;
}
__device__ __forceinline__ void attn_subpass(Frame& F, int b, int h, int R) {
    const int lane = F.lane, q = lane & 15, g = lane >> 4, w = F.wave, j = w & 3;
    const int r = R + (w >> 2);
    const int qcol = 16 * j + q, qtok = b * SEQ + r * GW + qcol;
    int r0 = r - 4; r0 = r0 < 0 ? 0 : (r0 > 56 ? 56 : r0);
    int krlo = R - 4; krlo = krlo < 0 ? 0 : (krlo > 56 ? 56 : krlo);
    int krhi = R - 3; krhi = (krhi < 0 ? 0 : (krhi > 56 ? 56 : krhi)) + 7;
    const int nwin = krhi - krlo + 1, nst = nwin + 4;
    int cs = qcol - 8; cs = cs < 0 ? 0 : (cs > 48 ? 48 : cs);
    const int band0 = (j == 0) ? 0 : (j == 1 ? 8 : (j == 2 ? 24 : 32));
    const int lo = cs - (band0 + 8 * g);
    const LAS float* rpb = (const LAS float*)(F.lds + RPB_OFF) + (band0 + 8 * g - qcol + 15);
    bf16x8 qf[4];
#pragma unroll
    for (int ds = 0; ds < 4; ++ds) qf[ds] = *(const bf16x8*)(F.QB + (size_t)qtok * DNA + h * HD + ds * 32 + 8 * g);
    f32x4 o[8];
#pragma unroll
    for (int dt = 0; dt < 8; ++dt) o[dt] = (f32x4){0.f, 0.f, 0.f, 0.f};
    float mrun = -1e30f, lrun = 0.f;
    const int Tw0 = b * SEQ + krlo * GW, Tc0 = M + b * CTX;
#define ATT_TILE_T(t) (((t) < nwin) ? Tw0 + (t) * GW : Tc0 + 64 * ((t) - nwin))
    asm volatile("" :: "v"(qf[0]), "v"(qf[1]), "v"(qf[2]), "v"(qf[3]));
    attn_stage(F, h, ATT_TILE_T(0), 0); attn_stage(F, h, ATT_TILE_T(1), 1); attn_stage(F, h, ATT_TILE_T(2), 2);
    for (int s = 0; s < nst; ++s) {
        if (s + 2 < nst) asm volatile("s_waitcnt vmcnt(8)" ::: "memory"); else if (s + 1 < nst) asm volatile("s_waitcnt vmcnt(4)" ::: "memory"); else asm volatile("s_waitcnt vmcnt(0)" ::: "memory");
        __builtin_amdgcn_s_barrier(); asm volatile("" ::: "memory");
        if (s + 3 < nst) attn_stage(F, h, ATT_TILE_T(s + 3), (s + 3) & (AT_NBUF - 1));
        const LAS unsigned char* tile = F.lds + (s & (AT_NBUF - 1)) * AT_TILE;
        if (s < nwin) {
            const int kr = krlo + s;
            if ((kr >= r0) && (kr < r0 + 8)) {
                bf16x8 kf[2][4], vf[8]; f32x4 sc[2];
                attn_kfrags(tile, band0, q, g, kf); attn_vfrags(tile, band0, q, g, vf);
                attn_scores(kf, qf, sc);
                bf16x8 pf = attn_softmax<true>(sc, rpb + (kr - r + 7) * 31, lo, o, mrun, lrun);
                attn_pv(vf, pf, o); ATT_KEEP1(pf);
            }
        } else {
#pragma unroll
            for (int hh = 0; hh < 2; ++hh) {
                bf16x8 kf[2][4], vf[8]; f32x4 sc[2];
                attn_kfrags(tile, 32 * hh, q, g, kf); attn_vfrags(tile, 32 * hh, q, g, vf);
                attn_scores(kf, qf, sc);
                bf16x8 pf = attn_softmax<false>(sc, nullptr, 0, o, mrun, lrun);
                attn_pv(vf, pf, o); ATT_KEEP1(pf);
            }
        }
    }
#undef ATT_TILE_T
    __builtin_amdgcn_s_barrier(); asm volatile("" ::: "memory");
    attn_finish(F, o, lrun, qtok, h, g);
}
__device__ __forceinline__ void p3_mixers(Frame& F) {
    __syncthreads();
    DBG_BEGIN(ts_);
    for (int rep = 0; rep < REPS(31); ++rep) sgu_wg(F);
    DBG_END(F, 10, ts_); DBG_BEGIN(ta_);
    const int xcd = (int)blockIdx.x & 7, li = (int)blockIdx.x >> 3;
    for (int rep = 0; rep < REPS(32); ++rep)
    for (int bhi = 0; bhi < 8; ++bhi) {
        const int bh = xcd * 8 + bhi, b = bh >> 4, h = bh & 15;
        for (int i = F.tid; i < 15 * 31; i += NWAVES * 64) ((LAS float*)(F.lds + RPB_OFF))[i] = F.rpb[h * 15 * 31 + i] * LOG2E;
        asm volatile("s_waitcnt lgkmcnt(0)" ::: "memory");
        attn_subpass(F, b, h, 2 * li);
    }
    DBG_END(F, 11, ta_);
}
struct Args { const float* in[19]; float* out; unsigned char* ws; int ph_lo, ph_hi; };
__global__ void __launch_bounds__(NWAVES * 64, 2) mk_fwd(Args args) {
    extern __shared__ __attribute__((aligned(16))) unsigned char lds[];
    Frame F;
    F.lds = (LAS unsigned char*)lds;
    F.MISC = (volatile LAS unsigned*)(F.lds + MISC_OFF);
    F.tid = threadIdx.x; F.lane = F.tid & 63; F.wave = __builtin_amdgcn_readfirstlane(F.tid >> 6);
    F.G = gridDim.x;
    unsigned char* ws = args.ws;
    F.ctl = (gu32*)(ws + WS_CTL);
    F.x = args.in[0]; F.c = args.in[1]; F.ctx = args.in[2]; F.cctx = args.in[3]; F.w_ada = args.in[4]; F.b_ada = args.in[5]; F.norm1_w = args.in[6]; F.w_in = args.in[7]; F.rpb = args.in[8];
    F.sgu_norm_w = args.in[9]; F.sgu_w = args.in[10]; F.sgu_b = args.in[11]; F.gna = args.in[12]; F.gsgu = args.in[13]; F.w_out = args.in[14]; F.norm2_w = args.in[15];
    F.w_ff1 = args.in[16]; F.w_ff2 = args.in[17]; F.fnw = args.in[18]; F.out = args.out;
    F.modf = (float*)(ws + WS_MODF); F.part = (float*)(ws + WS_PART); F.ssna = (float*)(ws + WS_SSNA); F.sssg = (float*)(ws + WS_SSSG); F.cbias = (float*)(ws + WS_CBIAS); F.pss = (float*)(ws + WS_PSS); F.ssgp = (float*)(ws + WS_SSGP);
    F.Wt_in = (bf16*)(ws + WS_WIN); F.Wt_out = (bf16*)(ws + WS_WOUT); F.Wt_ff1 = (bf16*)(ws + WS_WFF1); F.Wt_ff2 = (bf16*)(ws + WS_WFF2);
    F.A1 = (bf16*)(ws + WS_A1); F.QB = (bf16*)(ws + WS_Q); F.KB = (bf16*)(ws + WS_K); F.VT = (bf16*)(ws + WS_VT); F.UB = (bf16*)(ws + WS_U); F.GT = (bf16*)(ws + WS_GT);
    F.A2 = (bf16*)(ws + WS_A2); F.HB = (bf16*)(ws + WS_H); F.XB = (bf16*)(ws + WS_XB);
    for (int u = F.tid; u < (LDS_BYTES - LDSCTL_OFF) / 4; u += NWAVES * 64) ((LAS unsigned*)(F.lds + LDSCTL_OFF))[u] = 0u;
    __syncthreads();
    XcdBarrier bar; bar.bar = (unsigned*)(F.ctl + CW_BAR); bar.x = 0; bar.st = nullptr;
    if (MK_N_LAUNCHES == 1) bar = xcd_barrier_post((unsigned*)(F.ctl + CW_BAR), F.MISC + 8);
    const int lo = args.ph_lo, hi = args.ph_hi;
#define IN(k) (lo <= (k) && (k) < hi)
#define SEAM(k) do { if (IN(k) && IN((k) + 1)) { DBG_BEGIN(tb_); xcd_barrier(bar); DBG_END(F, 16 + (k), tb_); } } while (0)

    DBG_BEGIN(tp_);
    if (IN(0)) { for (int rep = 0; rep < REPS(0); ++rep) p0_prologue(F); } DBG_END(F, 0, tp_); SEAM(0);
    DBG_MARK(tp_); if (IN(1)) { p1_rows(F); } DBG_END(F, 1, tp_); SEAM(1);
    DBG_MARK(tp_);
    if (IN(2)) {
        pg8::Gemm g{F.A1, F.Wt_in, MA, DIN, D, D}; pg8::InProjOrder S; S.G = F.G; S.c = (int)blockIdx.x;
        pg8::EpiInProj E{F.QB, WS_SLOT / 2, 0.08838834764831845f * LOG2E, F.ssgp};
        pg8::gemm_phase<pg8::EpiInProj, pg8::InProjOrder, true, true>(F.lds + RING_OFF, g, S, E);
        if (blockIdx.x >= 64) p2_cbias(F);
    } DBG_END(F, 2, tp_); SEAM(2);
    DBG_MARK(tp_);
    if (IN(3)) { for (int rep = 0; rep < REPS(3); ++rep) p3_mixers(F); } DBG_END(F, 3, tp_); SEAM(3);
    DBG_MARK(tp_);
    if (IN(4)) {
        pg8::Gemm g{F.A2, F.Wt_out, M, D, D, D}; pg8::StdOrder S; S.init(M, D, F.G, (int)blockIdx.x);
        pg8::Unit u0; S.next(0, u0); fill_tab_outproj(F, u0.pm, u0.pn & 3);
        pg8::EpiOutProj E{F.x, F.XB, F.A1, LDK, F.pss, (const LAS float*)(F.lds + COLTAB_OFF), (const LAS float*)(F.lds + COLTAB_OFF) + 1024, (const LAS float*)(F.lds + ROWTAB_OFF)};
        pg8::gemm_phase<pg8::EpiOutProj, pg8::StdOrder, true, true>(F.lds + RING_OFF, g, S, E);
    } DBG_END(F, 4, tp_); SEAM(4);
    DBG_MARK(tp_);
    if (IN(5)) for (int rep = 0; rep < REPS(5); ++rep) {
        pg8::Gemm g{F.A1, F.Wt_ff1, M, DFF, D, LDK}; pg8::StdOrder S; S.init(M, DFF, F.G, (int)blockIdx.x);
        pg8::Unit u0; S.next(0, u0); fill_tab_ff1(F, u0.pm, u0.pn & 3);
        pg8::EpiRelu2 E{F.HB, LDF2, (const LAS float*)(F.lds + COLTAB_OFF), (const LAS float*)(F.lds + ROWTAB_OFF)};
        pg8::gemm_phase<pg8::EpiRelu2, pg8::StdOrder, true, true>(F.lds + RING_OFF, g, S, E);
    } DBG_END(F, 5, tp_); SEAM(5);
    DBG_MARK(tp_);
    if (IN(6)) {
        pg8::Gemm g{F.HB, F.Wt_ff2, M, D, DFF, LDF2}; pg8::StdOrder S; S.init(M, D, F.G, (int)blockIdx.x, FF2_WGM);
        fill_tab_ff2(F, S);
        pg8::EpiGatedRes E{F.XB, (const LAS float*)(F.lds + COLTAB_OFF)};
        pg8::gemm_phase<pg8::EpiGatedRes, pg8::StdOrder, true, true>(F.lds + RING_OFF, g, S, E);
    } DBG_END(F, 6, tp_); SEAM(6);
    DBG_MARK(tp_);
    if (IN(7)) { p9_final(F); } DBG_END(F, 7, tp_);
    if (DBG_SLOT >= 0) {
        __syncthreads();
        if (blockIdx.x == 0 && F.tid == 0) { const unsigned long long v = (unsigned long long)__hip_atomic_load((unsigned*)(F.ctl + CW_DBG + 64 * (DBG_SLOT >= 0 ? DBG_SLOT : 0)), RLX_AGENT) * DBG_MULT;
            const unsigned long long t0 = __builtin_amdgcn_s_memrealtime(); while (__builtin_amdgcn_s_memrealtime() - t0 < v) __builtin_amdgcn_s_sleep(8); }
    }
#undef IN
#undef SEAM
}

extern "C" void kernel_launch(void* const* d_in, const int* in_sizes, int n_in, void* d_out, int out_size, void* d_ws, size_t ws_size, hipStream_t stream) {
    static int grid = 0;
    if (grid == 0) {
        if (n_in != 19 || in_sizes[0] != M * D || out_size != M * D || ws_size < WS_END) { fprintf(stderr, "kernel_launch: unexpected shapes / workspace (%zu)\n", ws_size); grid = -1; return; }
        int dev = 0, cus = 0, per_cu = 0;
        if (hipGetDevice(&dev) != hipSuccess || hipDeviceGetAttribute(&cus, hipDeviceAttributeMultiprocessorCount, dev) != hipSuccess) { grid = -1; return; }
        if (hipFuncSetAttribute((const void*)mk_fwd, hipFuncAttributeMaxDynamicSharedMemorySize, LDS_BYTES) != hipSuccess) { grid = -1; return; }
        if (hipOccupancyMaxActiveBlocksPerMultiprocessor(&per_cu, (const void*)mk_fwd, NWAVES * 64, LDS_BYTES) != hipSuccess || per_cu < 1) { fprintf(stderr, "kernel_launch: occupancy query says %d\n", per_cu); }
        (void)hipGetLastError();
        if (cus < 256) { fprintf(stderr, "kernel_launch: needs 256 CUs, device has %d\n", cus); grid = -1; return; }
        grid = 256;
    }
    if (grid < 0) return;
    if (hipMemsetAsync((char*)d_ws + WS_CTL, 0, CTL_ZERO_BYTES, stream) != hipSuccess) return;
    Args a{};
    for (int i = 0; i < 19; ++i) a.in[i] = (const float*)d_in[i];
    a.out = (float*)d_out; a.ws = (unsigned char*)d_ws;
    if (MK_N_LAUNCHES == 1) { a.ph_lo = 0; a.ph_hi = N_PHASES; hipLaunchKernelGGL(mk_fwd, dim3(grid), dim3(NWAVES * 64), LDS_BYTES, stream, a); }
    else for (int p = 0; p < N_PHASES; ++p) { a.ph_lo = p; a.ph_hi = p + 1; hipLaunchKernelGGL(mk_fwd, dim3(grid), dim3(NWAVES * 64), LDS_BYTES, stream, a); }
}
```

```cpp
#include <hip/hip_runtime.h>
#include <cstdio>
#include <cstdint>
namespace pg8 {
#define PG8_LAS __attribute__((address_space(3)))
typedef unsigned short bf16_t;
typedef short bf16x8 __attribute__((ext_vector_type(8)));
typedef float f32x4 __attribute__((ext_vector_type(4)));
typedef unsigned u32x4 __attribute__((ext_vector_type(4)));
constexpr int BM = 256, BK = 64, HALF = 128, HTB = HALF * BK * 2  , STAGE_BYTES = 8 * HTB, NXCD = 8, WGM = 8;

__host__ __device__ __forceinline__ int lds_byte(int r, int c) { const int st = (r >> 4) * 2 + (c >> 5), rr = r & 15, cc = c & 31, ob = rr * 64 + cc * 2; return st * 1024 + (ob ^ (((ob >> 9) & 1) << 5)); }
__host__ __device__ __forceinline__ void stage_rc(int b, int& R, int& C) { const int st = b / 1024, sb = b % 1024, swz = sb ^ (((sb >> 9) & 1) << 5); R = (st >> 1) * 16 + swz / 64; C = (st & 1) * 32 + (swz % 64) / 2; }
__host__ __device__ __forceinline__ int perm32(int rho) { const int n = rho >> 4, i = rho & 15; return 8 * (i >> 2) + 4 * n + (i & 3); }

struct Unit { int pm, pn, ui; };
struct Gemm { const bf16_t* A; const bf16_t* Bt; int M, N, K, ld; };

__device__ __forceinline__ void std_map(int wgid, int nM, int nN, Unit& u, int wgm = WGM) {
    const int nwg = nM * nN;
    { const int q = nwg / NXCD, r = nwg % NXCD, xcd = wgid % NXCD, off = wgid / NXCD; wgid = (xcd < r ? xcd * (q + 1) : r * (q + 1) + (xcd - r) * q) + off; }
    const int nig = wgm * nN, gid = wgid / nig, fm = gid * wgm, gsz = (nM - fm) < wgm ? (nM - fm) : wgm;
    u.pm = fm + ((wgid % nig) % gsz); u.pn = (wgid % nig) / gsz;
}
struct StdOrder {
    int nM, nN, nwg, G, c, wgm;
    __device__ __forceinline__ void init(int M, int N, int G_, int c_, int wgm_ = WGM) { nM = M / BM; nN = N / BM; nwg = nM * nN; G = G_; c = c_; wgm = wgm_; }
    __device__ __forceinline__ bool next(int i, Unit& u) const { const long L = (long)i * G + c; if (L >= nwg) return false; std_map((int)L, nM, nN, u, wgm); u.ui = i; return true; }
    __device__ __forceinline__ void bases(const Unit& u, const Gemm& g, size_t tstep, const char*& a, const char*& b) const { a = (const char*)g.A + (size_t)u.pm * tstep; b = (const char*)g.Bt + (size_t)u.pn * tstep; }
    __device__ __forceinline__ void a_ready(const Unit&) const {}
    __device__ __forceinline__ void done(const Unit&) const {}
};
struct InProjOrder {
    int G, c, i0, n;
    __device__ __forceinline__ bool next(int i, Unit& u) const {
        if (i >= n) return false;
        const long L = (long)(i + i0) * G + c;
        u.ui = i + i0;
        if (L < 2560) { std_map((int)L, 64, 40, u); return true; }
        if (L < 2624) { const int j = (int)L - 2560; u.pm = 64 + (j >> 4); u.pn = 8 + (j & 15); return true; }
        return false;
    }
    __device__ __forceinline__ void bases(const Unit& u, const Gemm& g, size_t tstep, const char*& a, const char*& b) const {
        const int ty = u.pn >> 3; const bool sw = (ty == 2) || (ty == 4);
        const char* act = (const char*)g.A + (size_t)u.pm * tstep; const char* w = (const char*)g.Bt + (size_t)u.pn * tstep;
        a = sw ? w : act; b = sw ? act : w;
    }
    __device__ __forceinline__ void a_ready(const Unit&) const {}
    __device__ __forceinline__ void done(const Unit&) const {}
};

__device__ __forceinline__ unsigned cvt_pk_bf16(float lo, float hi) { unsigned r; asm volatile("v_cvt_pk_bf16_f32 %0, %1, %2" : "=v"(r) : "v"(lo), "v"(hi)); return r; }
__device__ __forceinline__ f32x4 lds_ld4(const PG8_LAS float* p) { f32x4 v; asm volatile("ds_read_b128 %0, %1\n\ts_waitcnt lgkmcnt(0)" : "=v"(v) : "v"((unsigned)(size_t)p) : "memory"); return v; }
__device__ __forceinline__ float lds_ld1(const PG8_LAS float* p) { float v; asm volatile("ds_read_b32 %0, %1\n\ts_waitcnt lgkmcnt(0)" : "=v"(v) : "v"((unsigned)(size_t)p) : "memory"); return v; }
__device__ __forceinline__ float gelu_t(float x) { const float u = x * (0.7978845608f + 0.0356774081f * x * x); const float t = __builtin_amdgcn_exp2f(-2.8853900818f * u); return x * __builtin_amdgcn_rcpf(1.0f + t); }

template <int CTRL> __device__ __forceinline__ float dpp_f(float x) { return __builtin_bit_cast(float, __builtin_amdgcn_mov_dpp(__builtin_bit_cast(int, x), CTRL, 0xf, 0xf, true)); }
__device__ __forceinline__ float row16_sum(float s) {
    s += dpp_f<0xB1>(s); s += dpp_f<0x4E>(s); s += dpp_f<0x124>(s); s += dpp_f<0x128>(s); return s; }
struct EpiInProj {
    static constexpr bool PERM = true, AFTER_DRAIN = false, MIDK = false;
    __device__ __forceinline__ void midk(f32x4 (&)[2][2][4][2], int, int) const {}
    bf16_t* base0; size_t slot; float qscale; float* ssg;
    __device__ __forceinline__ void operator()(const f32x4 (&acc)[2][2][4][2], const Unit& u, int wr, int wc, int fr, int fq) const {
        const int ty = u.pn >> 3, sub = (u.pn & 7) * BM, tokb = u.pm * BM;
        bf16_t* base = base0 + (size_t)ty * slot; const bool sw = (ty == 2) || (ty == 4);
        const int ldc = (ty == 2) ? 17408 : ((ty == 4) ? 16384 : 2048), rb = sw ? sub : tokb, cb = sw ? tokb : sub;
        const float sc = (ty == 0) ? qscale : 1.f; const bool act = ty >= 3;
        const int row0 = rb + wr * 64 + fr, col0 = cb + wc * 32 + 8 * fq;
        f32x4 sq[2][2];
#pragma unroll
        for (int bj = 0; bj < 2; ++bj) { sq[bj][0] = (f32x4){0.f, 0.f, 0.f, 0.f}; sq[bj][1] = (f32x4){0.f, 0.f, 0.f, 0.f}; }
#pragma unroll
        for (int ai = 0; ai < 2; ++ai)
#pragma unroll
            for (int m = 0; m < 4; ++m) { bf16_t* rowp = base + (size_t)(row0 + ai * HALF + m * 16) * ldc + col0;
#pragma unroll
                for (int bj = 0; bj < 2; ++bj) { f32x4 v0 = acc[ai][bj][m][0] * sc, v1 = acc[ai][bj][m][1] * sc;
                    if (act) {
#pragma unroll
                        for (int j = 0; j < 4; ++j) { v0[j] = gelu_t(v0[j]); v1[j] = gelu_t(v1[j]); }
                        sq[bj][0] += v0 * v0; sq[bj][1] += v1 * v1; }
                    u32x4 w; w.x = cvt_pk_bf16(v0[0], v0[1]); w.y = cvt_pk_bf16(v0[2], v0[3]); w.z = cvt_pk_bf16(v1[0], v1[1]); w.w = cvt_pk_bf16(v1[2], v1[3]);
                    *(u32x4*)(rowp + bj * HALF) = w; } }
        if (ty == 4) {
            float* sp = ssg + (size_t)(col0) * 16 + (u.pn & 7) * 2 + wr;
#pragma unroll
            for (int bj = 0; bj < 2; ++bj)
#pragma unroll
                for (int n = 0; n < 2; ++n)
#pragma unroll
                    for (int j = 0; j < 4; ++j) { const float s = row16_sum(sq[bj][n][j]); if (fr == 0) sp[(size_t)(bj * HALF + 4 * n + j) * 16] = s; }
        }
    }
};
__device__ __forceinline__ float xrow_sum(float x) {
    auto s = __builtin_amdgcn_permlane16_swap(__float_as_uint(x), __float_as_uint(x), false, false);
    x = __uint_as_float(s[0]) + __uint_as_float(s[1]);
    auto t = __builtin_amdgcn_permlane32_swap(__float_as_uint(x), __float_as_uint(x), false, false);
    return __uint_as_float(t[0]) + __uint_as_float(t[1]);
}
typedef unsigned u32x2 __attribute__((ext_vector_type(2)));
struct EpiRelu2 {
    static constexpr bool PERM = true, AFTER_DRAIN = false, MIDK = false;
    bf16_t* O; int ldc; const PG8_LAS float* cb; const PG8_LAS float* rs;
    __device__ __forceinline__ void midk(f32x4 (&)[2][2][4][2], int, int) const {}
    __device__ __forceinline__ void operator()(const f32x4 (&acc)[2][2][4][2], const Unit& u, int wr, int wc, int fr, int fq) const {
        const int row0 = u.pm * BM + wr * 64 + fr, cin = wc * 32 + 8 * fq, col0 = u.pn * BM + cin;
        const PG8_LAS float* bp = cb + (u.pn >> 2) * BM + cin;
        f32x4 bv[2][2];
#pragma unroll
        for (int bj = 0; bj < 2; ++bj)
#pragma unroll
            for (int n = 0; n < 2; ++n) bv[bj][n] = lds_ld4(bp + bj * HALF + 4 * n);
#pragma unroll
        for (int ai = 0; ai < 2; ++ai)
#pragma unroll
            for (int m = 0; m < 4; ++m) { bf16_t* rowp = O + (size_t)(row0 + ai * HALF + m * 16) * ldc + col0; const float r = lds_ld1(rs + ai * HALF + wr * 64 + m * 16 + fr);
#pragma unroll
                for (int bj = 0; bj < 2; ++bj) { f32x4 v0 = acc[ai][bj][m][0] * r + bv[bj][0], v1 = acc[ai][bj][m][1] * r + bv[bj][1];
#pragma unroll
                    for (int j = 0; j < 4; ++j) { const float a = fmaxf(v0[j], 0.f), b = fmaxf(v1[j], 0.f); v0[j] = a * a; v1[j] = b * b; }
                    u32x4 w; w.x = cvt_pk_bf16(v0[0], v0[1]); w.y = cvt_pk_bf16(v0[2], v0[3]); w.z = cvt_pk_bf16(v1[0], v1[1]); w.w = cvt_pk_bf16(v1[2], v1[3]);
                    *(u32x4*)(rowp + bj * HALF) = w; } }
    }
};
struct EpiOutProj {
    static constexpr bool PERM = true, AFTER_DRAIN = false, MIDK = true;
    const float* x; bf16_t* x1b; bf16_t* a3; int lda3; float* pss; const PG8_LAS float* gvt; const PG8_LAS float* avt; const PG8_LAS float* tab;
    __device__ __forceinline__ void midk(f32x4 (&acc)[2][2][4][2], int wr, int fr) const {
#pragma unroll
        for (int ai = 0; ai < 2; ++ai)
#pragma unroll
            for (int m = 0; m < 4; ++m) { const float f = lds_ld1(tab + ai * HALF + wr * 64 + m * 16 + fr);
#pragma unroll
                for (int bj = 0; bj < 2; ++bj)
#pragma unroll
                    for (int n = 0; n < 2; ++n) acc[ai][bj][m][n] *= f; }
    }
    __device__ __forceinline__ void operator()(const f32x4 (&acc)[2][2][4][2], const Unit& u, int wr, int wc, int fr, int fq) const {
        const int cin = wc * 32 + 8 * fq, col0 = u.pn * BM + cin, tr0 = wr * 64 + fr, ct0 = (u.pn >> 2) * BM + cin;
        const size_t off0 = (size_t)(u.pm * BM + tr0) * 4096 + col0;
        float ss[2][4];
#pragma unroll
        for (int ai = 0; ai < 2; ++ai)
#pragma unroll
            for (int m = 0; m < 4; ++m) ss[ai][m] = 0.f;
#pragma unroll
        for (int bj = 0; bj < 2; ++bj) {
            const f32x4 g0 = lds_ld4(gvt + ct0 + bj * HALF), g1 = lds_ld4(gvt + ct0 + bj * HALF + 4);
            const f32x4 a0 = lds_ld4(avt + ct0 + bj * HALF), a1 = lds_ld4(avt + ct0 + bj * HALF + 4);
#pragma unroll
            for (int ai = 0; ai < 2; ++ai)
#pragma unroll
                for (int m = 0; m < 4; ++m) { const size_t off = off0 + (size_t)(ai * HALF + m * 16) * 4096 + bj * HALF; const float r = lds_ld1(tab + 256 + ai * HALF + m * 16 + tr0);
                    const f32x4 v0 = *(const f32x4*)(x + off) + g0 * (acc[ai][bj][m][0] * r), v1 = *(const f32x4*)(x + off + 4) + g1 * (acc[ai][bj][m][1] * r);
                    { u32x4 w1; w1.x = cvt_pk_bf16(v0.x, v0.y); w1.y = cvt_pk_bf16(v0.z, v0.w); w1.z = cvt_pk_bf16(v1.x, v1.y); w1.w = cvt_pk_bf16(v1.z, v1.w); *(u32x4*)(x1b + off) = w1; }
                    ss[ai][m] += ((v0.x * v0.x + v0.y * v0.y) + (v0.z * v0.z + v0.w * v0.w)) + ((v1.x * v1.x + v1.y * v1.y) + (v1.z * v1.z + v1.w * v1.w));
                    const f32x4 b0 = v0 * a0, b1 = v1 * a1; u32x4 w; w.x = cvt_pk_bf16(b0.x, b0.y); w.y = cvt_pk_bf16(b0.z, b0.w); w.z = cvt_pk_bf16(b1.x, b1.y); w.w = cvt_pk_bf16(b1.z, b1.w);
                    *(u32x4*)(a3 + (size_t)(u.pm * BM + tr0 + ai * HALF + m * 16) * lda3 + col0 + bj * HALF) = w; }
            asm volatile("" ::: "memory"); }
#pragma unroll
        for (int ai = 0; ai < 2; ++ai)
#pragma unroll
            for (int m = 0; m < 4; ++m) { const float s = xrow_sum(ss[ai][m]);
                if (fq == 0) pss[(size_t)(u.pm * BM + ai * HALF + m * 16 + tr0) * 64 + u.pn * 4 + wc] = s; }
    }
};
struct EpiGatedRes {
    static constexpr bool PERM = true, AFTER_DRAIN = false, MIDK = false;
    bf16_t* xb; const PG8_LAS float* gvt;
    __device__ __forceinline__ void midk(f32x4 (&)[2][2][4][2], int, int) const {}
    __device__ __forceinline__ void operator()(const f32x4 (&acc)[2][2][4][2], const Unit& u, int wr, int wc, int fr, int fq) const {
        const int cin = wc * 32 + 8 * fq, col0 = u.pn * BM + cin, ct0 = u.ui * BM + cin;
        const size_t off0 = (size_t)(u.pm * BM + wr * 64 + fr) * 4096 + col0;
#pragma unroll
        for (int bj = 0; bj < 2; ++bj) {
            const f32x4 g0 = lds_ld4(gvt + ct0 + bj * HALF), g1 = lds_ld4(gvt + ct0 + bj * HALF + 4);
#pragma unroll
            for (int ai = 0; ai < 2; ++ai)
#pragma unroll
                for (int m = 0; m < 4; ++m) { const size_t off = off0 + (size_t)(ai * HALF + m * 16) * 4096 + bj * HALF;
                    const u32x4 b = *(const u32x4*)(xb + off);
                    const f32x4 v0 = (f32x4){__uint_as_float(b.x << 16), __uint_as_float(b.x & 0xffff0000u), __uint_as_float(b.y << 16), __uint_as_float(b.y & 0xffff0000u)} + g0 * acc[ai][bj][m][0];
                    const f32x4 v1 = (f32x4){__uint_as_float(b.z << 16), __uint_as_float(b.z & 0xffff0000u), __uint_as_float(b.w << 16), __uint_as_float(b.w & 0xffff0000u)} + g1 * acc[ai][bj][m][1];
                    u32x4 w; w.x = cvt_pk_bf16(v0.x, v0.y); w.y = cvt_pk_bf16(v0.z, v0.w); w.z = cvt_pk_bf16(v1.x, v1.y); w.w = cvt_pk_bf16(v1.z, v1.w);
                    *(u32x4*)(xb + off) = w; }
            asm volatile("" ::: "memory"); }
    }
};

template <class Epi, class Sched, bool ALIGN_EPI = false, bool SP2 = false>
__device__ __forceinline__ void gemm_phase(PG8_LAS unsigned char* lds, const Gemm g, const Sched& S, const Epi& E) {
    const int tid = threadIdx.x, wid = __builtin_amdgcn_readfirstlane(tid >> 6), lane = tid & 63, wr = wid >> 2, wc = wid & 3, fr = lane & 15, fq = lane >> 4;
    const int K = g.K, nt = K / BK;
    unsigned voffA[2], voffB[2];
#pragma unroll
    for (int i = 0; i < 2; ++i) { int R, C; stage_rc(tid * 16 + i * 8192, R, C); const int Rb = Epi::PERM ? ((R & ~31) + perm32(R & 31)) : R;
        voffA[i] = (unsigned)(R * g.ld + C) * 2u; voffB[i] = (unsigned)(Rb * g.ld + C) * 2u; }
    const size_t kstep = (size_t)(BK * 2);
    const size_t hstep = (size_t)HALF * g.ld * 2;
    const size_t tstep = 2 * hstep;
    const unsigned ldsw = (unsigned)wid * 1024u;
    const int aoff = lds_byte(wr * 64 + fr, fq * 8), boff = lds_byte(wc * 32 + fr, fq * 8);
#define PG8_SA(b, h) (((b) * 2 + (h)) * HTB)
#define PG8_SB(b, h) ((4 + (b) * 2 + (h)) * HTB)
#define PG8_STAGE(bufoff, gbase, voff) do { _Pragma("unroll") for (int _i = 0; _i < 2; ++_i) \
        __builtin_amdgcn_global_load_lds((const unsigned*)((const char*)(gbase) + (voff)[_i]), (PG8_LAS unsigned*)(lds + (bufoff) + ldsw + _i * 8192), 16, 0, 0); } while (0)
#define PG8_LDA(dst, b, h) do { _Pragma("unroll") for (int m = 0; m < 4; ++m) _Pragma("unroll") for (int k = 0; k < 2; ++k) dst[m][k] = *(const PG8_LAS bf16x8*)(lds + PG8_SA(b, h) + aoff + m * 2048 + k * 1024); } while (0)
#define PG8_LDB(dst, b, h) do { _Pragma("unroll") for (int n = 0; n < 2; ++n) _Pragma("unroll") for (int k = 0; k < 2; ++k) dst[n][k] = *(const PG8_LAS bf16x8*)(lds + PG8_SB(b, h) + boff + n * 2048 + k * 1024); } while (0)
#define PG8_MMA(ai, bj, At, Bt) do { __builtin_amdgcn_s_setprio(1); _Pragma("unroll") for (int m = 0; m < 4; ++m) _Pragma("unroll") for (int n = 0; n < 2; ++n) _Pragma("unroll") for (int k = 0; k < 2; ++k) \
        acc[ai][bj][m][n] = __builtin_amdgcn_mfma_f32_16x16x32_bf16(Bt[n][k], At[m][k], acc[ai][bj][m][n], 0, 0, 0); __builtin_amdgcn_s_setprio(0); } while (0)
#define PG8_WAIT_V(n) asm volatile("s_waitcnt vmcnt(" #n ")" ::: "memory")
#define PG8_WAIT_L(n) asm volatile("s_waitcnt lgkmcnt(" #n ")" ::: "memory")
#define PG8_BAR __builtin_amdgcn_s_barrier()
#define PG8_SCHED __builtin_amdgcn_sched_barrier(0)
    Unit cur, nxt; int ui = 0;
    if (!S.next(0, cur)) return;
    f32x4 acc[2][2][4][2];
#pragma unroll
    for (int a = 0; a < 2; ++a)
#pragma unroll
        for (int b = 0; b < 2; ++b)
#pragma unroll
            for (int m = 0; m < 4; ++m)
#pragma unroll
                for (int n = 0; n < 2; ++n) acc[a][b][m][n] = (f32x4){0.f, 0.f, 0.f, 0.f};
    bf16x8 At[4][2], B0[2][2], B1[2][2];
    const char* cA; const char* cB; S.bases(cur, g, tstep, cA, cB);
    S.a_ready(cur);
    if constexpr (SP2) {
        PG8_STAGE(PG8_SB(0, 0), cB, voffB); PG8_STAGE(PG8_SB(0, 1), cB + hstep, voffB); PG8_STAGE(PG8_SA(0, 0), cA, voffA); PG8_STAGE(PG8_SA(0, 1), cA + hstep, voffA);
        if (wr == 1) PG8_BAR;
        PG8_WAIT_V(2); PG8_BAR;
        PG8_STAGE(PG8_SB(1, 0), cB + kstep, voffB); PG8_STAGE(PG8_SA(1, 0), cA + kstep, voffA); PG8_STAGE(PG8_SB(1, 1), cB + hstep + kstep, voffB);
        PG8_WAIT_V(6); PG8_BAR;
    } else {
        PG8_STAGE(PG8_SB(0, 0), cB, voffB); PG8_STAGE(PG8_SA(0, 0), cA, voffA); PG8_STAGE(PG8_SB(0, 1), cB + hstep, voffB); PG8_STAGE(PG8_SA(0, 1), cA + hstep, voffA);
        if (wr == 1) PG8_BAR;
        PG8_WAIT_V(4); PG8_BAR;
        PG8_STAGE(PG8_SB(1, 0), cB + kstep, voffB); PG8_STAGE(PG8_SA(1, 0), cA + kstep, voffA); PG8_STAGE(PG8_SB(1, 1), cB + hstep + kstep, voffB);
        PG8_WAIT_V(6); PG8_BAR;
    }
    for (;;) {
        const bool has_next = S.next(ui + 1, nxt);
        const char* nA = cA; const char* nB = cB; if (has_next) S.bases(nxt, g, tstep, nA, nB);
        for (int t = 0; t < nt; t += 2) {
            const bool last = (t == nt - 2);
            const char* a1 = cA + (size_t)(t + 1) * kstep;
            const char* a2 = last ? nA : cA + (size_t)(t + 2) * kstep; const char* b2 = last ? nB : cB + (size_t)(t + 2) * kstep;
            const char* a3 = a2 + kstep; const char* b3 = b2 + kstep;
            if (last && has_next) S.a_ready(nxt);
            if constexpr (Epi::MIDK) { if (t == (nt >> 1)) { E.midk(acc, wr, fr); asm volatile("s_waitcnt lgkmcnt(0)" ::: "memory"); } }
            if constexpr (SP2) {
            PG8_LDB(B0, 0, 0); PG8_LDB(B1, 0, 1); PG8_SCHED; PG8_LDA(At, 0, 0); PG8_STAGE(PG8_SA(1, 1), a1 + hstep, voffA);
            PG8_WAIT_V(8); PG8_WAIT_L(0); PG8_BAR; PG8_MMA(0, 0, At, B0); PG8_MMA(0, 1, At, B1); PG8_BAR; PG8_SCHED;
            PG8_LDA(At, 0, 1); PG8_STAGE(PG8_SB(0, 0), b2, voffB); PG8_STAGE(PG8_SB(0, 1), b2 + hstep, voffB); PG8_STAGE(PG8_SA(0, 0), a2, voffA);
            PG8_WAIT_V(8); PG8_WAIT_L(0); PG8_BAR; PG8_MMA(1, 0, At, B0); PG8_MMA(1, 1, At, B1); PG8_BAR; PG8_SCHED;
            PG8_LDB(B0, 1, 0); PG8_LDB(B1, 1, 1); PG8_SCHED; PG8_LDA(At, 1, 0); PG8_STAGE(PG8_SA(0, 1), a2 + hstep, voffA);
            PG8_WAIT_V(8); PG8_WAIT_L(0); PG8_BAR; PG8_MMA(0, 0, At, B0); PG8_MMA(0, 1, At, B1); PG8_BAR; PG8_SCHED;
            PG8_LDA(At, 1, 1); PG8_STAGE(PG8_SB(1, 0), b3, voffB); PG8_STAGE(PG8_SB(1, 1), b3 + hstep, voffB); PG8_STAGE(PG8_SA(1, 0), a3, voffA);
            PG8_WAIT_V(8); PG8_WAIT_L(0); PG8_BAR; PG8_MMA(1, 0, At, B0); PG8_MMA(1, 1, At, B1); PG8_BAR; PG8_SCHED;
            } else {
            PG8_LDB(B0, 0, 0); PG8_SCHED; PG8_LDA(At, 0, 0); PG8_STAGE(PG8_SA(1, 1), a1 + hstep, voffA);
            PG8_WAIT_L(8); PG8_BAR; PG8_WAIT_L(0); PG8_MMA(0, 0, At, B0); PG8_BAR; PG8_SCHED;
            PG8_LDB(B1, 0, 1); PG8_STAGE(PG8_SB(0, 0), b2, voffB);
            PG8_BAR; PG8_WAIT_L(0); PG8_MMA(0, 1, At, B1); PG8_BAR;
            PG8_LDA(At, 0, 1); PG8_STAGE(PG8_SA(0, 0), a2, voffA);
            PG8_BAR; PG8_WAIT_L(0); PG8_MMA(1, 0, At, B0); PG8_BAR; PG8_SCHED;
            PG8_STAGE(PG8_SB(0, 1), b2 + hstep, voffB);
            PG8_WAIT_V(6); PG8_BAR; PG8_MMA(1, 1, At, B1); PG8_BAR;
            PG8_LDB(B0, 1, 0); PG8_SCHED; PG8_LDA(At, 1, 0); PG8_STAGE(PG8_SA(0, 1), a2 + hstep, voffA);
            PG8_WAIT_L(8); PG8_BAR; PG8_WAIT_L(0); PG8_MMA(0, 0, At, B0); PG8_BAR; PG8_SCHED;
            PG8_LDB(B1, 1, 1); PG8_STAGE(PG8_SB(1, 0), b3, voffB);
            PG8_BAR; PG8_WAIT_L(0); PG8_MMA(0, 1, At, B1); PG8_BAR;
            PG8_LDA(At, 1, 1); PG8_STAGE(PG8_SA(1, 0), a3, voffA);
            PG8_BAR; PG8_WAIT_L(0); PG8_MMA(1, 0, At, B0); PG8_BAR; PG8_SCHED;
            PG8_STAGE(PG8_SB(1, 1), b3 + hstep, voffB);
            PG8_WAIT_V(6); PG8_BAR; PG8_MMA(1, 1, At, B1); PG8_BAR;
            }
        }
        if constexpr (ALIGN_EPI) { if (wr == 0) PG8_BAR; }
        if constexpr (!Epi::AFTER_DRAIN) { E(acc, cur, wr, wc, fr, fq); S.done(cur); }
        if (!has_next) break;
#pragma unroll
        for (int a = 0; a < 2; ++a)
#pragma unroll
            for (int b = 0; b < 2; ++b)
#pragma unroll
                for (int m = 0; m < 4; ++m)
#pragma unroll
                    for (int n = 0; n < 2; ++n) acc[a][b][m][n] = (f32x4){0.f, 0.f, 0.f, 0.f};
        cur = nxt; cA = nA; cB = nB; ++ui;
        if constexpr (ALIGN_EPI) { if (wr == 1) PG8_BAR; }
    }
    PG8_WAIT_V(0);
    if constexpr (!ALIGN_EPI) { if (wr == 0) PG8_BAR; }
    PG8_BAR;
    if constexpr (Epi::AFTER_DRAIN) { E.fused(acc, cur, wr, wc, fr, fq, lds, wid, lane); S.done(cur); }
#undef PG8_SA
#undef PG8_SB
#undef PG8_STAGE
#undef PG8_LDA
#undef PG8_LDB
#undef PG8_MMA
#undef PG8_WAIT_V
#undef PG8_WAIT_L
#undef PG8_BAR
#undef PG8_SCHED
}
}

constexpr int NWAVES = 8;
#ifndef MK_N_LAUNCHES
#define MK_N_LAUNCHES 1
#endif
constexpr int N_PHASES = 8;
#ifndef FF2_WGM
#define FF2_WGM 4
#endif
#ifndef P0_KS
#define P0_KS 1
#endif
#ifndef PRE_IDLE_US
#define PRE_IDLE_US 0
#endif
#ifndef REP_PHASE
#define REP_PHASE -1
#endif
#define REPS(k) (((k) == REP_PHASE) ? 2 : 1)
#ifndef DBG_MULT
#define DBG_MULT 4
#endif
#ifndef DBG_SLOT
#define DBG_SLOT -1
#endif
constexpr int D = 4096, BATCH = 4, SEQ = 4096, GW = 64, CTX = 256;
constexpr int NH = 16, HD = 128, DNA = 2048, DSGU = 2048, DIN = 10240, DFF = 16384, NMODC = 6 * D;
constexpr int LDK = D;
constexpr int LDF2 = DFF + 64;
constexpr int M = BATCH * SEQ, MC = BATCH * CTX, MA = M + MC;
constexpr float EPS = 1e-6f;
constexpr float LOG2E = 1.4426950408889634f;
constexpr int ADA_KS = 16, ADA_STRIPS = NMODC / 256;

constexpr size_t MiB = 1u << 20;
constexpr size_t WS_CTL = 0, CTL_ZERO_BYTES = 1 * MiB;
constexpr size_t WS_MODF = 1 * MiB;
constexpr size_t WS_PART = 2 * MiB;
constexpr size_t WS_SSNA = 10 * MiB;
constexpr size_t WS_SSGP = 2 * MiB;
constexpr size_t WS_SSSG = 11 * MiB;
constexpr size_t WS_CBIAS = 11 * MiB + 512 * 1024;
constexpr size_t WS_PSS = 12 * MiB;
constexpr size_t WS_WIN = 16 * MiB;
constexpr size_t WS_WOUT = 96 * MiB;
constexpr size_t WS_WFF1 = 128 * MiB;
constexpr size_t WS_WFF2 = 260 * MiB;
constexpr size_t WS_A1 = 390 * MiB;
constexpr size_t WS_SLOT = 68 * MiB;
constexpr size_t WS_Q = 526 * MiB;
constexpr size_t WS_K = WS_Q + 1 * WS_SLOT;
constexpr size_t WS_VT = WS_Q + 2 * WS_SLOT;
constexpr size_t WS_U = WS_Q + 3 * WS_SLOT;
constexpr size_t WS_GT = WS_Q + 4 * WS_SLOT;
constexpr size_t WS_A2 = WS_Q + 5 * WS_SLOT;
constexpr size_t WS_H = 526 * MiB;
constexpr size_t WS_XB = 1040 * MiB;
constexpr size_t WS_END = 1168 * MiB;
static_assert(WS_A1 + (size_t)MA * D * 2 <= WS_Q && WS_K + (size_t)MA * DNA * 2 <= WS_VT && WS_VT + (size_t)DNA * MA * 2 <= WS_U && WS_GT + (size_t)DSGU * M * 2 <= WS_A2 && WS_A2 + (size_t)M * D * 2 <= WS_END && WS_H + (size_t)M * LDF2 * 2 <= WS_XB && WS_WFF2 + (size_t)D * LDF2 * 2 <= WS_A1 && WS_WFF1 + (size_t)DFF * LDK * 2 <= WS_WFF2 && WS_A1 + (size_t)M * LDK * 2 <= WS_Q && WS_XB + (size_t)M * D * 2 <= WS_END, "d_ws map");
constexpr int CW_BAR = 4096;

constexpr int RING_OFF = 0, RING_BYTES = 131072;
constexpr int ROWTAB_OFF = RING_BYTES, COLTAB_OFF = ROWTAB_OFF + 2048;
constexpr int LDSCTL_OFF = 149504, MISC_OFF = LDSCTL_OFF + 320;
constexpr int LDS_BYTES = 150528;
static_assert(COLTAB_OFF + 16384 <= LDSCTL_OFF && MISC_OFF + 128 <= LDS_BYTES, "LDS map");

#define GAS __attribute__((address_space(1)))
#define LAS __attribute__((address_space(3)))
typedef unsigned short bf16;
typedef unsigned v4u __attribute__((ext_vector_type(4)));
typedef unsigned v2u __attribute__((ext_vector_type(2)));
typedef float f32x4 __attribute__((ext_vector_type(4)));
typedef short bf16x8 __attribute__((ext_vector_type(8)));
typedef GAS unsigned gu32;
#define RLX_AGENT __ATOMIC_RELAXED, __HIP_MEMORY_SCOPE_AGENT
#define LDS_WAIT() asm volatile("s_waitcnt lgkmcnt(0)" ::: "memory")
#define VM_WAIT() asm volatile("s_waitcnt vmcnt(0)" ::: "memory")
__device__ __forceinline__ unsigned pk2(float lo, float hi) { return pg8::cvt_pk_bf16(lo, hi); }
__device__ __forceinline__ float bf_lo(unsigned w) { return __builtin_bit_cast(float, w << 16); }
__device__ __forceinline__ float bf_hi(unsigned w) { return __builtin_bit_cast(float, w & 0xffff0000u); }

#define XB_TMO      128
#define XB_XCNT(j)  (256  + 64 * (j))
#define XB_XSUB(j)  (1280 + 64 * (j))
#define XB_XGEN(j)  (2304 + 64 * (j))
#define XB_TOP      3328
#define XB_TOPGEN   3392
#define XCD_BAR_WORDS 3456
#define XB_SPIN_CAP (1u << 18)

__device__ __forceinline__ unsigned xb_ld(unsigned* p)              { return __hip_atomic_load(p, __ATOMIC_RELAXED, __HIP_MEMORY_SCOPE_AGENT); }
__device__ __forceinline__ unsigned xb_add(unsigned* p, unsigned v) { return __hip_atomic_fetch_add(p, v, __ATOMIC_RELAXED, __HIP_MEMORY_SCOPE_AGENT); }
__device__ __forceinline__ unsigned xb_xcc_id() { return (unsigned)__builtin_amdgcn_s_getreg((3 << 11) | 20) & 0xFu; }
#define XB_SPIN(cond, bar) do { unsigned _sp = 0; while (cond) { __builtin_amdgcn_s_sleep(1); \
    if ((++_sp & 255u) == 0u) { if (xb_ld(&(bar)[XB_TMO])) break; if (_sp > XB_SPIN_CAP) { atomicAdd(&(bar)[XB_TMO], 1u); break; } } } } while (0)

struct XcdBarrier {
    unsigned* bar; unsigned x;
    volatile LAS unsigned* st;
};

__device__ __forceinline__ XcdBarrier xcd_barrier_post(unsigned* bar, volatile LAS unsigned* st) {
    XcdBarrier b; b.bar = bar; b.x = xb_xcc_id(); b.st = st;
    if (threadIdx.x == 0) (void)xb_add(&bar[XB_XCNT(b.x)], 1u);
    return b;
}
__device__ __forceinline__ void xcd_barrier_complete(unsigned* bar, unsigned x, unsigned& nloc, unsigned& nx) {
    const unsigned G = gridDim.x * gridDim.y * gridDim.z;
    unsigned sum, cnt, mine, sp = 0u;
    for (;;) {
        sum = 0u; cnt = 0u; mine = 0u;
#pragma unroll
        for (unsigned j = 0; j < 16; ++j) { const unsigned c = xb_ld(&bar[XB_XCNT(j)]); sum += c; cnt += (c > 0u) ? 1u : 0u; mine = (j == x) ? c : mine; }
        if (sum == G) break;
        __builtin_amdgcn_s_sleep(1);
        if ((++sp & 255u) == 0u) { if (xb_ld(&bar[XB_TMO])) break; if (sp > XB_SPIN_CAP) { atomicAdd(&bar[XB_TMO], 1u); break; } }
    }
    nloc = mine > 0u ? mine : 1u; nx = cnt > 0u ? cnt : 1u;
}

__device__ __forceinline__ void xcd_barrier(const XcdBarrier& b) {
    asm volatile("s_waitcnt vmcnt(0)" ::: "memory");
    __syncthreads();
    if (threadIdx.x == 0) {
        unsigned* bar = b.bar;
        __builtin_amdgcn_s_waitcnt(0);
        unsigned nloc = b.st[0], nx = b.st[1];
        if (nloc == 0u) { xcd_barrier_complete(bar, b.x, nloc, nx); b.st[0] = nloc; b.st[1] = nx; }
        const unsigned old = xb_add(&bar[XB_XSUB(b.x)], 1u);
        const unsigned gen = old / nloc;
        if (old + 1u == (gen + 1u) * nloc) {
            __builtin_amdgcn_fence(__ATOMIC_RELEASE, "agent");
            asm volatile("s_waitcnt vmcnt(0)" ::: "memory");
            const unsigned og = xb_add(&bar[XB_TOP], 1u);
            const unsigned tg = og / nx;
            if (og + 1u == (tg + 1u) * nx) xb_add(&bar[XB_TOPGEN], 1u);
            else XB_SPIN(xb_ld(&bar[XB_TOPGEN]) == tg, bar);
            __builtin_amdgcn_fence(__ATOMIC_ACQUIRE, "agent");
            xb_add(&bar[XB_XGEN(b.x)], 1u);
            asm volatile("s_waitcnt vmcnt(0)" ::: "memory");
        } else {
            XB_SPIN(xb_ld(&bar[XB_XGEN(b.x)]) == gen, bar);
            __builtin_amdgcn_fence(__ATOMIC_ACQUIRE, "agent");
            asm volatile("s_waitcnt vmcnt(0)" ::: "memory");
        }
    }
    __syncthreads();
}

struct Frame {
    LAS unsigned char* lds;
    volatile LAS unsigned* MISC;
    gu32* ctl;
    int tid, lane, wave, G, vc;
    const float *x, *c, *ctx, *cctx, *w_ada, *b_ada, *norm1_w, *w_in, *rpb, *sgu_norm_w, *sgu_w, *sgu_b, *gna, *gsgu, *w_out, *norm2_w, *w_ff1, *w_ff2, *fnw;
    float* out;
    float *modf, *part, *ssna, *sssg, *cbias, *pss, *ssgp;
    bf16 *Wt_in, *Wt_out, *Wt_ff1, *Wt_ff2, *A1, *QB, *KB, *VT, *UB, *GT, *A2, *HB, *XB;
};
constexpr int CW_DBG = 8192;
#define DBG_BEGIN(t) unsigned long long t = 0; if (DBG_SLOT >= 0) t = __builtin_amdgcn_s_memrealtime()
#define DBG_MARK(t) do { if (DBG_SLOT >= 0) t = __builtin_amdgcn_s_memrealtime(); } while (0)
#define DBG_CLK_BEGIN(c, r) unsigned long long c = 0, r = 0; if (DBG_SLOT >= 0) { c = __builtin_amdgcn_s_memtime(); r = __builtin_amdgcn_s_memrealtime(); }
#define DBG_CLK_END(F, slot, c, r) do { if (DBG_SLOT >= 0 && (F).tid == 0 && blockIdx.x == 0) { const unsigned long long dc_ = __builtin_amdgcn_s_memtime() - (c), dr_ = __builtin_amdgcn_s_memrealtime() - (r); \
        atomicMax((unsigned*)((F).ctl + CW_DBG + 64 * (slot)), (unsigned)(dc_ * 1000ull / (dr_ ? dr_ : 1ull))); } } while (0)
#define DBG_END(F, slot, t) do { if (DBG_SLOT >= 0 && (F).tid == 0) atomicMax((unsigned*)((F).ctl + CW_DBG + 64 * (slot)), (unsigned)(__builtin_amdgcn_s_memrealtime() - (t))); } while (0)
__device__ __forceinline__ float wave_sum(float v) {
#pragma unroll
    for (int o = 1; o < 64; o <<= 1) v += __shfl_xor(v, o);
    return v;
}
constexpr int CW_EVT = 12288;
__device__ __forceinline__ void evt_arrive(Frame& F, int k) {
    asm volatile("s_waitcnt vmcnt(0)" ::: "memory"); __syncthreads();
    if (F.tid == 0) { __builtin_amdgcn_fence(__ATOMIC_RELEASE, "agent"); asm volatile("s_waitcnt vmcnt(0)" ::: "memory"); (void)__hip_atomic_fetch_add((unsigned*)(F.ctl + CW_EVT + 64 * k), 1u, RLX_AGENT); }
}
__device__ __forceinline__ void evt_wait(Frame& F, int k) {
    if (F.tid == 0) { unsigned* p = (unsigned*)(F.ctl + CW_EVT + 64 * k); unsigned sp = 0u;
        while (__hip_atomic_load(p, RLX_AGENT) < (unsigned)F.G) { __builtin_amdgcn_s_sleep(2); if (++sp > (1u << 20)) break; }
        __builtin_amdgcn_fence(__ATOMIC_ACQUIRE, "agent"); asm volatile("s_waitcnt vmcnt(0)" ::: "memory"); }
    __syncthreads();
}
constexpr int I_IN = (D / 64) * (DIN / 32), I_OUT = (D / 64) * (D / 32), I_F1 = (D / 64) * (DFF / 32), I_F2 = (DFF / 64) * (D / 32), I_TR = I_IN + I_OUT + I_F1 + I_F2;
struct TIt { const float* src; bf16* dst; const float* kg; int N, K; };
__device__ __forceinline__ void p0_titem(Frame& F, int t, TIt& r) {
    int x = t; const float* W = F.w_in; bf16* WT = F.Wt_in; int K = D, N = DIN; bool gain = false;
    if (x >= I_IN) { x -= I_IN; W = F.w_out; WT = F.Wt_out; N = D; gain = true;
        if (x >= I_OUT) { x -= I_OUT; W = F.w_ff1; WT = F.Wt_ff1; N = DFF; K = LDK; gain = false;
            if (x >= I_F1) { x -= I_F1; W = F.w_ff2; WT = F.Wt_ff2; K = LDF2; N = D; } } }
    constexpr int KS = P0_KS, NS = 8 / P0_KS;
    const int nblk = N >> 5, gpr = nblk / NS, gidx = x >> 3, sub = x & 7, gk = gidx / gpr, gn = gidx - gk * gpr, kb = gk * KS + sub / NS, nb = gn * NS + sub % NS, k0 = 64 * kb, n0 = 32 * nb;
    r.src = W + (size_t)k0 * N + n0; r.dst = WT + (size_t)n0 * K + k0; r.N = N; r.K = K;
    r.kg = gain ? (k0 < 2048 ? F.gna + k0 : F.gsgu + (k0 - 2048)) : nullptr;
}
__device__ __forceinline__ void p0_tload(const TIt& r, float (&v)[32], int lane) {
    const float* p = r.src + (size_t)(lane >> 5) * r.N + (lane & 31);
#pragma unroll
    for (int i = 0; i < 32; ++i) v[i] = p[(size_t)(2 * i) * r.N];
}
__device__ __forceinline__ void p0_tstore(const TIt& r, const float (&v)[32], LAS float* scr, int lane) {
#pragma unroll
    for (int i = 0; i < 32; ++i) { const int kk = 2 * i + (lane >> 5); float x = v[i]; if (r.kg) x *= r.kg[kk]; scr[kk * 33 + (lane & 31)] = x; }
    LDS_WAIT(); asm volatile("" ::: "memory");
    const int c = lane & 7;
#pragma unroll
    for (int j = 0; j < 4; ++j) { const int n = (lane >> 3) + 8 * j; const LAS float* s = scr + (8 * c) * 33 + n;
        v4u o; o.x = pk2(s[0 * 33], s[1 * 33]); o.y = pk2(s[2 * 33], s[3 * 33]); o.z = pk2(s[4 * 33], s[5 * 33]); o.w = pk2(s[6 * 33], s[7 * 33]);
        *(GAS v4u*)(r.dst + (size_t)n * r.K + 8 * c) = o; }
    LDS_WAIT(); asm volatile("" ::: "memory");
}
__device__ __forceinline__ float silu_f(float v) { return v / (1.0f + __expf(-v)); }
typedef float f32x3 __attribute__((ext_vector_type(3)));
__device__ __forceinline__ void p0_ada_item(Frame& F, int item, LAS float* sil) {
    const int s = item & 127, ks = item >> 7, k0 = ks * 256, lane = F.lane;
#pragma unroll
    for (int r = 0; r < 5; ++r) { const float* src = (r < 4) ? F.c + r * D : F.cctx; const f32x4 v = *(const f32x4*)(src + k0 + 4 * lane);
        f32x4 o; o.x = silu_f(v.x); o.y = silu_f(v.y); o.z = silu_f(v.z); o.w = silu_f(v.w); *(LAS f32x4*)(sil + r * 256 + 4 * lane) = o; }
    LDS_WAIT(); asm volatile("" ::: "memory");
    f32x3 acc[5];
#pragma unroll
    for (int r = 0; r < 5; ++r) acc[r] = (f32x3){0.f, 0.f, 0.f};
    const float* wp = F.w_ada + (size_t)k0 * NMODC + 192 * s + 3 * lane;
#pragma unroll 16
    for (int kk = 0; kk < 256; ++kk) { const f32x3 w = *(const f32x3*)(wp + (size_t)kk * NMODC);
#pragma unroll
        for (int r = 0; r < 5; ++r) acc[r] += w * sil[r * 256 + kk]; }
#pragma unroll
    for (int r = 0; r < 5; ++r) *(f32x3*)(F.part + (size_t)(ks * 5 + r) * NMODC + 192 * s + 3 * lane) = acc[r];
    LDS_WAIT(); asm volatile("" ::: "memory");
}
__device__ __forceinline__ void p0_prologue(Frame& F) {
    LAS float* scr = (LAS float*)(F.lds + RING_OFF + F.wave * 16384);
    LAS float* sil = (LAS float*)(F.lds + RING_OFF + F.wave * 16384 + 8704);
    const int gw = (int)blockIdx.x * NWAVES + F.wave;
    constexpr int NW = 2048, NT = I_TR / NW;
    static_assert(ADA_KS * 128 == NW && NT * NW == I_TR && NT >= 3, "P0 work split");
    p0_ada_item(F, gw, sil);
    TIt ia, ib, ic; float va[32], vb[32], vc[32];
    p0_titem(F, gw, ia); p0_tload(ia, va, F.lane);
    p0_titem(F, gw + NW, ib); p0_tload(ib, vb, F.lane);
    for (int k = 0; k < NT; k += 3) {
        if (k + 2 < NT) { p0_titem(F, gw + (k + 2) * NW, ic); p0_tload(ic, vc, F.lane); }
        p0_tstore(ia, va, scr, F.lane);
        if (k + 3 < NT) { p0_titem(F, gw + (k + 3) * NW, ia); p0_tload(ia, va, F.lane); }
        if (k + 1 < NT) p0_tstore(ib, vb, scr, F.lane);
        if (k + 4 < NT) { p0_titem(F, gw + (k + 4) * NW, ib); p0_tload(ib, vb, F.lane); }
        if (k + 2 < NT) p0_tstore(ic, vc, scr, F.lane);
    }
}
__device__ __forceinline__ f32x4 ld4(const float* p) { return *(const f32x4*)p; }
__device__ __forceinline__ f32x4 ld4(const LAS float* p) { return *(const LAS f32x4*)p; }
__device__ __forceinline__ void row_load(const float* xrow, f32x4 (&v)[16], int lane) {
#pragma unroll
    for (int j = 0; j < 8; ++j) { const float* p = xrow + 8 * (lane + 64 * j); v[2 * j] = *(const f32x4*)p; v[2 * j + 1] = *(const f32x4*)(p + 4); }
}
template <class SP> __device__ __forceinline__ void row_finish(const f32x4 (&v)[16], const float* nw, SP sh, SP sc, bf16* orow, int lane) {
    float ss = 0.f;
#pragma unroll
    for (int j = 0; j < 16; ++j) ss += (v[j].x * v[j].x + v[j].y * v[j].y) + (v[j].z * v[j].z + v[j].w * v[j].w);
    const float rstd = rsqrtf(wave_sum(ss) * (1.0f / D) + EPS);
#pragma unroll
    for (int j = 0; j < 8; ++j) { const int col = 8 * (lane + 64 * j);
        const f32x4 o0 = v[2 * j] * rstd * ld4(nw + col) * (ld4(sc + col) + 1.0f) + ld4(sh + col), o1 = v[2 * j + 1] * rstd * ld4(nw + col + 4) * (ld4(sc + col + 4) + 1.0f) + ld4(sh + col + 4);
        v4u pk; pk.x = pk2(o0.x, o0.y); pk.y = pk2(o0.z, o0.w); pk.z = pk2(o1.x, o1.y); pk.w = pk2(o1.z, o1.w);
        *(v4u*)(orow + col) = pk; }
}
__device__ __forceinline__ void p1_rows(Frame& F) {
    LAS float* modL = (LAS float*)(F.lds + RING_OFF);
    const int bx = (int)blockIdx.x, b = bx >> 6;
    f32x4 va[16]; row_load(F.x + (size_t)(64 * bx + F.wave) * D, va, F.lane);
    for (int i4 = F.tid; i4 < 2 * D / 4; i4 += NWAVES * 64) { const int i = 4 * i4;
        f32x4 p0[ADA_KS], p1[ADA_KS];
#pragma unroll
        for (int sp = 0; sp < ADA_KS; ++sp) { p0[sp] = *(const f32x4*)(F.part + (size_t)(sp * 5 + b) * NMODC + i); p1[sp] = *(const f32x4*)(F.part + (size_t)(sp * 5 + 4) * NMODC + i); }
        f32x4 s0 = *(const f32x4*)(F.b_ada + i), s1 = s0;
#pragma unroll
        for (int sp = 0; sp < ADA_KS; ++sp) { s0 += p0[sp]; s1 += p1[sp]; }
        *(LAS f32x4*)(modL + i) = s0; *(LAS f32x4*)(modL + 2 * D + i) = s1; }
    if (F.tid < 120) { const int idx = bx * 480 + 4 * F.tid, r = idx / NMODC, j = idx % NMODC;
        f32x4 p0[ADA_KS];
#pragma unroll
        for (int sp = 0; sp < ADA_KS; ++sp) p0[sp] = *(const f32x4*)(F.part + (size_t)(sp * 5 + r) * NMODC + j);
        f32x4 s = *(const f32x4*)(F.b_ada + j);
#pragma unroll
        for (int sp = 0; sp < ADA_KS; ++sp) s += p0[sp];
        *(f32x4*)(F.modf + idx) = s; }
    __syncthreads();
    f32x4 vb[16];
#pragma unroll 1
    for (int i = 0; i < 8; i += 2) {
        const int r0 = 64 * bx + F.wave + 8 * i, r1 = r0 + 8;
        row_load(F.x + (size_t)r1 * D, vb, F.lane);
        row_finish<const LAS float*>(va, F.norm1_w, modL, modL + D, F.A1 + (size_t)r0 * D, F.lane);
        if (i + 2 < 8) row_load(F.x + (size_t)(r1 + 8) * D, va, F.lane); else if (F.wave < 4) row_load(F.ctx + (size_t)(4 * bx + F.wave) * D, va, F.lane);
        row_finish<const LAS float*>(vb, F.norm1_w, modL, modL + D, F.A1 + (size_t)r1 * D, F.lane);
    }
    if (F.wave < 4) row_finish<const LAS float*>(va, F.norm1_w, modL + 2 * D, modL + 3 * D, F.A1 + (size_t)(M + 4 * bx + F.wave) * D, F.lane);
}
__device__ __forceinline__ void p2_cbias(Frame& F) {
    const int b = F.wave & 3, n0 = 2 * (F.vc - 64) + (F.wave >> 2);
    constexpr int NS = 384, NR = (DFF + NS - 1) / NS;
    float sh[64];
    const float* sp = F.modf + (size_t)b * NMODC + 3 * D + 8 * F.lane;
#pragma unroll
    for (int i = 0; i < 8; ++i) { const f32x4 a0 = *(const f32x4*)(sp + 512 * i), a1 = *(const f32x4*)(sp + 512 * i + 4);
        sh[8 * i] = a0.x; sh[8 * i + 1] = a0.y; sh[8 * i + 2] = a0.z; sh[8 * i + 3] = a0.w; sh[8 * i + 4] = a1.x; sh[8 * i + 5] = a1.y; sh[8 * i + 6] = a1.z; sh[8 * i + 7] = a1.w; }
    const v4u* wp = (const v4u*)(F.Wt_ff1 + (size_t)n0 * LDK) + F.lane;
    v4u wa[8], wb[8];
#pragma unroll
    for (int i = 0; i < 8; ++i) wa[i] = wp[64 * i];
#define CB_ROW(WV, n) { float s = 0.f; _Pragma("unroll") for (int i = 0; i < 8; ++i) { const v4u q_ = WV[i]; \
        s += (bf_lo(q_.x) * sh[8 * i] + bf_hi(q_.x) * sh[8 * i + 1]) + (bf_lo(q_.y) * sh[8 * i + 2] + bf_hi(q_.y) * sh[8 * i + 3]) \
           + (bf_lo(q_.z) * sh[8 * i + 4] + bf_hi(q_.z) * sh[8 * i + 5]) + (bf_lo(q_.w) * sh[8 * i + 6] + bf_hi(q_.w) * sh[8 * i + 7]); } \
        s = wave_sum(s); if (F.lane == 0) F.cbias[(size_t)b * DFF + (n)] = s; }
    for (int r = 0; r < NR; r += 2) {
        const bool h1 = n0 + NS * (r + 1) < DFF, h2 = n0 + NS * (r + 2) < DFF;
        if (h1) { const v4u* wq = wp + (size_t)(r + 1) * NS * (LDK / 8);
#pragma unroll
            for (int i = 0; i < 8; ++i) wb[i] = wq[64 * i]; }
        if (n0 + NS * r < DFF) CB_ROW(wa, n0 + NS * r)
        if (h2) { const v4u* wr2 = wp + (size_t)(r + 2) * NS * (LDK / 8);
#pragma unroll
            for (int i = 0; i < 8; ++i) wa[i] = wr2[64 * i]; }
        if (h1) CB_ROW(wb, n0 + NS * (r + 1))
    }
#undef CB_ROW
}
__device__ __forceinline__ void fill_tab_outproj(Frame& F, int pm, int cc) {
    LAS float* tab = (LAS float*)(F.lds + ROWTAB_OFF); LAS float* ct = (LAS float*)(F.lds + COLTAB_OFF);
    if (F.tid < 256) { const int m = pm * 256 + F.tid; float sa = 0.f, sg = 0.f;
#pragma unroll
        for (int i = 0; i < 4; ++i) { const f32x4 t = *(const f32x4*)(F.ssna + (size_t)m * 16 + 4 * i); sa += (t.x + t.y) + (t.z + t.w); }
        { const f32x4 t = *(const f32x4*)(F.sssg + (size_t)m * 4); sg = (t.x + t.y) + (t.z + t.w); }
        const float rna = rsqrtf(sa * (1.0f / DNA) + EPS), rsg = rsqrtf(sg * (1.0f / DSGU) + EPS);
        tab[F.tid] = rna / rsg; tab[256 + F.tid] = rsg; }
    const float* mf = F.modf + (size_t)(pm >> 4) * NMODC;
    for (int i = F.tid; i < 1024; i += NWAVES * 64) { const int col = (4 * (i >> 8) + cc) * 256 + (i & 255);
        ct[i] = mf[2 * D + col]; ct[1024 + i] = F.norm2_w[col] * (1.0f + mf[4 * D + col]); }
    __syncthreads();
}
__device__ __forceinline__ void fill_tab_ff1(Frame& F, int pm, int cc) {
    LAS float* tab = (LAS float*)(F.lds + ROWTAB_OFF); LAS float* ct = (LAS float*)(F.lds + COLTAB_OFF);
    if (F.tid < 256) { const int m = pm * 256 + F.tid; float s = 0.f;
#pragma unroll
        for (int i = 0; i < 16; ++i) { const f32x4 t = *(const f32x4*)(F.pss + (size_t)m * 64 + 4 * i); s += (t.x + t.y) + (t.z + t.w); }
        tab[F.tid] = rsqrtf(s * (1.0f / D) + EPS); }
    const float* cbp = F.cbias + (size_t)(pm >> 4) * DFF;
    for (int i = F.tid; i < 4096; i += NWAVES * 64) ct[i] = cbp[(4 * (i >> 8) + cc) * 256 + (i & 255)];
    __syncthreads();
}
template <class Sched> __device__ __forceinline__ void fill_tab_ff2(Frame& F, const Sched& S) {
    LAS float* ct = (LAS float*)(F.lds + COLTAB_OFF);
    for (int i = 0; i < 4; ++i) { pg8::Unit u; if (!S.next(i, u)) break;
        const float* mf = F.modf + (size_t)(u.pm >> 4) * NMODC + 5 * D + u.pn * 256;
        for (int j = F.tid; j < 256; j += NWAVES * 64) ct[i * 256 + j] = mf[j]; }
    __syncthreads();
}
__device__ __forceinline__ void p9_final(Frame& F) {
    const int gw = (int)blockIdx.x * NWAVES + F.wave, NGW = F.G * NWAVES;
    for (int m = gw; m < M; m += NGW) {
        const v4u* xr = (const v4u*)(F.XB + (size_t)m * D) + F.lane;
        v4u v[8]; float ss = 0.f;
#pragma unroll
        for (int j = 0; j < 8; ++j) { v[j] = xr[64 * j];
            const float a0 = bf_lo(v[j].x), a1 = bf_hi(v[j].x), a2 = bf_lo(v[j].y), a3 = bf_hi(v[j].y), a4 = bf_lo(v[j].z), a5 = bf_hi(v[j].z), a6 = bf_lo(v[j].w), a7 = bf_hi(v[j].w);
            ss += ((a0 * a0 + a1 * a1) + (a2 * a2 + a3 * a3)) + ((a4 * a4 + a5 * a5) + (a6 * a6 + a7 * a7)); }
        const float rstd = rsqrtf(wave_sum(ss) * (1.0f / D) + EPS);
        float* orow = F.out + (size_t)m * D;
#pragma unroll
        for (int j = 0; j < 8; ++j) { const int col = 8 * (F.lane + 64 * j);
            const f32x4 w0 = ld4(F.fnw + col), w1 = ld4(F.fnw + col + 4);
            *(f32x4*)(orow + col) = (f32x4){bf_lo(v[j].x), bf_hi(v[j].x), bf_lo(v[j].y), bf_hi(v[j].y)} * rstd * w0;
            *(f32x4*)(orow + col + 4) = (f32x4){bf_lo(v[j].z), bf_hi(v[j].z), bf_lo(v[j].w), bf_hi(v[j].w)} * rstd * w1; }
    }
}
__device__ __forceinline__ float xrow16_max(float x) {
    auto s = __builtin_amdgcn_permlane16_swap(__float_as_uint(x), __float_as_uint(x), false, false);
    x = fmaxf(__uint_as_float(s[0]), __uint_as_float(s[1]));
    auto t = __builtin_amdgcn_permlane32_swap(__float_as_uint(x), __float_as_uint(x), false, false);
    return fmaxf(__uint_as_float(t[0]), __uint_as_float(t[1]));
}
__device__ __forceinline__ float xrow16_sum(float x) {
    auto s = __builtin_amdgcn_permlane16_swap(__float_as_uint(x), __float_as_uint(x), false, false);
    x = __uint_as_float(s[0]) + __uint_as_float(s[1]);
    auto t = __builtin_amdgcn_permlane32_swap(__float_as_uint(x), __float_as_uint(x), false, false);
    return __uint_as_float(t[0]) + __uint_as_float(t[1]);
}
__device__ __forceinline__ void glds16(const void* gsrc, unsigned lds_dst) { unsigned keep;
    asm volatile("s_mov_b32 %0, m0\n\ts_mov_b32 m0, %2\n\ts_nop 0\n\tglobal_load_lds_dwordx4 %1, off\n\ts_mov_b32 m0, %0" : "=&s"(keep) : "v"(gsrc), "s"(lds_dst) : "memory"); }
constexpr int SG_BUF = 65536, SG_NW_OFF = 2 * SG_BUF, SG_RG_OFF = SG_NW_OFF + 8192;
static_assert(SG_RG_OFF + 512 <= LDSCTL_OFF, "SGU LDS image below the control words");
__device__ __forceinline__ void sgu_stage(Frame& F, int tok0, int cq, int buf) {
    const int w = F.wave, L = F.lane;
    const unsigned base = (unsigned)(size_t)(F.lds + buf * SG_BUF);
#pragma unroll
    for (int i = 0; i < 4; ++i) { const int p = w + 8 * i, row = 4 * p + (L >> 4), c = (L & 15) ^ (row & 15);
        glds16(F.GT + (size_t)(cq + row) * M + tok0 + c * 8, (unsigned)__builtin_amdgcn_readfirstlane((int)(base + p * 1024))); }
#pragma unroll
    for (int i = 0; i < 4; ++i) { const int p = w + 8 * i, row = 4 * p + (L >> 4), c = (L & 15) ^ (row & 15);
        glds16(F.UB + (size_t)(tok0 + row) * DSGU + cq + c * 8, (unsigned)__builtin_amdgcn_readfirstlane((int)(base + 32768 + p * 1024))); }
}
__device__ __forceinline__ void sgu_wg(Frame& F, const int u0, const int ustride, const int nun) {
    const int lane = F.lane, w = F.wave, l15 = lane & 15, g = lane >> 4;
    LAS float* nwl = (LAS float*)(F.lds + SG_NW_OFF); LAS float* rgs = (LAS float*)(F.lds + SG_RG_OFF);
    for (int i = F.tid; i < DSGU / 4; i += NWAVES * 64) *(LAS f32x4*)(nwl + 4 * i) = *(const f32x4*)(F.sgu_norm_w + 4 * i);
    bf16x8 wf[4]; float bias = 0.f, ssq = 0.f; int tok0 = 0, grp = 0;
    const int nq = 4 * nun;
    sgu_stage(F, (u0 >> 7) * SEQ + ((u0 >> 2) & 31) * 128, (u0 & 3) * 512, 0);
    for (int k = 0; k < nq; ++k) {
        const int uid = u0 + ustride * (k >> 2), qq = k & 3;
        if (qq == 0) {
            tok0 = (uid >> 7) * SEQ + ((uid >> 2) & 31) * 128; grp = uid & 3; ssq = 0.f;
            __syncthreads();
            if (F.tid < 128) { const float* sp = F.ssgp + (size_t)(tok0 + F.tid) * 16; float s = 0.f;
#pragma unroll
                for (int i = 0; i < 4; ++i) { const f32x4 t = *(const f32x4*)(sp + 4 * i); s += (t.x + t.y) + (t.z + t.w); }
                rgs[F.tid] = rsqrtf(s * (1.0f / DSGU) + EPS); }
            __syncthreads();
            const int p = 16 * w + l15;
#pragma unroll
            for (int ks = 0; ks < 4; ++ks) { const int q0 = ks * 32 + 8 * g; const float* wp = F.sgu_w + (size_t)(grp * 128 + p) * 128 + q0;
                const f32x4 w0 = *(const f32x4*)wp, w1 = *(const f32x4*)(wp + 4); const f32x4 r0 = *(const LAS f32x4*)(rgs + q0), r1 = *(const LAS f32x4*)(rgs + q0 + 4);
                v4u pk; pk.x = pk2(w0.x * r0.x, w0.y * r0.y); pk.y = pk2(w0.z * r0.z, w0.w * r0.w); pk.z = pk2(w1.x * r1.x, w1.y * r1.y); pk.w = pk2(w1.z * r1.z, w1.w * r1.w);
                wf[ks] = __builtin_bit_cast(bf16x8, pk); }
            bias = F.sgu_b[grp * 128 + p];
            asm volatile("" :: "v"(wf[0]), "v"(wf[1]), "v"(wf[2]), "v"(wf[3]), "v"(bias));
        }
        asm volatile("s_waitcnt vmcnt(0)" ::: "memory"); __builtin_amdgcn_s_barrier(); asm volatile("" ::: "memory");
        if (k + 1 < nq) { const int un = u0 + ustride * ((k + 1) >> 2); sgu_stage(F, (un >> 7) * SEQ + ((un >> 2) & 31) * 128, (un & 3) * 512 + ((k + 1) & 3) * 128, (k + 1) & 1); }
        const LAS unsigned char* gb = F.lds + (k & 1) * SG_BUF; LAS unsigned char* ub = F.lds + (k & 1) * SG_BUF + 32768;
        const int p = 16 * w + l15;
#pragma unroll 2
        for (int ct = 0; ct < 8; ++ct) {
            f32x4 d = (f32x4){0.f, 0.f, 0.f, 0.f};
            const LAS unsigned char* gr = gb + (16 * ct + l15) * 256;
#pragma unroll
            for (int ks = 0; ks < 4; ++ks) { const bf16x8 gf = *(const LAS bf16x8*)(gr + (((4 * ks + g) ^ l15) << 4)); d = __builtin_amdgcn_mfma_f32_16x16x32_bf16(gf, wf[ks], d, 0, 0, 0); }
            LAS unsigned char* ua = ub + p * 256 + (((2 * ct + (g >> 1)) ^ l15) << 4) + ((g & 1) << 3);
            const v2u uu = *(const LAS v2u*)ua;
            const f32x4 nw = *(const LAS f32x4*)(nwl + grp * 512 + qq * 128 + 16 * ct + 4 * g);
            const float o0 = bf_lo(uu.x) * (nw.x * d[0] + bias), o1 = bf_hi(uu.x) * (nw.y * d[1] + bias), o2 = bf_lo(uu.y) * (nw.z * d[2] + bias), o3 = bf_hi(uu.y) * (nw.w * d[3] + bias);
            ssq += (o0 * o0 + o1 * o1) + (o2 * o2 + o3 * o3);
            v2u pk; pk.x = pk2(o0, o1); pk.y = pk2(o2, o3);
            *(LAS v2u*)ua = pk;
        }
        asm volatile("s_waitcnt lgkmcnt(0)" ::: "memory"); __builtin_amdgcn_s_barrier(); asm volatile("" ::: "memory");
        {
            bf16* ob = F.A2 + (size_t)tok0 * D + DNA + grp * 512 + qq * 128;
#pragma unroll
            for (int i = 0; i < 4; ++i) { const int id = F.tid + 512 * i, row = id >> 4, slot = id & 15, c = slot ^ (row & 15);
                const v4u v = *(const LAS v4u*)(ub + row * 256 + (slot << 4));
                *(v4u*)(ob + (size_t)row * D + c * 8) = v; }
        }
        if (qq == 3) { const float s = xrow16_sum(ssq); if (g == 0) F.sssg[(size_t)(tok0 + 16 * w + l15) * 4 + grp] = s; }
    }
    __syncthreads();
}
constexpr int AT_TILE = 32768;
constexpr int AT_NBUF = 4;
constexpr int RPB_OFF = AT_NBUF * AT_TILE + 64, ATT_LDS_END = RPB_OFF + 15 * 31 * 4 + 256;
static_assert(ATT_LDS_END <= LDSCTL_OFF, "attention LDS image below the control words");
__device__ __forceinline__ void attn_scores(const bf16x8 (&k)[2][4], const bf16x8 (&qf)[4], f32x4 (&s)[2]) {
#pragma unroll
    for (int tt = 0; tt < 2; ++tt) { s[tt] = (f32x4){0.f, 0.f, 0.f, 0.f};
#pragma unroll
        for (int ds = 0; ds < 4; ++ds) s[tt] = __builtin_amdgcn_mfma_f32_16x16x32_bf16(k[tt][ds], qf[ds], s[tt], 0, 0, 0); }
}
template <bool WIN> __device__ __forceinline__ bf16x8 attn_softmax(f32x4 (&s)[2], const LAS float* bp, int lo, f32x4 (&o)[8], float& mrun, float& lrun) {
    if (WIN) {
        float bv[8];
#pragma unroll
        for (int i = 0; i < 8; ++i) bv[i] = bp[i];
        asm volatile("" : "+v"(bv[0]), "+v"(bv[1]), "+v"(bv[2]), "+v"(bv[3]), "+v"(bv[4]), "+v"(bv[5]), "+v"(bv[6]), "+v"(bv[7]));
#pragma unroll
        for (int i = 0; i < 8; ++i) { const bool valid = (unsigned)(i - lo) < 16u; s[i >> 2][i & 3] = valid ? s[i >> 2][i & 3] + bv[i] : -1e30f; }
    }
    float mx = fmaxf(fmaxf(fmaxf(s[0][0], s[0][1]), fmaxf(s[0][2], s[0][3])), fmaxf(fmaxf(s[1][0], s[1][1]), fmaxf(s[1][2], s[1][3])));
    mx = xrow16_max(mx);
    if (__builtin_amdgcn_ballot_w64(mx > mrun + 8.0f)) {
        const float mn = fmaxf(mrun, mx), alpha = __builtin_amdgcn_exp2f(mrun - mn); mrun = mn; lrun *= alpha;
#pragma unroll
        for (int dt = 0; dt < 8; ++dt) o[dt] *= alpha;
    }
    float ps = 0.f;
#pragma unroll
    for (int tt = 0; tt < 2; ++tt)
#pragma unroll
        for (int rg = 0; rg < 4; ++rg) { s[tt][rg] = __builtin_amdgcn_exp2f(s[tt][rg] - mrun); ps += s[tt][rg]; }
    lrun += ps;
    v4u pk; pk.x = pk2(s[0][0], s[0][1]); pk.y = pk2(s[0][2], s[0][3]); pk.z = pk2(s[1][0], s[1][1]); pk.w = pk2(s[1][2], s[1][3]);
    return __builtin_bit_cast(bf16x8, pk);
}
__device__ __forceinline__ void attn_pv(const bf16x8 (&v)[8], bf16x8 pf, f32x4 (&o)[8]) {
#pragma unroll
    for (int dt = 0; dt < 8; ++dt) o[dt] = __builtin_amdgcn_mfma_f32_16x16x32_bf16(v[dt], pf, o[dt], 0, 0, 0);
}
__device__ __forceinline__ void glds16s(const void* sbase, unsigned voff, unsigned lds_dst) { unsigned keep;
    asm volatile("s_mov_b32 %0, m0\n\ts_mov_b32 m0, %3\n\ts_nop 0\n\tglobal_load_lds_dwordx4 %1, %2\n\ts_mov_b32 m0, %0" : "=&s"(keep) : "v"(voff), "s"(sbase), "s"(lds_dst) : "memory"); }
__device__ __forceinline__ const void* uniform_ptr(const void* p) { const unsigned long long a = (unsigned long long)p;
    return (const void*)(((unsigned long long)(unsigned)__builtin_amdgcn_readfirstlane((int)(a >> 32)) << 32) | (unsigned)__builtin_amdgcn_readfirstlane((int)a)); }
struct AttnDma { unsigned ko[2], vo[2]; };
__device__ __forceinline__ void attn_dma_init(AttnDma& d, int w, int L) {
#pragma unroll
    for (int i = 0; i < 2; ++i) { const int p = w + 8 * i, row = 4 * p + (L >> 4), f = (row & 3) | (((row >> 3) & 3) << 2), c = (L & 15) ^ f; d.ko[i] = (unsigned)(row * DNA * 2 + c * 16); }
#pragma unroll
    for (int i = 0; i < 2; ++i) { const int p = w + 8 * i, row = 8 * p + (L >> 3), c = (L & 7) ^ ((row >> 1) & 7); d.vo[i] = (unsigned)(row * MA * 2 + c * 16); }
}
__device__ __forceinline__ void attn_stage(Frame& F, const AttnDma& d, int h, int T, int buf) {
    const int w = F.wave;
    const unsigned base = (unsigned)(size_t)(F.lds + buf * AT_TILE);
    const void* kb = uniform_ptr(F.KB + (size_t)T * DNA + h * HD); const void* vb = uniform_ptr(F.VT + (size_t)(h * HD) * MA + T);
#pragma unroll
    for (int i = 0; i < 2; ++i) glds16s(kb, d.ko[i], (unsigned)__builtin_amdgcn_readfirstlane((int)(base + (w + 8 * i) * 1024)));
#pragma unroll
    for (int i = 0; i < 2; ++i) glds16s(vb, d.vo[i], (unsigned)__builtin_amdgcn_readfirstlane((int)(base + 16384 + (w + 8 * i) * 1024)));
}
__device__ __forceinline__ void attn_kfrags(const LAS unsigned char* tile, int kb0, int q, int g, bf16x8 (&k)[2][4]) {
    const int a = q >> 2, cc = q & 3, fh = ((kb0 >> 3) + a) & 3;
    const LAS unsigned char* kr = tile + (kb0 + 8 * a + cc) * 256 + ((g ^ cc) << 4);
#pragma unroll
    for (int ds = 0; ds < 4; ++ds) { const int off = (ds ^ fh) << 6;
#pragma unroll
        for (int tt = 0; tt < 2; ++tt) k[tt][ds] = *(const LAS bf16x8*)(kr + tt * 1024 + off); }
}
__device__ __forceinline__ void attn_vfrags(const LAS unsigned char* tile, int kb0, int q, int g, bf16x8 (&v)[8]) {
    const int pc = ((kb0 >> 3) + g) ^ ((q >> 1) & 7);
    const LAS unsigned char* vr = tile + 16384 + q * 128 + (pc << 4);
#pragma unroll
    for (int dt = 0; dt < 8; ++dt) v[dt] = *(const LAS bf16x8*)(vr + dt * 2048);
}
template <bool A, bool B> __device__ __forceinline__ void attn_pv2(const LAS unsigned char* tile, int kb0, int q, int g, bf16x8 pfA, bf16x8 pfB, f32x4 (&oA)[8], f32x4 (&oB)[8]) {
    const int pc = ((kb0 >> 3) + g) ^ ((q >> 1) & 7);
    const LAS unsigned char* vr = tile + 16384 + q * 128 + (pc << 4);
#pragma unroll
    for (int hf = 0; hf < 2; ++hf) {
        bf16x8 v[4];
#pragma unroll
        for (int i = 0; i < 4; ++i) v[i] = *(const LAS bf16x8*)(vr + (4 * hf + i) * 2048);
#pragma unroll
        for (int i = 0; i < 4; ++i) { if (A) oA[4 * hf + i] = __builtin_amdgcn_mfma_f32_16x16x32_bf16(v[i], pfA, oA[4 * hf + i], 0, 0, 0);
                                      if (B) oB[4 * hf + i] = __builtin_amdgcn_mfma_f32_16x16x32_bf16(v[i], pfB, oB[4 * hf + i], 0, 0, 0); }
        __builtin_amdgcn_sched_barrier(0);
    }
}
#define ATT_KEEP2(pa, pb) asm volatile("s_nop 7" :: "v"(pa), "v"(pb))
#define ATT_KEEP1(pa) asm volatile("s_nop 7" :: "v"(pa))
__device__ __forceinline__ void attn_finish(Frame& F, f32x4 (&o)[8], float lrun, int qtok, int h, int g) {
    const float inv = 1.0f / xrow16_sum(lrun); float ssq = 0.f;
    bf16* op = F.A2 + (size_t)qtok * D + h * HD + 4 * g;
#pragma unroll
    for (int dt = 0; dt < 8; ++dt) { const f32x4 v = o[dt] * inv; ssq += (v.x * v.x + v.y * v.y) + (v.z * v.z + v.w * v.w);
        v2u pk; pk.x = pk2(v.x, v.y); pk.y = pk2(v.z, v.w); *(v2u*)(op + dt * 16) = pk; }
    ssq = xrow16_sum(ssq);
    if (g == 0) F.ssna[(size_t)qtok * 16 + h] = ssq;
}
__device__ __forceinline__ void attn_wg(Frame& F) {
    const int lane = F.lane, q = lane & 15, g = lane >> 4, w = F.wave, j = w & 3;
    const int xcd = F.vc & 7, li = F.vc >> 3, R = 2 * li, r = R + (w >> 2);
    const int qcol = 16 * j + q;
    int r0 = r - 4; r0 = r0 < 0 ? 0 : (r0 > 56 ? 56 : r0);
    int krlo = R - 4; krlo = krlo < 0 ? 0 : (krlo > 56 ? 56 : krlo);
    int krhi = R - 3; krhi = (krhi < 0 ? 0 : (krhi > 56 ? 56 : krhi)) + 7;
    const int nwin = krhi - krlo + 1, nst = nwin + 4, NT = 8 * nst;
    int cs = qcol - 8; cs = cs < 0 ? 0 : (cs > 48 ? 48 : cs);
    const int band0 = (j == 0) ? 0 : (j == 1 ? 8 : (j == 2 ? 24 : 32));
    const int lo = cs - (band0 + 8 * g);
    const LAS float* rpb = (const LAS float*)(F.lds + RPB_OFF) + (band0 + 8 * g - qcol + 15);
    AttnDma dma; attn_dma_init(dma, w, lane);
    int sg_s = 0, sg_bh = xcd * 8;
#define ATT_STAGE_NEXT(slot) do { const int b_ = sg_bh >> 4, h_ = sg_bh & 15; \
        attn_stage(F, dma, h_, (sg_s < nwin) ? b_ * SEQ + (krlo + sg_s) * GW : M + b_ * CTX + 64 * (sg_s - nwin), (slot)); \
        if (++sg_s == nst) { sg_s = 0; ++sg_bh; } } while (0)
    ATT_STAGE_NEXT(0); ATT_STAGE_NEXT(1); ATT_STAGE_NEXT(2);
    bf16x8 qf[4]; f32x4 o[8]; float mrun = -1e30f, lrun = 0.f; int s = 0, bh = xcd * 8, qtok = 0;
#pragma unroll
    for (int ds = 0; ds < 4; ++ds) qf[ds] = (bf16x8){0, 0, 0, 0, 0, 0, 0, 0};
#pragma unroll
    for (int dt = 0; dt < 8; ++dt) o[dt] = (f32x4){0.f, 0.f, 0.f, 0.f};
    for (int t = 0; t < NT; ++t) {
        const int b = bh >> 4, h = bh & 15;
        if (s == 0) {
            for (int i = F.tid; i < 15 * 31; i += NWAVES * 64) ((LAS float*)(F.lds + RPB_OFF))[i] = F.rpb[h * 15 * 31 + i] * LOG2E;
            qtok = b * SEQ + r * GW + qcol;
#pragma unroll
            for (int ds = 0; ds < 4; ++ds) qf[ds] = *(const bf16x8*)(F.QB + (size_t)qtok * DNA + h * HD + ds * 32 + 8 * g);
#pragma unroll
            for (int dt = 0; dt < 8; ++dt) o[dt] = (f32x4){0.f, 0.f, 0.f, 0.f};
            mrun = -1e30f; lrun = 0.f;
            asm volatile("s_waitcnt lgkmcnt(0)" :: "v"(qf[0]), "v"(qf[1]), "v"(qf[2]), "v"(qf[3]) : "memory");
        }
        if (t + 2 < NT) asm volatile("s_waitcnt vmcnt(8)" ::: "memory"); else if (t + 1 < NT) asm volatile("s_waitcnt vmcnt(4)" ::: "memory"); else asm volatile("s_waitcnt vmcnt(0)" ::: "memory");
        __builtin_amdgcn_s_barrier(); asm volatile("" ::: "memory");
        if (t + 3 < NT) ATT_STAGE_NEXT((t + 3) & (AT_NBUF - 1));
        const LAS unsigned char* tile = F.lds + (t & (AT_NBUF - 1)) * AT_TILE;
        if (s < nwin) {
            const int kr = krlo + s;
            if ((kr >= r0) && (kr < r0 + 8)) {
                bf16x8 kf[2][4], vf[8]; f32x4 sc[2];
                attn_kfrags(tile, band0, q, g, kf); attn_vfrags(tile, band0, q, g, vf);
                attn_scores(kf, qf, sc);
                bf16x8 pf = attn_softmax<true>(sc, rpb + (kr - r + 7) * 31, lo, o, mrun, lrun);
                attn_pv(vf, pf, o); ATT_KEEP1(pf);
            }
        } else {
#pragma unroll
            for (int hh = 0; hh < 2; ++hh) {
                bf16x8 kf[2][4], vf[8]; f32x4 sc[2];
                attn_kfrags(tile, 32 * hh, q, g, kf); attn_vfrags(tile, 32 * hh, q, g, vf);
                attn_scores(kf, qf, sc);
                bf16x8 pf = attn_softmax<false>(sc, nullptr, 0, o, mrun, lrun);
                attn_pv(vf, pf, o); ATT_KEEP1(pf);
            }
        }
        if (++s == nst) { attn_finish(F, o, lrun, qtok, h, g); s = 0; ++bh; }
    }
#undef ATT_STAGE_NEXT
    __builtin_amdgcn_s_barrier(); asm volatile("" ::: "memory");
}
__device__ __forceinline__ void p3_mixers(Frame& F) {
    __syncthreads();
    DBG_BEGIN(ts_);
    DBG_END(F, 10, ts_); DBG_BEGIN(ta_);
    for (int rep = 0; rep < REPS(32); ++rep) attn_wg(F);
    DBG_END(F, 11, ta_);
}
struct Args { const float* in[19]; float* out; unsigned char* ws; int ph_lo, ph_hi; };
__global__ void __launch_bounds__(NWAVES * 64, 2) mk_fwd(Args args) {
    extern __shared__ __attribute__((aligned(16))) unsigned char lds[];
    Frame F;
    F.lds = (LAS unsigned char*)lds;
    F.MISC = (volatile LAS unsigned*)(F.lds + MISC_OFF);
    F.tid = threadIdx.x; F.lane = F.tid & 63; F.wave = __builtin_amdgcn_readfirstlane(F.tid >> 6);
    F.G = gridDim.x;
    unsigned char* ws = args.ws;
    F.ctl = (gu32*)(ws + WS_CTL);
    F.x = args.in[0]; F.c = args.in[1]; F.ctx = args.in[2]; F.cctx = args.in[3]; F.w_ada = args.in[4]; F.b_ada = args.in[5]; F.norm1_w = args.in[6]; F.w_in = args.in[7]; F.rpb = args.in[8];
    F.sgu_norm_w = args.in[9]; F.sgu_w = args.in[10]; F.sgu_b = args.in[11]; F.gna = args.in[12]; F.gsgu = args.in[13]; F.w_out = args.in[14]; F.norm2_w = args.in[15];
    F.w_ff1 = args.in[16]; F.w_ff2 = args.in[17]; F.fnw = args.in[18]; F.out = args.out;
    F.modf = (float*)(ws + WS_MODF); F.part = (float*)(ws + WS_PART); F.ssna = (float*)(ws + WS_SSNA); F.sssg = (float*)(ws + WS_SSSG); F.cbias = (float*)(ws + WS_CBIAS); F.pss = (float*)(ws + WS_PSS); F.ssgp = (float*)(ws + WS_SSGP);
    F.Wt_in = (bf16*)(ws + WS_WIN); F.Wt_out = (bf16*)(ws + WS_WOUT); F.Wt_ff1 = (bf16*)(ws + WS_WFF1); F.Wt_ff2 = (bf16*)(ws + WS_WFF2);
    F.A1 = (bf16*)(ws + WS_A1); F.QB = (bf16*)(ws + WS_Q); F.KB = (bf16*)(ws + WS_K); F.VT = (bf16*)(ws + WS_VT); F.UB = (bf16*)(ws + WS_U); F.GT = (bf16*)(ws + WS_GT);
    F.A2 = (bf16*)(ws + WS_A2); F.HB = (bf16*)(ws + WS_H); F.XB = (bf16*)(ws + WS_XB);
    for (int u = F.tid; u < (LDS_BYTES - LDSCTL_OFF) / 4; u += NWAVES * 64) ((LAS unsigned*)(F.lds + LDSCTL_OFF))[u] = 0u;
    __syncthreads();
    XcdBarrier bar; bar.bar = (unsigned*)(F.ctl + CW_BAR); bar.x = 0; bar.st = nullptr;
    F.vc = (int)blockIdx.x;
    if (MK_N_LAUNCHES == 1) {
        bar.x = xb_xcc_id(); bar.st = F.MISC + 8;
        if (F.tid == 0) F.MISC[12] = xb_add(&bar.bar[XB_XCNT(bar.x)], 1u);
    }
    const int lo = args.ph_lo, hi = args.ph_hi;
#define IN(k) (lo <= (k) && (k) < hi)
#define SEAM(k) do { if (IN(k) && IN((k) + 1)) { DBG_BEGIN(tb_); xcd_barrier(bar); DBG_END(F, 16 + (k), tb_); } } while (0)

    DBG_BEGIN(tp_);
    if (IN(0)) { for (int rep = 0; rep < REPS(0); ++rep) p0_prologue(F); } DBG_END(F, 0, tp_); SEAM(0);
    if (MK_N_LAUNCHES == 1) {
        if (F.tid == 0) { bool ok = (F.G == 256) && (bar.x < 8u);
            for (unsigned jx = 0; jx < 16; ++jx) { const unsigned cnt = xb_ld(&bar.bar[XB_XCNT(jx)]); ok = ok && (cnt == (jx < 8 ? 32u : 0u)); }
            F.MISC[13] = ok ? (bar.x + 8u * F.MISC[12]) : (unsigned)blockIdx.x; }
        __syncthreads();
        F.vc = (int)F.MISC[13];
    }
    DBG_MARK(tp_); if (IN(1)) { p1_rows(F); } DBG_END(F, 1, tp_); SEAM(1);
    DBG_MARK(tp_);
    if (IN(2)) {
        pg8::Gemm g{F.A1, F.Wt_in, MA, DIN, D, D}; pg8::InProjOrder S; S.G = F.G; S.c = F.vc; S.i0 = 0; S.n = 10;
        pg8::EpiInProj E{F.QB, WS_SLOT / 2, 0.08838834764831845f * LOG2E, F.ssgp};
        for (int pass = 0; pass < 2; ++pass) {
            if (pass == 1) { if (F.vc >= 64) break; S.i0 = 10; S.n = 1; }
            pg8::gemm_phase<pg8::EpiInProj, pg8::InProjOrder, true, true>(F.lds + RING_OFF, g, S, E);
            if (pass == 0) evt_arrive(F, 0);
        }
        if (F.vc >= 64) {
            p2_cbias(F); evt_wait(F, 0);
            const int t = F.vc - 64; sgu_wg(F, t, 192, t < 128 ? 3 : 2);
        }
    } DBG_END(F, 2, tp_); SEAM(2);
    DBG_MARK(tp_);
    if (IN(3)) { for (int rep = 0; rep < REPS(3); ++rep) p3_mixers(F); } DBG_END(F, 3, tp_); SEAM(3);
    DBG_MARK(tp_);
    if (IN(4)) {
        pg8::Gemm g{F.A2, F.Wt_out, M, D, D, D}; pg8::StdOrder S; S.init(M, D, F.G, F.vc);
        pg8::Unit u0; S.next(0, u0); fill_tab_outproj(F, u0.pm, u0.pn & 3);
        pg8::EpiOutProj E{F.x, F.XB, F.A1, LDK, F.pss, (const LAS float*)(F.lds + COLTAB_OFF), (const LAS float*)(F.lds + COLTAB_OFF) + 1024, (const LAS float*)(F.lds + ROWTAB_OFF)};
        pg8::gemm_phase<pg8::EpiOutProj, pg8::StdOrder, true, true>(F.lds + RING_OFF, g, S, E);
    } DBG_END(F, 4, tp_); SEAM(4);
    if (PRE_IDLE_US > 0 && IN(5)) { const unsigned long long ti_ = __builtin_amdgcn_s_memrealtime(); while (__builtin_amdgcn_s_memrealtime() - ti_ < 100ull * PRE_IDLE_US) __builtin_amdgcn_s_sleep(32); }
    DBG_MARK(tp_);
    DBG_CLK_BEGIN(cc5_, cr5_);
    if (IN(5)) for (int rep = 0; rep < REPS(5); ++rep) {
        pg8::Gemm g{F.A1, F.Wt_ff1, M, DFF, D, LDK}; pg8::StdOrder S; S.init(M, DFF, F.G, F.vc);
        pg8::Unit u0; S.next(0, u0); fill_tab_ff1(F, u0.pm, u0.pn & 3);
        pg8::EpiRelu2 E{F.HB, LDF2, (const LAS float*)(F.lds + COLTAB_OFF), (const LAS float*)(F.lds + ROWTAB_OFF)};
        pg8::gemm_phase<pg8::EpiRelu2, pg8::StdOrder, true, true>(F.lds + RING_OFF, g, S, E);
        DBG_CLK_END(F, 13, cc5_, cr5_);
    } DBG_END(F, 5, tp_); SEAM(5);
    DBG_MARK(tp_);
    if (IN(6)) {
        pg8::Gemm g{F.HB, F.Wt_ff2, M, D, DFF, LDF2}; pg8::StdOrder S; S.init(M, D, F.G, F.vc, FF2_WGM);
        fill_tab_ff2(F, S);
        pg8::EpiGatedRes E{F.XB, (const LAS float*)(F.lds + COLTAB_OFF)};
        pg8::gemm_phase<pg8::EpiGatedRes, pg8::StdOrder, true, true>(F.lds + RING_OFF, g, S, E);
    } DBG_END(F, 6, tp_); SEAM(6);
    DBG_MARK(tp_);
    if (IN(7)) { p9_final(F); } DBG_END(F, 7, tp_);
    if (DBG_SLOT >= 0) {
        __syncthreads();
        if (blockIdx.x == 0 && F.tid == 0) { const unsigned long long v = (unsigned long long)__hip_atomic_load((unsigned*)(F.ctl + CW_DBG + 64 * (DBG_SLOT >= 0 ? DBG_SLOT : 0)), RLX_AGENT) * DBG_MULT;
            const unsigned long long t0 = __builtin_amdgcn_s_memrealtime(); while (__builtin_amdgcn_s_memrealtime() - t0 < v) __builtin_amdgcn_s_sleep(8); }
    }
#undef IN
#undef SEAM
}

extern "C" void kernel_launch(void* const* d_in, const int* in_sizes, int n_in, void* d_out, int out_size, void* d_ws, size_t ws_size, hipStream_t stream) {
    static int grid = 0;
    if (grid == 0) {
        if (n_in != 19 || in_sizes[0] != M * D || out_size != M * D || ws_size < WS_END) { fprintf(stderr, "kernel_launch: unexpected shapes / workspace (%zu)\n", ws_size); grid = -1; return; }
        int dev = 0, cus = 0, per_cu = 0;
        if (hipGetDevice(&dev) != hipSuccess || hipDeviceGetAttribute(&cus, hipDeviceAttributeMultiprocessorCount, dev) != hipSuccess) { grid = -1; return; }
        if (hipFuncSetAttribute((const void*)mk_fwd, hipFuncAttributeMaxDynamicSharedMemorySize, LDS_BYTES) != hipSuccess) { grid = -1; return; }
        if (hipOccupancyMaxActiveBlocksPerMultiprocessor(&per_cu, (const void*)mk_fwd, NWAVES * 64, LDS_BYTES) != hipSuccess || per_cu < 1) { fprintf(stderr, "kernel_launch: occupancy query says %d\n", per_cu); }
        (void)hipGetLastError();
        if (cus < 256) { fprintf(stderr, "kernel_launch: needs 256 CUs, device has %d\n", cus); grid = -1; return; }
        grid = 256;
    }
    if (grid < 0) return;
    if (hipMemsetAsync((char*)d_ws + WS_CTL, 0, CTL_ZERO_BYTES, stream) != hipSuccess) return;
    Args a{};
    for (int i = 0; i < 19; ++i) a.in[i] = (const float*)d_in[i];
    a.out = (float*)d_out; a.ws = (unsigned char*)d_ws;
    if (MK_N_LAUNCHES == 1) { a.ph_lo = 0; a.ph_hi = N_PHASES; hipLaunchKernelGGL(mk_fwd, dim3(grid), dim3(NWAVES * 64), LDS_BYTES, stream, a); }
    else for (int p = 0; p < N_PHASES; ++p) { a.ph_lo = p; a.ph_hi = p + 1; hipLaunchKernelGGL(mk_fwd, dim3(grid), dim3(NWAVES * 64), LDS_BYTES, stream, a); }
}
```

```cpp
#include <hip/hip_runtime.h>
#include <cstdio>
#include <cstdint>
namespace pg8 {
#define PG8_LAS __attribute__((address_space(3)))
typedef unsigned short bf16_t;
typedef short bf16x8 __attribute__((ext_vector_type(8)));
typedef float f32x4 __attribute__((ext_vector_type(4)));
typedef unsigned u32x4 __attribute__((ext_vector_type(4)));
constexpr int BM = 256, BK = 64, HALF = 128, HTB = HALF * BK * 2  , STAGE_BYTES = 8 * HTB, NXCD = 8, WGM = 8;

__host__ __device__ __forceinline__ int lds_byte(int r, int c) { const int st = (r >> 4) * 2 + (c >> 5), rr = r & 15, cc = c & 31, ob = rr * 64 + cc * 2; return st * 1024 + (ob ^ (((ob >> 9) & 1) << 5)); }
__host__ __device__ __forceinline__ void stage_rc(int b, int& R, int& C) { const int st = b / 1024, sb = b % 1024, swz = sb ^ (((sb >> 9) & 1) << 5); R = (st >> 1) * 16 + swz / 64; C = (st & 1) * 32 + (swz % 64) / 2; }
__host__ __device__ __forceinline__ int perm32(int rho) { const int n = rho >> 4, i = rho & 15; return 8 * (i >> 2) + 4 * n + (i & 3); }

struct Unit { int pm, pn, ui; };
struct Gemm { const bf16_t* A; const bf16_t* Bt; int M, N, K, ld; };

__device__ __forceinline__ void std_map(int wgid, int nM, int nN, Unit& u, int wgm = WGM) {
    const int nwg = nM * nN;
    { const int q = nwg / NXCD, r = nwg % NXCD, xcd = wgid % NXCD, off = wgid / NXCD; wgid = (xcd < r ? xcd * (q + 1) : r * (q + 1) + (xcd - r) * q) + off; }
    const int nig = wgm * nN, gid = wgid / nig, fm = gid * wgm, gsz = (nM - fm) < wgm ? (nM - fm) : wgm;
    u.pm = fm + ((wgid % nig) % gsz); u.pn = (wgid % nig) / gsz;
}
struct StdOrder {
    int nM, nN, nwg, G, c, wgm;
    __device__ __forceinline__ void init(int M, int N, int G_, int c_, int wgm_ = WGM) { nM = M / BM; nN = N / BM; nwg = nM * nN; G = G_; c = c_; wgm = wgm_; }
    __device__ __forceinline__ bool next(int i, Unit& u) const { const long L = (long)i * G + c; if (L >= nwg) return false; std_map((int)L, nM, nN, u, wgm); u.ui = i; return true; }
    __device__ __forceinline__ void bases(const Unit& u, const Gemm& g, size_t tstep, const char*& a, const char*& b) const { a = (const char*)g.A + (size_t)u.pm * tstep; b = (const char*)g.Bt + (size_t)u.pn * tstep; }
    __device__ __forceinline__ void a_ready(const Unit&) const {}
    __device__ __forceinline__ void done(const Unit&) const {}
};
struct Ff2Order {
    int c;
    __device__ __forceinline__ bool next(int i, Unit& u) const { if (i >= 4) return false; const int x = c & 7, r = c >> 3; u.pm = 16 * i + 4 * (x >> 1) + (r & 3); u.pn = 8 * (x & 1) + (r >> 2); u.ui = i; return true; }
    __device__ __forceinline__ void bases(const Unit& u, const Gemm& g, size_t tstep, const char*& a, const char*& b) const { a = (const char*)g.A + (size_t)u.pm * tstep; b = (const char*)g.Bt + (size_t)u.pn * tstep; }
    __device__ __forceinline__ void a_ready(const Unit&) const {}
    __device__ __forceinline__ void done(const Unit&) const {}
};
struct InProjOrder {
    int G, c;
    __device__ __forceinline__ bool next(int i, Unit& u) const {
        const long L = (long)i * G + c;
        u.ui = i;
        if (L < 2560) { std_map((int)L, 64, 40, u); return true; }
        if (L < 2624) { const int j = (int)L - 2560; u.pm = 64 + (j >> 4); u.pn = 8 + (j & 15); return true; }
        return false;
    }
    __device__ __forceinline__ void bases(const Unit& u, const Gemm& g, size_t tstep, const char*& a, const char*& b) const {
        const int ty = u.pn >> 3; const bool sw = (ty == 2) || (ty == 4);
        const char* act = (const char*)g.A + (size_t)u.pm * tstep; const char* w = (const char*)g.Bt + (size_t)u.pn * tstep;
        a = sw ? w : act; b = sw ? act : w;
    }
    __device__ __forceinline__ void a_ready(const Unit&) const {}
    __device__ __forceinline__ void done(const Unit&) const {}
};

__device__ __forceinline__ unsigned cvt_pk_bf16(float lo, float hi) { unsigned r; asm volatile("v_cvt_pk_bf16_f32 %0, %1, %2" : "=v"(r) : "v"(lo), "v"(hi)); return r; }
__device__ __forceinline__ f32x4 lds_ld4(const PG8_LAS float* p) { f32x4 v; asm volatile("ds_read_b128 %0, %1\n\ts_waitcnt lgkmcnt(0)" : "=v"(v) : "v"((unsigned)(size_t)p) : "memory"); return v; }
__device__ __forceinline__ float lds_ld1(const PG8_LAS float* p) { float v; asm volatile("ds_read_b32 %0, %1\n\ts_waitcnt lgkmcnt(0)" : "=v"(v) : "v"((unsigned)(size_t)p) : "memory"); return v; }
__device__ __forceinline__ float gelu_t(float x) { const float u = x * (0.7978845608f + 0.0356774081f * x * x); const float t = __builtin_amdgcn_exp2f(-2.8853900818f * u); return x * __builtin_amdgcn_rcpf(1.0f + t); }

template <int CTRL> __device__ __forceinline__ float dpp_f(float x) { return __builtin_bit_cast(float, __builtin_amdgcn_mov_dpp(__builtin_bit_cast(int, x), CTRL, 0xf, 0xf, true)); }
__device__ __forceinline__ float row16_sum(float s) {
    s += dpp_f<0xB1>(s); s += dpp_f<0x4E>(s); s += dpp_f<0x124>(s); s += dpp_f<0x128>(s); return s; }
struct EpiInProj {
    static constexpr bool PERM = true, AFTER_DRAIN = false, MIDK = false;
    __device__ __forceinline__ void midk(f32x4 (&)[2][2][4][2], int, int) const {}
    bf16_t* base0; size_t slot; float qscale; float* ssg;
    __device__ __forceinline__ void operator()(const f32x4 (&acc)[2][2][4][2], const Unit& u, int wr, int wc, int fr, int fq) const {
        const int ty = u.pn >> 3, sub = (u.pn & 7) * BM, tokb = u.pm * BM;
        bf16_t* base = base0 + (size_t)ty * slot; const bool sw = (ty == 2) || (ty == 4);
        const int ldc = (ty == 2) ? 17408 : ((ty == 4) ? 16384 : 2048), rb = sw ? sub : tokb, cb = sw ? tokb : sub;
        const float sc = (ty == 0) ? qscale : 1.f; const bool act = ty >= 3;
        const int row0 = rb + wr * 64 + fr, col0 = cb + wc * 32 + 8 * fq;
        f32x4 sq[2][2];
#pragma unroll
        for (int bj = 0; bj < 2; ++bj) { sq[bj][0] = (f32x4){0.f, 0.f, 0.f, 0.f}; sq[bj][1] = (f32x4){0.f, 0.f, 0.f, 0.f}; }
#pragma unroll
        for (int ai = 0; ai < 2; ++ai)
#pragma unroll
            for (int m = 0; m < 4; ++m) { bf16_t* rowp = base + (size_t)(row0 + ai * HALF + m * 16) * ldc + col0;
#pragma unroll
                for (int bj = 0; bj < 2; ++bj) { f32x4 v0 = acc[ai][bj][m][0] * sc, v1 = acc[ai][bj][m][1] * sc;
                    if (act) {
#pragma unroll
                        for (int j = 0; j < 4; ++j) { v0[j] = gelu_t(v0[j]); v1[j] = gelu_t(v1[j]); }
                        sq[bj][0] += v0 * v0; sq[bj][1] += v1 * v1; }
                    u32x4 w; w.x = cvt_pk_bf16(v0[0], v0[1]); w.y = cvt_pk_bf16(v0[2], v0[3]); w.z = cvt_pk_bf16(v1[0], v1[1]); w.w = cvt_pk_bf16(v1[2], v1[3]);
                    *(u32x4*)(rowp + bj * HALF) = w; } }
        if (ty == 4) {
            float* sp = ssg + (size_t)(col0) * 16 + (u.pn & 7) * 2 + wr;
#pragma unroll
            for (int bj = 0; bj < 2; ++bj)
#pragma unroll
                for (int n = 0; n < 2; ++n)
#pragma unroll
                    for (int j = 0; j < 4; ++j) { const float s = row16_sum(sq[bj][n][j]); if (fr == 0) sp[(size_t)(bj * HALF + 4 * n + j) * 16] = s; }
        }
    }
};
__device__ __forceinline__ float xrow_sum(float x) {
    auto s = __builtin_amdgcn_permlane16_swap(__float_as_uint(x), __float_as_uint(x), false, false);
    x = __uint_as_float(s[0]) + __uint_as_float(s[1]);
    auto t = __builtin_amdgcn_permlane32_swap(__float_as_uint(x), __float_as_uint(x), false, false);
    return __uint_as_float(t[0]) + __uint_as_float(t[1]);
}
typedef unsigned u32x2 __attribute__((ext_vector_type(2)));
struct EpiRelu2 {
    static constexpr bool PERM = true, AFTER_DRAIN = false, MIDK = false;
    bf16_t* O; int ldc; const PG8_LAS float* cb; const PG8_LAS float* rs;
    __device__ __forceinline__ void midk(f32x4 (&)[2][2][4][2], int, int) const {}
    __device__ __forceinline__ void operator()(const f32x4 (&acc)[2][2][4][2], const Unit& u, int wr, int wc, int fr, int fq) const {
        const int row0 = u.pm * BM + wr * 64 + fr, cin = wc * 32 + 8 * fq, col0 = u.pn * BM + cin;
        const PG8_LAS float* bp = cb + (u.pn >> 2) * BM + cin;
        f32x4 bv[2][2];
#pragma unroll
        for (int bj = 0; bj < 2; ++bj)
#pragma unroll
            for (int n = 0; n < 2; ++n) bv[bj][n] = lds_ld4(bp + bj * HALF + 4 * n);
#pragma unroll
        for (int ai = 0; ai < 2; ++ai)
#pragma unroll
            for (int m = 0; m < 4; ++m) { bf16_t* rowp = O + (size_t)(row0 + ai * HALF + m * 16) * ldc + col0; const float r = lds_ld1(rs + ai * HALF + wr * 64 + m * 16 + fr);
#pragma unroll
                for (int bj = 0; bj < 2; ++bj) { f32x4 v0 = acc[ai][bj][m][0] * r + bv[bj][0], v1 = acc[ai][bj][m][1] * r + bv[bj][1];
#pragma unroll
                    for (int j = 0; j < 4; ++j) { const float a = fmaxf(v0[j], 0.f), b = fmaxf(v1[j], 0.f); v0[j] = a * a; v1[j] = b * b; }
                    u32x4 w; w.x = cvt_pk_bf16(v0[0], v0[1]); w.y = cvt_pk_bf16(v0[2], v0[3]); w.z = cvt_pk_bf16(v1[0], v1[1]); w.w = cvt_pk_bf16(v1[2], v1[3]);
                    *(u32x4*)(rowp + bj * HALF) = w; } }
    }
};
struct EpiOutProj {
    static constexpr bool PERM = true, AFTER_DRAIN = false, MIDK = true;
    const float* x; bf16_t* x1b; bf16_t* a3; int lda3; float* pss; const PG8_LAS float* gvt; const PG8_LAS float* avt; const PG8_LAS float* tab;
    __device__ __forceinline__ void midk(f32x4 (&acc)[2][2][4][2], int wr, int fr) const {
#pragma unroll
        for (int ai = 0; ai < 2; ++ai)
#pragma unroll
            for (int m = 0; m < 4; ++m) { const float f = lds_ld1(tab + ai * HALF + wr * 64 + m * 16 + fr);
#pragma unroll
                for (int bj = 0; bj < 2; ++bj)
#pragma unroll
                    for (int n = 0; n < 2; ++n) acc[ai][bj][m][n] *= f; }
    }
    __device__ __forceinline__ void operator()(const f32x4 (&acc)[2][2][4][2], const Unit& u, int wr, int wc, int fr, int fq) const {
        const int cin = wc * 32 + 8 * fq, col0 = u.pn * BM + cin, tr0 = wr * 64 + fr, ct0 = (u.pn >> 2) * BM + cin;
        const size_t off0 = (size_t)(u.pm * BM + tr0) * 4096 + col0;
        float ss[2][4];
#pragma unroll
        for (int ai = 0; ai < 2; ++ai)
#pragma unroll
            for (int m = 0; m < 4; ++m) ss[ai][m] = 0.f;
#pragma unroll
        for (int bj = 0; bj < 2; ++bj) {
            const f32x4 g0 = lds_ld4(gvt + ct0 + bj * HALF), g1 = lds_ld4(gvt + ct0 + bj * HALF + 4);
            const f32x4 a0 = lds_ld4(avt + ct0 + bj * HALF), a1 = lds_ld4(avt + ct0 + bj * HALF + 4);
#pragma unroll
            for (int ai = 0; ai < 2; ++ai)
#pragma unroll
                for (int m = 0; m < 4; ++m) { const size_t off = off0 + (size_t)(ai * HALF + m * 16) * 4096 + bj * HALF; const float r = lds_ld1(tab + 256 + ai * HALF + m * 16 + tr0);
                    const f32x4 v0 = *(const f32x4*)(x + off) + g0 * (acc[ai][bj][m][0] * r), v1 = *(const f32x4*)(x + off + 4) + g1 * (acc[ai][bj][m][1] * r);
                    { u32x4 w1; w1.x = cvt_pk_bf16(v0.x, v0.y); w1.y = cvt_pk_bf16(v0.z, v0.w); w1.z = cvt_pk_bf16(v1.x, v1.y); w1.w = cvt_pk_bf16(v1.z, v1.w); *(u32x4*)(x1b + off) = w1; }
                    ss[ai][m] += ((v0.x * v0.x + v0.y * v0.y) + (v0.z * v0.z + v0.w * v0.w)) + ((v1.x * v1.x + v1.y * v1.y) + (v1.z * v1.z + v1.w * v1.w));
                    const f32x4 b0 = v0 * a0, b1 = v1 * a1; u32x4 w; w.x = cvt_pk_bf16(b0.x, b0.y); w.y = cvt_pk_bf16(b0.z, b0.w); w.z = cvt_pk_bf16(b1.x, b1.y); w.w = cvt_pk_bf16(b1.z, b1.w);
                    *(u32x4*)(a3 + (size_t)(u.pm * BM + tr0 + ai * HALF + m * 16) * lda3 + col0 + bj * HALF) = w; }
            asm volatile("" ::: "memory"); }
#pragma unroll
        for (int ai = 0; ai < 2; ++ai)
#pragma unroll
            for (int m = 0; m < 4; ++m) { const float s = xrow_sum(ss[ai][m]);
                if (fq == 0) pss[(size_t)(u.pm * BM + ai * HALF + m * 16 + tr0) * 64 + u.pn * 4 + wc] = s; }
    }
};
struct EpiGatedRes {
    static constexpr bool PERM = true, AFTER_DRAIN = false, MIDK = false;
    bf16_t* xb; const PG8_LAS float* gvt;
    __device__ __forceinline__ void midk(f32x4 (&)[2][2][4][2], int, int) const {}
    __device__ __forceinline__ void operator()(const f32x4 (&acc)[2][2][4][2], const Unit& u, int wr, int wc, int fr, int fq) const {
        const int cin = wc * 32 + 8 * fq, col0 = u.pn * BM + cin, ct0 = u.ui * BM + cin;
        const size_t off0 = (size_t)(u.pm * BM + wr * 64 + fr) * 4096 + col0;
#pragma unroll
        for (int bj = 0; bj < 2; ++bj) {
            const f32x4 g0 = lds_ld4(gvt + ct0 + bj * HALF), g1 = lds_ld4(gvt + ct0 + bj * HALF + 4);
#pragma unroll
            for (int ai = 0; ai < 2; ++ai)
#pragma unroll
                for (int m = 0; m < 4; ++m) { const size_t off = off0 + (size_t)(ai * HALF + m * 16) * 4096 + bj * HALF;
                    const u32x4 b = *(const u32x4*)(xb + off);
                    const f32x4 v0 = (f32x4){__uint_as_float(b.x << 16), __uint_as_float(b.x & 0xffff0000u), __uint_as_float(b.y << 16), __uint_as_float(b.y & 0xffff0000u)} + g0 * acc[ai][bj][m][0];
                    const f32x4 v1 = (f32x4){__uint_as_float(b.z << 16), __uint_as_float(b.z & 0xffff0000u), __uint_as_float(b.w << 16), __uint_as_float(b.w & 0xffff0000u)} + g1 * acc[ai][bj][m][1];
                    u32x4 w; w.x = cvt_pk_bf16(v0.x, v0.y); w.y = cvt_pk_bf16(v0.z, v0.w); w.z = cvt_pk_bf16(v1.x, v1.y); w.w = cvt_pk_bf16(v1.z, v1.w);
                    *(u32x4*)(xb + off) = w; }
            asm volatile("" ::: "memory"); }
    }
};

template <class Epi, class Sched, bool ALIGN_EPI = false, bool SP2 = false>
__device__ __forceinline__ void gemm_phase(PG8_LAS unsigned char* lds, const Gemm g, const Sched& S, const Epi& E) {
    const int tid = threadIdx.x, wid = __builtin_amdgcn_readfirstlane(tid >> 6), lane = tid & 63, wr = wid >> 2, wc = wid & 3, fr = lane & 15, fq = lane >> 4;
    const int K = g.K, nt = K / BK;
    unsigned voffA[2], voffB[2];
#pragma unroll
    for (int i = 0; i < 2; ++i) { int R, C; stage_rc(tid * 16 + i * 8192, R, C); const int Rb = Epi::PERM ? ((R & ~31) + perm32(R & 31)) : R;
        voffA[i] = (unsigned)(R * g.ld + C) * 2u; voffB[i] = (unsigned)(Rb * g.ld + C) * 2u; }
    const size_t kstep = (size_t)(BK * 2);
    const size_t hstep = (size_t)HALF * g.ld * 2;
    const size_t tstep = 2 * hstep;
    const unsigned ldsw = (unsigned)wid * 1024u;
    const int aoff = lds_byte(wr * 64 + fr, fq * 8), boff = lds_byte(wc * 32 + fr, fq * 8);
#define PG8_SA(b, h) (((b) * 2 + (h)) * HTB)
#define PG8_SB(b, h) ((4 + (b) * 2 + (h)) * HTB)
#define PG8_STAGE(bufoff, gbase, voff) do { _Pragma("unroll") for (int _i = 0; _i < 2; ++_i) \
        __builtin_amdgcn_global_load_lds((const unsigned*)((const char*)(gbase) + (voff)[_i]), (PG8_LAS unsigned*)(lds + (bufoff) + ldsw + _i * 8192), 16, 0, 0); } while (0)
#define PG8_LDA(dst, b, h) do { _Pragma("unroll") for (int m = 0; m < 4; ++m) _Pragma("unroll") for (int k = 0; k < 2; ++k) dst[m][k] = *(const PG8_LAS bf16x8*)(lds + PG8_SA(b, h) + aoff + m * 2048 + k * 1024); } while (0)
#define PG8_LDB(dst, b, h) do { _Pragma("unroll") for (int n = 0; n < 2; ++n) _Pragma("unroll") for (int k = 0; k < 2; ++k) dst[n][k] = *(const PG8_LAS bf16x8*)(lds + PG8_SB(b, h) + boff + n * 2048 + k * 1024); } while (0)
#define PG8_MMA(ai, bj, At, Bt) do { __builtin_amdgcn_s_setprio(1); _Pragma("unroll") for (int m = 0; m < 4; ++m) _Pragma("unroll") for (int n = 0; n < 2; ++n) _Pragma("unroll") for (int k = 0; k < 2; ++k) \
        acc[ai][bj][m][n] = __builtin_amdgcn_mfma_f32_16x16x32_bf16(Bt[n][k], At[m][k], acc[ai][bj][m][n], 0, 0, 0); __builtin_amdgcn_s_setprio(0); } while (0)
#define PG8_WAIT_V(n) asm volatile("s_waitcnt vmcnt(" #n ")" ::: "memory")
#define PG8_WAIT_L(n) asm volatile("s_waitcnt lgkmcnt(" #n ")" ::: "memory")
#define PG8_BAR __builtin_amdgcn_s_barrier()
#define PG8_SCHED __builtin_amdgcn_sched_barrier(0)
    Unit cur, nxt; int ui = 0;
    if (!S.next(0, cur)) return;
    f32x4 acc[2][2][4][2];
#pragma unroll
    for (int a = 0; a < 2; ++a)
#pragma unroll
        for (int b = 0; b < 2; ++b)
#pragma unroll
            for (int m = 0; m < 4; ++m)
#pragma unroll
                for (int n = 0; n < 2; ++n) acc[a][b][m][n] = (f32x4){0.f, 0.f, 0.f, 0.f};
    bf16x8 At[4][2], B0[2][2], B1[2][2];
    const char* cA; const char* cB; S.bases(cur, g, tstep, cA, cB);
    S.a_ready(cur);
    if constexpr (SP2) {
        PG8_STAGE(PG8_SB(0, 0), cB, voffB); PG8_STAGE(PG8_SB(0, 1), cB + hstep, voffB); PG8_STAGE(PG8_SA(0, 0), cA, voffA); PG8_STAGE(PG8_SA(0, 1), cA + hstep, voffA);
        if (wr == 1) PG8_BAR;
        PG8_WAIT_V(2); PG8_BAR;
        PG8_STAGE(PG8_SB(1, 0), cB + kstep, voffB); PG8_STAGE(PG8_SA(1, 0), cA + kstep, voffA); PG8_STAGE(PG8_SB(1, 1), cB + hstep + kstep, voffB);
        PG8_WAIT_V(6); PG8_BAR;
    } else {
        PG8_STAGE(PG8_SB(0, 0), cB, voffB); PG8_STAGE(PG8_SA(0, 0), cA, voffA); PG8_STAGE(PG8_SB(0, 1), cB + hstep, voffB); PG8_STAGE(PG8_SA(0, 1), cA + hstep, voffA);
        if (wr == 1) PG8_BAR;
        PG8_WAIT_V(4); PG8_BAR;
        PG8_STAGE(PG8_SB(1, 0), cB + kstep, voffB); PG8_STAGE(PG8_SA(1, 0), cA + kstep, voffA); PG8_STAGE(PG8_SB(1, 1), cB + hstep + kstep, voffB);
        PG8_WAIT_V(6); PG8_BAR;
    }
    for (;;) {
        const bool has_next = S.next(ui + 1, nxt);
        const char* nA = cA; const char* nB = cB; if (has_next) S.bases(nxt, g, tstep, nA, nB);
        for (int t = 0; t < nt; t += 2) {
            const bool last = (t == nt - 2);
            const char* a1 = cA + (size_t)(t + 1) * kstep;
            const char* a2 = last ? nA : cA + (size_t)(t + 2) * kstep; const char* b2 = last ? nB : cB + (size_t)(t + 2) * kstep;
            const char* a3 = a2 + kstep; const char* b3 = b2 + kstep;
            if (last && has_next) S.a_ready(nxt);
            if constexpr (Epi::MIDK) { if (t == (nt >> 1)) { E.midk(acc, wr, fr); asm volatile("s_waitcnt lgkmcnt(0)" ::: "memory"); } }
            if constexpr (SP2) {
            PG8_LDB(B0, 0, 0); PG8_LDB(B1, 0, 1); PG8_SCHED; PG8_LDA(At, 0, 0); PG8_STAGE(PG8_SA(1, 1), a1 + hstep, voffA);
            PG8_WAIT_V(8); PG8_WAIT_L(0); PG8_BAR; PG8_MMA(0, 0, At, B0); PG8_MMA(0, 1, At, B1); PG8_BAR; PG8_SCHED;
            PG8_LDA(At, 0, 1); PG8_STAGE(PG8_SB(0, 0), b2, voffB); PG8_STAGE(PG8_SB(0, 1), b2 + hstep, voffB); PG8_STAGE(PG8_SA(0, 0), a2, voffA);
            PG8_WAIT_V(8); PG8_WAIT_L(0); PG8_BAR; PG8_MMA(1, 0, At, B0); PG8_MMA(1, 1, At, B1); PG8_BAR; PG8_SCHED;
            PG8_LDB(B0, 1, 0); PG8_LDB(B1, 1, 1); PG8_SCHED; PG8_LDA(At, 1, 0); PG8_STAGE(PG8_SA(0, 1), a2 + hstep, voffA);
            PG8_WAIT_V(8); PG8_WAIT_L(0); PG8_BAR; PG8_MMA(0, 0, At, B0); PG8_MMA(0, 1, At, B1); PG8_BAR; PG8_SCHED;
            PG8_LDA(At, 1, 1); PG8_STAGE(PG8_SB(1, 0), b3, voffB); PG8_STAGE(PG8_SB(1, 1), b3 + hstep, voffB); PG8_STAGE(PG8_SA(1, 0), a3, voffA);
            PG8_WAIT_V(8); PG8_WAIT_L(0); PG8_BAR; PG8_MMA(1, 0, At, B0); PG8_MMA(1, 1, At, B1); PG8_BAR; PG8_SCHED;
            } else {
            PG8_LDB(B0, 0, 0); PG8_SCHED; PG8_LDA(At, 0, 0); PG8_STAGE(PG8_SA(1, 1), a1 + hstep, voffA);
            PG8_WAIT_L(8); PG8_BAR; PG8_WAIT_L(0); PG8_MMA(0, 0, At, B0); PG8_BAR; PG8_SCHED;
            PG8_LDB(B1, 0, 1); PG8_STAGE(PG8_SB(0, 0), b2, voffB);
            PG8_BAR; PG8_WAIT_L(0); PG8_MMA(0, 1, At, B1); PG8_BAR;
            PG8_LDA(At, 0, 1); PG8_STAGE(PG8_SA(0, 0), a2, voffA);
            PG8_BAR; PG8_WAIT_L(0); PG8_MMA(1, 0, At, B0); PG8_BAR; PG8_SCHED;
            PG8_STAGE(PG8_SB(0, 1), b2 + hstep, voffB);
            PG8_WAIT_V(6); PG8_BAR; PG8_MMA(1, 1, At, B1); PG8_BAR;
            PG8_LDB(B0, 1, 0); PG8_SCHED; PG8_LDA(At, 1, 0); PG8_STAGE(PG8_SA(0, 1), a2 + hstep, voffA);
            PG8_WAIT_L(8); PG8_BAR; PG8_WAIT_L(0); PG8_MMA(0, 0, At, B0); PG8_BAR; PG8_SCHED;
            PG8_LDB(B1, 1, 1); PG8_STAGE(PG8_SB(1, 0), b3, voffB);
            PG8_BAR; PG8_WAIT_L(0); PG8_MMA(0, 1, At, B1); PG8_BAR;
            PG8_LDA(At, 1, 1); PG8_STAGE(PG8_SA(1, 0), a3, voffA);
            PG8_BAR; PG8_WAIT_L(0); PG8_MMA(1, 0, At, B0); PG8_BAR; PG8_SCHED;
            PG8_STAGE(PG8_SB(1, 1), b3 + hstep, voffB);
            PG8_WAIT_V(6); PG8_BAR; PG8_MMA(1, 1, At, B1); PG8_BAR;
            }
        }
        if constexpr (ALIGN_EPI) { if (wr == 0) PG8_BAR; }
        if constexpr (!Epi::AFTER_DRAIN) { E(acc, cur, wr, wc, fr, fq); S.done(cur); }
        if (!has_next) break;
#pragma unroll
        for (int a = 0; a < 2; ++a)
#pragma unroll
            for (int b = 0; b < 2; ++b)
#pragma unroll
                for (int m = 0; m < 4; ++m)
#pragma unroll
                    for (int n = 0; n < 2; ++n) acc[a][b][m][n] = (f32x4){0.f, 0.f, 0.f, 0.f};
        cur = nxt; cA = nA; cB = nB; ++ui;
        if constexpr (ALIGN_EPI) { if (wr == 1) PG8_BAR; }
    }
    PG8_WAIT_V(0);
    if constexpr (!ALIGN_EPI) { if (wr == 0) PG8_BAR; }
    PG8_BAR;
    if constexpr (Epi::AFTER_DRAIN) { E.fused(acc, cur, wr, wc, fr, fq, lds, wid, lane); S.done(cur); }
#undef PG8_SA
#undef PG8_SB
#undef PG8_STAGE
#undef PG8_LDA
#undef PG8_LDB
#undef PG8_MMA
#undef PG8_WAIT_V
#undef PG8_WAIT_L
#undef PG8_BAR
#undef PG8_SCHED
}
}

constexpr int NWAVES = 8;
#ifndef MK_N_LAUNCHES
#define MK_N_LAUNCHES 1
#endif
constexpr int N_PHASES = 8;
#ifndef FF2_WGM
#define FF2_WGM 4
#endif
#ifndef REP_PHASE
#define REP_PHASE -1
#endif
#define REPS(k) (((k) == REP_PHASE) ? 2 : 1)
#ifndef DBG_MULT
#define DBG_MULT 4
#endif
#ifndef DBG_SLOT
#define DBG_SLOT -1
#endif
constexpr int D = 4096, BATCH = 4, SEQ = 4096, GW = 64, CTX = 256;
constexpr int NH = 16, HD = 128, DNA = 2048, DSGU = 2048, DIN = 10240, DFF = 16384, NMODC = 6 * D;
constexpr int LDK = D;
constexpr int LDF2 = DFF + 64;
constexpr int M = BATCH * SEQ, MC = BATCH * CTX, MA = M + MC;
constexpr float EPS = 1e-6f;
constexpr float LOG2E = 1.4426950408889634f;
constexpr int ADA_KS = 16, ADA_STRIPS = NMODC / 256;

constexpr size_t MiB = 1u << 20;
constexpr size_t WS_CTL = 0, CTL_ZERO_BYTES = 1 * MiB;
constexpr size_t WS_MODF = 1 * MiB;
constexpr size_t WS_PART = 2 * MiB;
constexpr size_t WS_SSNA = 10 * MiB;
constexpr size_t WS_SSGP = 2 * MiB;
constexpr size_t WS_SSSG = 11 * MiB;
constexpr size_t WS_CBIAS = 11 * MiB + 512 * 1024;
constexpr size_t WS_PSS = 12 * MiB;
constexpr size_t WS_WIN = 16 * MiB;
constexpr size_t WS_WOUT = 96 * MiB;
constexpr size_t WS_WFF1 = 128 * MiB;
constexpr size_t WS_WFF2 = 260 * MiB;
constexpr size_t WS_A1 = 390 * MiB;
constexpr size_t WS_SLOT = 68 * MiB;
constexpr size_t WS_Q = 526 * MiB;
constexpr size_t WS_K = WS_Q + 1 * WS_SLOT;
constexpr size_t WS_VT = WS_Q + 2 * WS_SLOT;
constexpr size_t WS_U = WS_Q + 3 * WS_SLOT;
constexpr size_t WS_GT = WS_Q + 4 * WS_SLOT;
constexpr size_t WS_A2 = WS_Q + 5 * WS_SLOT;
constexpr size_t WS_H = 526 * MiB;
constexpr size_t WS_XB = 1040 * MiB;
constexpr size_t WS_END = 1168 * MiB;
static_assert(WS_A1 + (size_t)MA * D * 2 <= WS_Q && WS_K + (size_t)MA * DNA * 2 <= WS_VT && WS_VT + (size_t)DNA * MA * 2 <= WS_U && WS_GT + (size_t)DSGU * M * 2 <= WS_A2 && WS_A2 + (size_t)M * D * 2 <= WS_END && WS_H + (size_t)M * LDF2 * 2 <= WS_XB && WS_WFF2 + (size_t)D * LDF2 * 2 <= WS_A1 && WS_WFF1 + (size_t)DFF * LDK * 2 <= WS_WFF2 && WS_A1 + (size_t)M * LDK * 2 <= WS_Q && WS_XB + (size_t)M * D * 2 <= WS_END, "d_ws map");
constexpr int CW_BAR = 4096;

constexpr int RING_OFF = 0, RING_BYTES = 131072;
constexpr int ROWTAB_OFF = RING_BYTES, COLTAB_OFF = ROWTAB_OFF + 2048;
constexpr int LDSCTL_OFF = 149504, MISC_OFF = LDSCTL_OFF + 320;
constexpr int LDS_BYTES = 150528;
static_assert(COLTAB_OFF + 16384 <= LDSCTL_OFF && MISC_OFF + 128 <= LDS_BYTES, "LDS map");

#define GAS __attribute__((address_space(1)))
#define LAS __attribute__((address_space(3)))
typedef unsigned short bf16;
typedef unsigned v4u __attribute__((ext_vector_type(4)));
typedef unsigned v2u __attribute__((ext_vector_type(2)));
typedef float f32x4 __attribute__((ext_vector_type(4)));
typedef short bf16x8 __attribute__((ext_vector_type(8)));
typedef GAS unsigned gu32;
#define RLX_AGENT __ATOMIC_RELAXED, __HIP_MEMORY_SCOPE_AGENT
#define LDS_WAIT() asm volatile("s_waitcnt lgkmcnt(0)" ::: "memory")
#define VM_WAIT() asm volatile("s_waitcnt vmcnt(0)" ::: "memory")
__device__ __forceinline__ unsigned pk2(float lo, float hi) { return pg8::cvt_pk_bf16(lo, hi); }
__device__ __forceinline__ float bf_lo(unsigned w) { return __builtin_bit_cast(float, w << 16); }
__device__ __forceinline__ float bf_hi(unsigned w) { return __builtin_bit_cast(float, w & 0xffff0000u); }

#define XB_TMO      128
#define XB_XCNT(j)  (256  + 64 * (j))
#define XB_XSUB(j)  (1280 + 64 * (j))
#define XB_XGEN(j)  (2304 + 64 * (j))
#define XB_TOP      3328
#define XB_TOPGEN   3392
#define XCD_BAR_WORDS 3456
#define XB_SPIN_CAP (1u << 18)

__device__ __forceinline__ unsigned xb_ld(unsigned* p)              { return __hip_atomic_load(p, __ATOMIC_RELAXED, __HIP_MEMORY_SCOPE_AGENT); }
__device__ __forceinline__ unsigned xb_add(unsigned* p, unsigned v) { return __hip_atomic_fetch_add(p, v, __ATOMIC_RELAXED, __HIP_MEMORY_SCOPE_AGENT); }
__device__ __forceinline__ unsigned xb_xcc_id() { return (unsigned)__builtin_amdgcn_s_getreg((3 << 11) | 20) & 0xFu; }
#define XB_SPIN(cond, bar) do { unsigned _sp = 0; while (cond) { __builtin_amdgcn_s_sleep(1); \
    if ((++_sp & 255u) == 0u) { if (xb_ld(&(bar)[XB_TMO])) break; if (_sp > XB_SPIN_CAP) { atomicAdd(&(bar)[XB_TMO], 1u); break; } } } } while (0)

struct XcdBarrier {
    unsigned* bar; unsigned x;
    volatile LAS unsigned* st;
};

__device__ __forceinline__ XcdBarrier xcd_barrier_post(unsigned* bar, volatile LAS unsigned* st) {
    XcdBarrier b; b.bar = bar; b.x = xb_xcc_id(); b.st = st;
    if (threadIdx.x == 0) (void)xb_add(&bar[XB_XCNT(b.x)], 1u);
    return b;
}
__device__ __forceinline__ void xcd_barrier_complete(unsigned* bar, unsigned x, unsigned& nloc, unsigned& nx) {
    const unsigned G = gridDim.x * gridDim.y * gridDim.z;
    unsigned sum, cnt, mine, sp = 0u;
    for (;;) {
        sum = 0u; cnt = 0u; mine = 0u;
#pragma unroll
        for (unsigned j = 0; j < 16; ++j) { const unsigned c = xb_ld(&bar[XB_XCNT(j)]); sum += c; cnt += (c > 0u) ? 1u : 0u; mine = (j == x) ? c : mine; }
        if (sum == G) break;
        __builtin_amdgcn_s_sleep(1);
        if ((++sp & 255u) == 0u) { if (xb_ld(&bar[XB_TMO])) break; if (sp > XB_SPIN_CAP) { atomicAdd(&bar[XB_TMO], 1u); break; } }
    }
    nloc = mine > 0u ? mine : 1u; nx = cnt > 0u ? cnt : 1u;
}

__device__ __forceinline__ void xcd_barrier(const XcdBarrier& b) {
    asm volatile("s_waitcnt vmcnt(0)" ::: "memory");
    __syncthreads();
    if (threadIdx.x == 0) {
        unsigned* bar = b.bar;
        __builtin_amdgcn_s_waitcnt(0);
        unsigned nloc = b.st[0], nx = b.st[1];
        if (nloc == 0u) { xcd_barrier_complete(bar, b.x, nloc, nx); b.st[0] = nloc; b.st[1] = nx; }
        const unsigned old = xb_add(&bar[XB_XSUB(b.x)], 1u);
        const unsigned gen = old / nloc;
        if (old + 1u == (gen + 1u) * nloc) {
            __builtin_amdgcn_fence(__ATOMIC_RELEASE, "agent");
            asm volatile("s_waitcnt vmcnt(0)" ::: "memory");
            const unsigned og = xb_add(&bar[XB_TOP], 1u);
            const unsigned tg = og / nx;
            if (og + 1u == (tg + 1u) * nx) xb_add(&bar[XB_TOPGEN], 1u);
            else XB_SPIN(xb_ld(&bar[XB_TOPGEN]) == tg, bar);
            __builtin_amdgcn_fence(__ATOMIC_ACQUIRE, "agent");
            xb_add(&bar[XB_XGEN(b.x)], 1u);
            asm volatile("s_waitcnt vmcnt(0)" ::: "memory");
        } else {
            XB_SPIN(xb_ld(&bar[XB_XGEN(b.x)]) == gen, bar);
            __builtin_amdgcn_fence(__ATOMIC_ACQUIRE, "agent");
            asm volatile("s_waitcnt vmcnt(0)" ::: "memory");
        }
    }
    __syncthreads();
}

struct Frame {
    LAS unsigned char* lds;
    volatile LAS unsigned* MISC;
    gu32* ctl;
    int tid, lane, wave, G, vc;
    const float *x, *c, *ctx, *cctx, *w_ada, *b_ada, *norm1_w, *w_in, *rpb, *sgu_norm_w, *sgu_w, *sgu_b, *gna, *gsgu, *w_out, *norm2_w, *w_ff1, *w_ff2, *fnw;
    float* out;
    float *modf, *part, *ssna, *sssg, *cbias, *pss, *ssgp;
    bf16 *Wt_in, *Wt_out, *Wt_ff1, *Wt_ff2, *A1, *QB, *KB, *VT, *UB, *GT, *A2, *HB, *XB;
};
constexpr int CW_DBG = 8192;
#define DBG_BEGIN(t) unsigned long long t = 0; if (DBG_SLOT >= 0) t = __builtin_amdgcn_s_memrealtime()
#define DBG_MARK(t) do { if (DBG_SLOT >= 0) t = __builtin_amdgcn_s_memrealtime(); } while (0)
#define DBG_END(F, slot, t) do { if (DBG_SLOT >= 0 && (F).tid == 0) atomicMax((unsigned*)((F).ctl + CW_DBG + 64 * (slot)), (unsigned)(__builtin_amdgcn_s_memrealtime() - (t))); } while (0)
__device__ __forceinline__ float wave_sum(float v) {
#pragma unroll
    for (int o = 1; o < 64; o <<= 1) v += __shfl_xor(v, o);
    return v;
}
constexpr int I_IN = (D / 64) * (DIN / 32), I_OUT = (D / 64) * (D / 32), I_F1 = (D / 64) * (DFF / 32), I_F2 = (DFF / 64) * (D / 32), I_TR = I_IN + I_OUT + I_F1 + I_F2;
struct TIt { const float* src; bf16* dst; const LAS float* kg; bool gain; int N, K; };
__device__ __forceinline__ void p0_titem(Frame& F, int t, TIt& r) {
    int x = t; const float* W = F.w_in; bf16* WT = F.Wt_in; int K = D, N = DIN; bool gain = false;
    if (x >= I_IN) { x -= I_IN; W = F.w_out; WT = F.Wt_out; N = D; gain = true;
        if (x >= I_OUT) { x -= I_OUT; W = F.w_ff1; WT = F.Wt_ff1; N = DFF; K = LDK; gain = false;
            if (x >= I_F1) { x -= I_F1; W = F.w_ff2; WT = F.Wt_ff2; K = LDF2; N = D; } } }
    const int nblk = N >> 5, kb = x / nblk, nb = x - kb * nblk, k0 = 64 * kb, n0 = 32 * nb;
    r.src = W + (size_t)k0 * N + n0; r.dst = WT + (size_t)n0 * K + k0; r.N = N; r.K = K;
    r.gain = gain; r.kg = (const LAS float*)(F.lds + ROWTAB_OFF) + k0;
}
__device__ __forceinline__ void p0_tload(const TIt& r, float (&v)[32], int lane) {
    const float* p = r.src + (size_t)(lane >> 5) * r.N + (lane & 31);
#pragma unroll
    for (int i = 0; i < 32; ++i) v[i] = p[(size_t)(2 * i) * r.N];
}
__device__ __forceinline__ void p0_tstore(const TIt& r, const float (&v)[32], LAS float* scr, int lane) {
#pragma unroll
    for (int i = 0; i < 32; ++i) { const int kk = 2 * i + (lane >> 5); float x = v[i]; if (r.gain) x *= r.kg[kk]; scr[kk * 33 + (lane & 31)] = x; }
    LDS_WAIT(); asm volatile("" ::: "memory");
    const int c = lane & 7;
#pragma unroll
    for (int j = 0; j < 4; ++j) { const int n = (lane >> 3) + 8 * j; const LAS float* s = scr + (8 * c) * 33 + n;
        v4u o; o.x = pk2(s[0 * 33], s[1 * 33]); o.y = pk2(s[2 * 33], s[3 * 33]); o.z = pk2(s[4 * 33], s[5 * 33]); o.w = pk2(s[6 * 33], s[7 * 33]);
        *(GAS v4u*)(r.dst + (size_t)n * r.K + 8 * c) = o; }
    LDS_WAIT(); asm volatile("" ::: "memory");
}
__device__ __forceinline__ float silu_f(float v) { return v / (1.0f + __expf(-v)); }
typedef float f32x3 __attribute__((ext_vector_type(3)));
__device__ __forceinline__ void p0_ada_item(Frame& F, int item, LAS float* sil) {
    const int s = item & 127, ks = item >> 7, k0 = ks * 256, lane = F.lane;
#pragma unroll
    for (int r = 0; r < 5; ++r) { const float* src = (r < 4) ? F.c + r * D : F.cctx; const f32x4 v = *(const f32x4*)(src + k0 + 4 * lane);
        f32x4 o; o.x = silu_f(v.x); o.y = silu_f(v.y); o.z = silu_f(v.z); o.w = silu_f(v.w); *(LAS f32x4*)(sil + r * 256 + 4 * lane) = o; }
    LDS_WAIT(); asm volatile("" ::: "memory");
    f32x3 acc[5];
#pragma unroll
    for (int r = 0; r < 5; ++r) acc[r] = (f32x3){0.f, 0.f, 0.f};
    const float* wp = F.w_ada + (size_t)k0 * NMODC + 192 * s + 3 * lane;
#pragma unroll 16
    for (int kk = 0; kk < 256; ++kk) { const f32x3 w = *(const f32x3*)(wp + (size_t)kk * NMODC);
#pragma unroll
        for (int r = 0; r < 5; ++r) acc[r] += w * sil[r * 256 + kk]; }
#pragma unroll
    for (int r = 0; r < 5; ++r) *(f32x3*)(F.part + (size_t)(ks * 5 + r) * NMODC + 192 * s + 3 * lane) = acc[r];
    LDS_WAIT(); asm volatile("" ::: "memory");
}
__device__ __forceinline__ void p0_ada(Frame& F) {
    LAS float* sil = (LAS float*)(F.lds + RING_OFF + F.wave * 16384 + 8704);
    p0_ada_item(F, (int)blockIdx.x * NWAVES + F.wave, sil);
}
__device__ __forceinline__ void p0_transpose(Frame& F, const int t0, const int ts, const int nt, const int jsplit, const int jskip, const bool gains) {
    LAS float* scr = (LAS float*)(F.lds + RING_OFF + F.wave * 16384);
    static_assert(ADA_KS * 128 == 2048 && (I_TR / 2048) * 2048 == I_TR && I_IN % 2048 == 0 && I_OUT % 2048 == 0 && I_F1 % 2048 == 0, "P0 work split");
    __syncthreads();
    if (gains) { for (int i4 = F.tid; i4 < D / 4; i4 += NWAVES * 64) *(LAS f32x4*)(F.lds + ROWTAB_OFF + 16 * i4) = (i4 < DNA / 4) ? *(const f32x4*)(F.gna + 4 * i4) : *(const f32x4*)(F.gsgu + 4 * i4 - DNA);
        __syncthreads(); }
#define P0_IT(j) (t0 + ts * ((j) + ((j) >= jsplit ? jskip : 0)))
    TIt ia, ib, ic; float va[32], vb[32], vc[32];
    p0_titem(F, P0_IT(0), ia); p0_tload(ia, va, F.lane);
    p0_titem(F, P0_IT(1), ib); p0_tload(ib, vb, F.lane);
    for (int k = 0; k < nt; k += 3) {
        if (k + 2 < nt) { p0_titem(F, P0_IT(k + 2), ic); p0_tload(ic, vc, F.lane); }
        p0_tstore(ia, va, scr, F.lane);
        if (k + 3 < nt) { p0_titem(F, P0_IT(k + 3), ia); p0_tload(ia, va, F.lane); }
        if (k + 1 < nt) p0_tstore(ib, vb, scr, F.lane);
        if (k + 4 < nt) { p0_titem(F, P0_IT(k + 4), ib); p0_tload(ib, vb, F.lane); }
        if (k + 2 < nt) p0_tstore(ic, vc, scr, F.lane);
    }
#undef P0_IT
    __syncthreads();
}
constexpr int TR_K_SPLIT = (I_TR - I_F2) / 2048;
__device__ __forceinline__ f32x4 ld4(const float* p) { return *(const f32x4*)p; }
__device__ __forceinline__ f32x4 ld4(const LAS float* p) { return *(const LAS f32x4*)p; }
__device__ __forceinline__ void row_load(const float* xrow, f32x4 (&v)[16], int lane) {
#pragma unroll
    for (int j = 0; j < 8; ++j) { const float* p = xrow + 8 * (lane + 64 * j); v[2 * j] = *(const f32x4*)p; v[2 * j + 1] = *(const f32x4*)(p + 4); }
}
template <class SP> __device__ __forceinline__ void row_finish(const f32x4 (&v)[16], SP nw, SP sh, SP sc, bf16* orow, int lane) {
    float ss = 0.f;
#pragma unroll
    for (int j = 0; j < 16; ++j) ss += (v[j].x * v[j].x + v[j].y * v[j].y) + (v[j].z * v[j].z + v[j].w * v[j].w);
    const float rstd = rsqrtf(wave_sum(ss) * (1.0f / D) + EPS);
#pragma unroll
    for (int j = 0; j < 8; ++j) { const int col = 8 * (lane + 64 * j);
        const f32x4 o0 = v[2 * j] * rstd * ld4(nw + col) * (ld4(sc + col) + 1.0f) + ld4(sh + col), o1 = v[2 * j + 1] * rstd * ld4(nw + col + 4) * (ld4(sc + col + 4) + 1.0f) + ld4(sh + col + 4);
        v4u pk; pk.x = pk2(o0.x, o0.y); pk.y = pk2(o0.z, o0.w); pk.z = pk2(o1.x, o1.y); pk.w = pk2(o1.z, o1.w);
        *(v4u*)(orow + col) = pk; }
}
__device__ __forceinline__ void p1_rows(Frame& F) {
    LAS float* modL = (LAS float*)(F.lds + RING_OFF);
    const int bx = (int)blockIdx.x, b = bx >> 6;
    f32x4 va[16]; row_load(F.x + (size_t)(64 * bx + F.wave) * D, va, F.lane);
    for (int i4 = F.tid; i4 < 2 * D / 4; i4 += NWAVES * 64) { const int i = 4 * i4;
        f32x4 p0[ADA_KS], p1[ADA_KS];
#pragma unroll
        for (int sp = 0; sp < ADA_KS; ++sp) { p0[sp] = *(const f32x4*)(F.part + (size_t)(sp * 5 + b) * NMODC + i); p1[sp] = *(const f32x4*)(F.part + (size_t)(sp * 5 + 4) * NMODC + i); }
        f32x4 s0 = *(const f32x4*)(F.b_ada + i), s1 = s0;
#pragma unroll
        for (int sp = 0; sp < ADA_KS; ++sp) { s0 += p0[sp]; s1 += p1[sp]; }
        *(LAS f32x4*)(modL + i) = s0; *(LAS f32x4*)(modL + 2 * D + i) = s1; }
    if (F.tid < 120) { const int idx = bx * 480 + 4 * F.tid, r = idx / NMODC, j = idx % NMODC;
        f32x4 p0[ADA_KS];
#pragma unroll
        for (int sp = 0; sp < ADA_KS; ++sp) p0[sp] = *(const f32x4*)(F.part + (size_t)(sp * 5 + r) * NMODC + j);
        f32x4 s = *(const f32x4*)(F.b_ada + j);
#pragma unroll
        for (int sp = 0; sp < ADA_KS; ++sp) s += p0[sp];
        *(f32x4*)(F.modf + idx) = s; }
    LAS float* nwv = modL + 4 * D;
    for (int i4 = F.tid; i4 < D / 4; i4 += NWAVES * 64) *(LAS f32x4*)(nwv + 4 * i4) = *(const f32x4*)(F.norm1_w + 4 * i4);
    __syncthreads();
    f32x4 vb[16];
#pragma unroll 1
    for (int i = 0; i < 8; i += 2) {
        const int r0 = 64 * bx + F.wave + 8 * i, r1 = r0 + 8;
        row_load(F.x + (size_t)r1 * D, vb, F.lane);
        row_finish<const LAS float*>(va, nwv, modL, modL + D, F.A1 + (size_t)r0 * D, F.lane);
        if (i + 2 < 8) row_load(F.x + (size_t)(r1 + 8) * D, va, F.lane); else if (F.wave < 4) row_load(F.ctx + (size_t)(4 * bx + F.wave) * D, va, F.lane);
        row_finish<const LAS float*>(vb, nwv, modL, modL + D, F.A1 + (size_t)r1 * D, F.lane);
    }
    if (F.wave < 4) row_finish<const LAS float*>(va, nwv, modL + 2 * D, modL + 3 * D, F.A1 + (size_t)(M + 4 * bx + F.wave) * D, F.lane);
}
__device__ __forceinline__ void p2_cbias(Frame& F) {
    const int lane = F.lane, w = F.wave, col = lane & 15, q = lane >> 4;
    LAS float* red = (LAS float*)(F.lds + RING_OFF);
    __syncthreads();
    bf16x8 bfr[16];
    {   const float* sp = F.modf + (size_t)(col & 3) * NMODC + 3 * D + 512 * w + 8 * q;
#pragma unroll
        for (int s = 0; s < 16; ++s) { v4u pk = (v4u){0u, 0u, 0u, 0u};
            if (col < 8) { const f32x4 a0 = *(const f32x4*)(sp + 32 * s), a1 = *(const f32x4*)(sp + 32 * s + 4);
                const unsigned h0 = pk2(a0.x, a0.y), h1 = pk2(a0.z, a0.w), h2 = pk2(a1.x, a1.y), h3 = pk2(a1.z, a1.w);
                const unsigned l0 = pk2(a0.x - bf_lo(h0), a0.y - bf_hi(h0)), l1 = pk2(a0.z - bf_lo(h1), a0.w - bf_hi(h1)), l2 = pk2(a1.x - bf_lo(h2), a1.y - bf_hi(h2)), l3 = pk2(a1.z - bf_lo(h3), a1.w - bf_hi(h3));
                const bool hi = col < 4; pk.x = hi ? h0 : l0; pk.y = hi ? h1 : l1; pk.z = hi ? h2 : l2; pk.w = hi ? h3 : l3; }
            bfr[s] = __builtin_bit_cast(bf16x8, pk); }
    }
    constexpr int NG = DFF / 16, GS = 192;
    int g = F.vc - 64;
    v4u a[16];
    {   const bf16* wp = F.Wt_ff1 + (size_t)(16 * g + col) * LDK + 512 * w + 8 * q;
#pragma unroll
        for (int s = 0; s < 16; ++s) a[s] = *(const v4u*)(wp + 32 * s); }
    for (; g < NG; g += GS) {
        v4u an[16];
#pragma unroll
        for (int s = 0; s < 16; ++s) an[s] = a[s];
        if (g + GS < NG) { const bf16* wp = F.Wt_ff1 + (size_t)(16 * (g + GS) + col) * LDK + 512 * w + 8 * q;
#pragma unroll
            for (int s = 0; s < 16; ++s) an[s] = *(const v4u*)(wp + 32 * s); }
        f32x4 acc = (f32x4){0.f, 0.f, 0.f, 0.f};
#pragma unroll
        for (int s = 0; s < 16; ++s) acc = __builtin_amdgcn_mfma_f32_16x16x32_bf16(__builtin_bit_cast(bf16x8, a[s]), bfr[s], acc, 0, 0, 0);
#pragma unroll
        for (int r = 0; r < 4; ++r) red[(w * 16 + 4 * q + r) * 16 + col] = acc[r];
        __syncthreads();
        if (F.tid < 64) { const int row = F.tid >> 2, b = F.tid & 3; float s = 0.f;
#pragma unroll
            for (int ww = 0; ww < NWAVES; ++ww) s += red[(ww * 16 + row) * 16 + b] + red[(ww * 16 + row) * 16 + 4 + b];
            F.cbias[(size_t)b * DFF + 16 * g + row] = s; }
        __syncthreads();
#pragma unroll
        for (int s = 0; s < 16; ++s) a[s] = an[s];
    }
}
__device__ __forceinline__ void fill_tab_outproj(Frame& F, int pm, int cc) {
    LAS float* tab = (LAS float*)(F.lds + ROWTAB_OFF); LAS float* ct = (LAS float*)(F.lds + COLTAB_OFF);
    if (F.tid < 256) { const int m = pm * 256 + F.tid; float sa = 0.f, sg = 0.f;
#pragma unroll
        for (int i = 0; i < 4; ++i) { const f32x4 t = *(const f32x4*)(F.ssna + (size_t)m * 16 + 4 * i); sa += (t.x + t.y) + (t.z + t.w); }
        { const f32x4 t = *(const f32x4*)(F.sssg + (size_t)m * 4); sg = (t.x + t.y) + (t.z + t.w); }
        const float rna = rsqrtf(sa * (1.0f / DNA) + EPS), rsg = rsqrtf(sg * (1.0f / DSGU) + EPS);
        tab[F.tid] = rna / rsg; tab[256 + F.tid] = rsg; }
    const float* mf = F.modf + (size_t)(pm >> 4) * NMODC;
    for (int i = F.tid; i < 1024; i += NWAVES * 64) { const int col = (4 * (i >> 8) + cc) * 256 + (i & 255);
        ct[i] = mf[2 * D + col]; ct[1024 + i] = F.norm2_w[col] * (1.0f + mf[4 * D + col]); }
    __syncthreads();
}
__device__ __forceinline__ void fill_tab_ff1(Frame& F, int pm, int cc) {
    LAS float* tab = (LAS float*)(F.lds + ROWTAB_OFF); LAS float* ct = (LAS float*)(F.lds + COLTAB_OFF);
    if (F.tid < 256) { const int m = pm * 256 + F.tid; float s = 0.f;
#pragma unroll
        for (int i = 0; i < 16; ++i) { const f32x4 t = *(const f32x4*)(F.pss + (size_t)m * 64 + 4 * i); s += (t.x + t.y) + (t.z + t.w); }
        tab[F.tid] = rsqrtf(s * (1.0f / D) + EPS); }
    const float* cbp = F.cbias + (size_t)(pm >> 4) * DFF;
    for (int i = F.tid; i < 4096; i += NWAVES * 64) ct[i] = cbp[(4 * (i >> 8) + cc) * 256 + (i & 255)];
    __syncthreads();
}
template <class Sched> __device__ __forceinline__ void fill_tab_ff2(Frame& F, const Sched& S) {
    LAS float* ct = (LAS float*)(F.lds + COLTAB_OFF);
    for (int i = 0; i < 4; ++i) { pg8::Unit u; if (!S.next(i, u)) break;
        const float* mf = F.modf + (size_t)(u.pm >> 4) * NMODC + 5 * D + u.pn * 256;
        for (int j = F.tid; j < 256; j += NWAVES * 64) ct[i * 256 + j] = mf[j]; }
    __syncthreads();
}
__device__ __forceinline__ void p9_row(const v4u (&v)[8], const f32x4 (&fw)[16], float* orow, int lane) {
    float ss = 0.f;
#pragma unroll
    for (int j = 0; j < 8; ++j) {
        const float a0 = bf_lo(v[j].x), a1 = bf_hi(v[j].x), a2 = bf_lo(v[j].y), a3 = bf_hi(v[j].y), a4 = bf_lo(v[j].z), a5 = bf_hi(v[j].z), a6 = bf_lo(v[j].w), a7 = bf_hi(v[j].w);
        ss += ((a0 * a0 + a1 * a1) + (a2 * a2 + a3 * a3)) + ((a4 * a4 + a5 * a5) + (a6 * a6 + a7 * a7)); }
    const float rstd = rsqrtf(wave_sum(ss) * (1.0f / D) + EPS);
#pragma unroll
    for (int j = 0; j < 8; ++j) { const int col = 8 * (lane + 64 * j);
        *(f32x4*)(orow + col) = (f32x4){bf_lo(v[j].x), bf_hi(v[j].x), bf_lo(v[j].y), bf_hi(v[j].y)} * rstd * fw[2 * j];
        *(f32x4*)(orow + col + 4) = (f32x4){bf_lo(v[j].z), bf_hi(v[j].z), bf_lo(v[j].w), bf_hi(v[j].w)} * rstd * fw[2 * j + 1]; }
}
__device__ __forceinline__ void p9_final(Frame& F) {
    const int gw = (int)blockIdx.x * NWAVES + F.wave, NGW = F.G * NWAVES;
    f32x4 fw[16];
#pragma unroll
    for (int j = 0; j < 8; ++j) { const int col = 8 * (F.lane + 64 * j); fw[2 * j] = ld4(F.fnw + col); fw[2 * j + 1] = ld4(F.fnw + col + 4); }
    v4u va[8], vb[8];
    if (gw < M) { const v4u* xr = (const v4u*)(F.XB + (size_t)gw * D) + F.lane;
#pragma unroll
        for (int j = 0; j < 8; ++j) va[j] = xr[64 * j]; }
#pragma unroll 1
    for (int m = gw; m < M; m += 2 * NGW) {
        const int m1 = m + NGW, m2 = m1 + NGW;
        if (m1 < M) { const v4u* xr = (const v4u*)(F.XB + (size_t)m1 * D) + F.lane;
#pragma unroll
            for (int j = 0; j < 8; ++j) vb[j] = xr[64 * j]; }
        p9_row(va, fw, F.out + (size_t)m * D, F.lane);
        if (m2 < M) { const v4u* xr = (const v4u*)(F.XB + (size_t)m2 * D) + F.lane;
#pragma unroll
            for (int j = 0; j < 8; ++j) va[j] = xr[64 * j]; }
        if (m1 < M) p9_row(vb, fw, F.out + (size_t)m1 * D, F.lane);
    }
}
__device__ __forceinline__ float xrow16_max(float x) {
    auto s = __builtin_amdgcn_permlane16_swap(__float_as_uint(x), __float_as_uint(x), false, false);
    x = fmaxf(__uint_as_float(s[0]), __uint_as_float(s[1]));
    auto t = __builtin_amdgcn_permlane32_swap(__float_as_uint(x), __float_as_uint(x), false, false);
    return fmaxf(__uint_as_float(t[0]), __uint_as_float(t[1]));
}
__device__ __forceinline__ float xrow16_sum(float x) {
    auto s = __builtin_amdgcn_permlane16_swap(__float_as_uint(x), __float_as_uint(x), false, false);
    x = __uint_as_float(s[0]) + __uint_as_float(s[1]);
    auto t = __builtin_amdgcn_permlane32_swap(__float_as_uint(x), __float_as_uint(x), false, false);
    return __uint_as_float(t[0]) + __uint_as_float(t[1]);
}
__device__ __forceinline__ void glds16(const void* gsrc, unsigned lds_dst) { unsigned keep;
    asm volatile("s_mov_b32 %0, m0\n\ts_mov_b32 m0, %2\n\ts_nop 0\n\tglobal_load_lds_dwordx4 %1, off\n\ts_mov_b32 m0, %0" : "=&s"(keep) : "v"(gsrc), "s"(lds_dst) : "memory"); }
constexpr int SG_BUF = 65536, SG_NW_OFF = 2 * SG_BUF, SG_RG_OFF = SG_NW_OFF + 8192;
static_assert(SG_RG_OFF + 512 <= LDSCTL_OFF, "SGU LDS image below the control words");
__device__ __forceinline__ void sgu_stage(Frame& F, int tok0, int cq, int buf) {
    const int w = F.wave, L = F.lane;
    const unsigned base = (unsigned)(size_t)(F.lds + buf * SG_BUF);
#pragma unroll
    for (int i = 0; i < 4; ++i) { const int p = w + 8 * i, row = 4 * p + (L >> 4), c = (L & 15) ^ (row & 15);
        glds16(F.GT + (size_t)(cq + row) * M + tok0 + c * 8, (unsigned)__builtin_amdgcn_readfirstlane((int)(base + p * 1024))); }
#pragma unroll
    for (int i = 0; i < 4; ++i) { const int p = w + 8 * i, row = 4 * p + (L >> 4), c = (L & 15) ^ (row & 15);
        glds16(F.UB + (size_t)(tok0 + row) * DSGU + cq + c * 8, (unsigned)__builtin_amdgcn_readfirstlane((int)(base + 32768 + p * 1024))); }
}
__device__ __forceinline__ void sgu_wg(Frame& F, const int u0, const int ustride, const int nun) {
    const int lane = F.lane, w = F.wave, l15 = lane & 15, g = lane >> 4;
    LAS float* nwl = (LAS float*)(F.lds + SG_NW_OFF); LAS float* rgs = (LAS float*)(F.lds + SG_RG_OFF);
    for (int i = F.tid; i < DSGU / 4; i += NWAVES * 64) *(LAS f32x4*)(nwl + 4 * i) = *(const f32x4*)(F.sgu_norm_w + 4 * i);
    bf16x8 wf[4]; float bias = 0.f, ssq = 0.f; int tok0 = 0, grp = 0;
    const int nq = 4 * nun;
    sgu_stage(F, (u0 >> 7) * SEQ + ((u0 >> 2) & 31) * 128, (u0 & 3) * 512, 0);
    for (int k = 0; k < nq; ++k) {
        const int uid = u0 + ustride * (k >> 2), qq = k & 3;
        if (qq == 0) {
            tok0 = (uid >> 7) * SEQ + ((uid >> 2) & 31) * 128; grp = uid & 3; ssq = 0.f;
            __syncthreads();
            if (F.tid < 128) { const float* sp = F.ssgp + (size_t)(tok0 + F.tid) * 16; float s = 0.f;
#pragma unroll
                for (int i = 0; i < 4; ++i) { const f32x4 t = *(const f32x4*)(sp + 4 * i); s += (t.x + t.y) + (t.z + t.w); }
                rgs[F.tid] = rsqrtf(s * (1.0f / DSGU) + EPS); }
            __syncthreads();
            const int p = 16 * w + l15;
#pragma unroll
            for (int ks = 0; ks < 4; ++ks) { const int q0 = ks * 32 + 8 * g; const float* wp = F.sgu_w + (size_t)(grp * 128 + p) * 128 + q0;
                const f32x4 w0 = *(const f32x4*)wp, w1 = *(const f32x4*)(wp + 4); const f32x4 r0 = *(const LAS f32x4*)(rgs + q0), r1 = *(const LAS f32x4*)(rgs + q0 + 4);
                v4u pk; pk.x = pk2(w0.x * r0.x, w0.y * r0.y); pk.y = pk2(w0.z * r0.z, w0.w * r0.w); pk.z = pk2(w1.x * r1.x, w1.y * r1.y); pk.w = pk2(w1.z * r1.z, w1.w * r1.w);
                wf[ks] = __builtin_bit_cast(bf16x8, pk); }
            bias = F.sgu_b[grp * 128 + p];
            asm volatile("" :: "v"(wf[0]), "v"(wf[1]), "v"(wf[2]), "v"(wf[3]), "v"(bias));
        }
        asm volatile("" ::: "memory"); __builtin_amdgcn_s_barrier(); asm volatile("" ::: "memory");
        if (k + 1 < nq) { const int un = u0 + ustride * ((k + 1) >> 2); sgu_stage(F, (un >> 7) * SEQ + ((un >> 2) & 31) * 128, (un & 3) * 512 + ((k + 1) & 3) * 128, (k + 1) & 1);
            asm volatile("s_waitcnt vmcnt(12)" ::: "memory"); }
        else asm volatile("s_waitcnt vmcnt(4)" ::: "memory");
        __builtin_amdgcn_s_barrier(); asm volatile("" ::: "memory");
        const LAS unsigned char* gb = F.lds + (k & 1) * SG_BUF; LAS unsigned char* ub = F.lds + (k & 1) * SG_BUF + 32768;
        const int p = 16 * w + l15;
#pragma unroll 2
        for (int ct = 0; ct < 8; ++ct) {
            f32x4 d = (f32x4){0.f, 0.f, 0.f, 0.f};
            const LAS unsigned char* gr = gb + (16 * ct + l15) * 256;
#pragma unroll
            for (int ks = 0; ks < 4; ++ks) { const bf16x8 gf = *(const LAS bf16x8*)(gr + (((4 * ks + g) ^ l15) << 4)); d = __builtin_amdgcn_mfma_f32_16x16x32_bf16(gf, wf[ks], d, 0, 0, 0); }
            LAS unsigned char* ua = ub + p * 256 + (((2 * ct + (g >> 1)) ^ l15) << 4) + ((g & 1) << 3);
            const v2u uu = *(const LAS v2u*)ua;
            const f32x4 nw = *(const LAS f32x4*)(nwl + grp * 512 + qq * 128 + 16 * ct + 4 * g);
            const float o0 = bf_lo(uu.x) * (nw.x * d[0] + bias), o1 = bf_hi(uu.x) * (nw.y * d[1] + bias), o2 = bf_lo(uu.y) * (nw.z * d[2] + bias), o3 = bf_hi(uu.y) * (nw.w * d[3] + bias);
            ssq += (o0 * o0 + o1 * o1) + (o2 * o2 + o3 * o3);
            v2u pk; pk.x = pk2(o0, o1); pk.y = pk2(o2, o3);
            *(LAS v2u*)ua = pk;
        }
        asm volatile("s_waitcnt lgkmcnt(0)" ::: "memory"); __builtin_amdgcn_s_barrier(); asm volatile("" ::: "memory");
        {
            bf16* ob = F.A2 + (size_t)tok0 * D + DNA + grp * 512 + qq * 128;
#pragma unroll
            for (int i = 0; i < 4; ++i) { const int id = F.tid + 512 * i, row = id >> 4, slot = id & 15, c = slot ^ (row & 15);
                const v4u v = *(const LAS v4u*)(ub + row * 256 + (slot << 4));
                *(v4u*)(ob + (size_t)row * D + c * 8) = v; }
        }
        if (qq == 3) { const float s = xrow16_sum(ssq); if (g == 0) F.sssg[(size_t)(tok0 + 16 * w + l15) * 4 + grp] = s; }
    }
    __syncthreads();
}
constexpr int AT_TILE = 32768;
constexpr int AT_NBUF = 4;
constexpr int RPB_OFF = AT_NBUF * AT_TILE + 64, ATT_LDS_END = RPB_OFF + 15 * 31 * 4 + 256;
static_assert(ATT_LDS_END <= LDSCTL_OFF, "attention LDS image below the control words");
__device__ __forceinline__ void attn_scores(const bf16x8 (&k)[2][4], const bf16x8 (&qf)[4], f32x4 (&s)[2]) {
#pragma unroll
    for (int tt = 0; tt < 2; ++tt) { s[tt] = (f32x4){0.f, 0.f, 0.f, 0.f};
#pragma unroll
        for (int ds = 0; ds < 4; ++ds) s[tt] = __builtin_amdgcn_mfma_f32_16x16x32_bf16(k[tt][ds], qf[ds], s[tt], 0, 0, 0); }
}
template <bool WIN> __device__ __forceinline__ bf16x8 attn_softmax(f32x4 (&s)[2], const LAS float* bp, int lo, f32x4 (&o)[8], float& mrun, float& lrun) {
    if (WIN) {
        float bv[8];
#pragma unroll
        for (int i = 0; i < 8; ++i) bv[i] = bp[i];
        asm volatile("" : "+v"(bv[0]), "+v"(bv[1]), "+v"(bv[2]), "+v"(bv[3]), "+v"(bv[4]), "+v"(bv[5]), "+v"(bv[6]), "+v"(bv[7]));
#pragma unroll
        for (int i = 0; i < 8; ++i) { const bool valid = (unsigned)(i - lo) < 16u; s[i >> 2][i & 3] = valid ? s[i >> 2][i & 3] + bv[i] : -1e30f; }
    }
    float mx = fmaxf(fmaxf(fmaxf(s[0][0], s[0][1]), fmaxf(s[0][2], s[0][3])), fmaxf(fmaxf(s[1][0], s[1][1]), fmaxf(s[1][2], s[1][3])));
    mx = xrow16_max(mx);
    if (__builtin_amdgcn_ballot_w64(mx > mrun + 8.0f)) {
        const float mn = fmaxf(mrun, mx), alpha = __builtin_amdgcn_exp2f(mrun - mn); mrun = mn; lrun *= alpha;
#pragma unroll
        for (int dt = 0; dt < 8; ++dt) o[dt] *= alpha;
    }
    float ps = 0.f;
#pragma unroll
    for (int tt = 0; tt < 2; ++tt)
#pragma unroll
        for (int rg = 0; rg < 4; ++rg) { s[tt][rg] = __builtin_amdgcn_exp2f(s[tt][rg] - mrun); ps += s[tt][rg]; }
    lrun += ps;
    v4u pk; pk.x = pk2(s[0][0], s[0][1]); pk.y = pk2(s[0][2], s[0][3]); pk.z = pk2(s[1][0], s[1][1]); pk.w = pk2(s[1][2], s[1][3]);
    return __builtin_bit_cast(bf16x8, pk);
}
__device__ __forceinline__ void attn_pv(const bf16x8 (&v)[8], bf16x8 pf, f32x4 (&o)[8]) {
#pragma unroll
    for (int dt = 0; dt < 8; ++dt) o[dt] = __builtin_amdgcn_mfma_f32_16x16x32_bf16(v[dt], pf, o[dt], 0, 0, 0);
}
__device__ __forceinline__ void glds16s(const void* sbase, unsigned voff, unsigned lds_dst) { unsigned keep;
    asm volatile("s_mov_b32 %0, m0\n\ts_mov_b32 m0, %3\n\ts_nop 0\n\tglobal_load_lds_dwordx4 %1, %2\n\ts_mov_b32 m0, %0" : "=&s"(keep) : "v"(voff), "s"(sbase), "s"(lds_dst) : "memory"); }
__device__ __forceinline__ const void* uniform_ptr(const void* p) { const unsigned long long a = (unsigned long long)p;
    return (const void*)(((unsigned long long)(unsigned)__builtin_amdgcn_readfirstlane((int)(a >> 32)) << 32) | (unsigned)__builtin_amdgcn_readfirstlane((int)a)); }
struct AttnDma { unsigned ko[2], vo[2]; };
__device__ __forceinline__ void attn_dma_init(AttnDma& d, int w, int L) {
#pragma unroll
    for (int i = 0; i < 2; ++i) { const int p = w + 8 * i, row = 4 * p + (L >> 4), f = (row & 3) | (((row >> 3) & 3) << 2), c = (L & 15) ^ f; d.ko[i] = (unsigned)(row * DNA * 2 + c * 16); }
#pragma unroll
    for (int i = 0; i < 2; ++i) { const int p = w + 8 * i, row = 8 * p + (L >> 3), c = (L & 7) ^ ((row >> 1) & 7); d.vo[i] = (unsigned)(row * MA * 2 + c * 16); }
}
__device__ __forceinline__ void attn_stage(Frame& F, const AttnDma& d, int h, int T, int buf) {
    const int w = F.wave;
    const unsigned base = (unsigned)(size_t)(F.lds + buf * AT_TILE);
    const void* kb = uniform_ptr(F.KB + (size_t)T * DNA + h * HD); const void* vb = uniform_ptr(F.VT + (size_t)(h * HD) * MA + T);
#pragma unroll
    for (int i = 0; i < 2; ++i) glds16s(kb, d.ko[i], (unsigned)__builtin_amdgcn_readfirstlane((int)(base + (w + 8 * i) * 1024)));
#pragma unroll
    for (int i = 0; i < 2; ++i) glds16s(vb, d.vo[i], (unsigned)__builtin_amdgcn_readfirstlane((int)(base + 16384 + (w + 8 * i) * 1024)));
}
__device__ __forceinline__ void attn_kfrags(const LAS unsigned char* tile, int kb0, int q, int g, bf16x8 (&k)[2][4]) {
    const int a = q >> 2, cc = q & 3, fh = ((kb0 >> 3) + a) & 3;
    const LAS unsigned char* kr = tile + (kb0 + 8 * a + cc) * 256 + ((g ^ cc) << 4);
#pragma unroll
    for (int ds = 0; ds < 4; ++ds) { const int off = (ds ^ fh) << 6;
#pragma unroll
        for (int tt = 0; tt < 2; ++tt) k[tt][ds] = *(const LAS bf16x8*)(kr + tt * 1024 + off); }
}
__device__ __forceinline__ void attn_vfrags(const LAS unsigned char* tile, int kb0, int q, int g, bf16x8 (&v)[8]) {
    const int pc = ((kb0 >> 3) + g) ^ ((q >> 1) & 7);
    const LAS unsigned char* vr = tile + 16384 + q * 128 + (pc << 4);
#pragma unroll
    for (int dt = 0; dt < 8; ++dt) v[dt] = *(const LAS bf16x8*)(vr + dt * 2048);
}
template <bool A, bool B> __device__ __forceinline__ void attn_pv2(const LAS unsigned char* tile, int kb0, int q, int g, bf16x8 pfA, bf16x8 pfB, f32x4 (&oA)[8], f32x4 (&oB)[8]) {
    const int pc = ((kb0 >> 3) + g) ^ ((q >> 1) & 7);
    const LAS unsigned char* vr = tile + 16384 + q * 128 + (pc << 4);
#pragma unroll
    for (int hf = 0; hf < 2; ++hf) {
        bf16x8 v[4];
#pragma unroll
        for (int i = 0; i < 4; ++i) v[i] = *(const LAS bf16x8*)(vr + (4 * hf + i) * 2048);
#pragma unroll
        for (int i = 0; i < 4; ++i) { if (A) oA[4 * hf + i] = __builtin_amdgcn_mfma_f32_16x16x32_bf16(v[i], pfA, oA[4 * hf + i], 0, 0, 0);
                                      if (B) oB[4 * hf + i] = __builtin_amdgcn_mfma_f32_16x16x32_bf16(v[i], pfB, oB[4 * hf + i], 0, 0, 0); }
        __builtin_amdgcn_sched_barrier(0);
    }
}
#define ATT_KEEP2(pa, pb) asm volatile("s_nop 7" :: "v"(pa), "v"(pb))
#define ATT_KEEP1(pa) asm volatile("s_nop 7" :: "v"(pa))
__device__ __forceinline__ void attn_finish(Frame& F, f32x4 (&o)[8], float lrun, int qtok, int h, int g) {
    const float inv = 1.0f / xrow16_sum(lrun); float ssq = 0.f;
    bf16* op = F.A2 + (size_t)qtok * D + h * HD + 4 * g;
#pragma unroll
    for (int dt = 0; dt < 8; ++dt) { const f32x4 v = o[dt] * inv; ssq += (v.x * v.x + v.y * v.y) + (v.z * v.z + v.w * v.w);
        v2u pk; pk.x = pk2(v.x, v.y); pk.y = pk2(v.z, v.w); *(v2u*)(op + dt * 16) = pk; }
    ssq = xrow16_sum(ssq);
    if (g == 0) F.ssna[(size_t)qtok * 16 + h] = ssq;
}
__device__ __forceinline__ void attn_wg(Frame& F) {
    const int lane = F.lane, q = lane & 15, g = lane >> 4, w = F.wave, j = w & 3;
    const int xcd = F.vc & 7, li = F.vc >> 3, R = 2 * li, r = R + (w >> 2);
    const int qcol = 16 * j + q;
    int r0 = r - 4; r0 = r0 < 0 ? 0 : (r0 > 56 ? 56 : r0);
    int krlo = R - 4; krlo = krlo < 0 ? 0 : (krlo > 56 ? 56 : krlo);
    int krhi = R - 3; krhi = (krhi < 0 ? 0 : (krhi > 56 ? 56 : krhi)) + 7;
    const int nwin = krhi - krlo + 1, nst = nwin + 4, NT = 8 * nst;
    int cs = qcol - 8; cs = cs < 0 ? 0 : (cs > 48 ? 48 : cs);
    const int band0 = (j == 0) ? 0 : (j == 1 ? 8 : (j == 2 ? 24 : 32));
    const int lo = cs - (band0 + 8 * g);
    const LAS float* rpb = (const LAS float*)(F.lds + RPB_OFF) + (band0 + 8 * g - qcol + 15);
    AttnDma dma; attn_dma_init(dma, w, lane);
    int sg_s = 0, sg_bh = xcd * 8;
#define ATT_STAGE_NEXT(slot) do { const int b_ = sg_bh >> 4, h_ = sg_bh & 15; \
        attn_stage(F, dma, h_, (sg_s < nwin) ? b_ * SEQ + (krlo + sg_s) * GW : M + b_ * CTX + 64 * (sg_s - nwin), (slot)); \
        if (++sg_s == nst) { sg_s = 0; ++sg_bh; } } while (0)
    ATT_STAGE_NEXT(0); ATT_STAGE_NEXT(1); ATT_STAGE_NEXT(2);
    bf16x8 qf[4]; f32x4 o[8]; float mrun = -1e30f, lrun = 0.f; int s = 0, bh = xcd * 8, qtok = 0;
#pragma unroll
    for (int ds = 0; ds < 4; ++ds) qf[ds] = (bf16x8){0, 0, 0, 0, 0, 0, 0, 0};
#pragma unroll
    for (int dt = 0; dt < 8; ++dt) o[dt] = (f32x4){0.f, 0.f, 0.f, 0.f};
    for (int t = 0; t < NT; ++t) {
        const int b = bh >> 4, h = bh & 15;
        if (s == 0) {
            for (int i = F.tid; i < 15 * 31; i += NWAVES * 64) ((LAS float*)(F.lds + RPB_OFF))[i] = F.rpb[h * 15 * 31 + i] * LOG2E;
            qtok = b * SEQ + r * GW + qcol;
#pragma unroll
            for (int ds = 0; ds < 4; ++ds) qf[ds] = *(const bf16x8*)(F.QB + (size_t)qtok * DNA + h * HD + ds * 32 + 8 * g);
#pragma unroll
            for (int dt = 0; dt < 8; ++dt) o[dt] = (f32x4){0.f, 0.f, 0.f, 0.f};
            mrun = -1e30f; lrun = 0.f;
            asm volatile("s_waitcnt lgkmcnt(0)" :: "v"(qf[0]), "v"(qf[1]), "v"(qf[2]), "v"(qf[3]) : "memory");
        }
        if (t + 2 < NT) asm volatile("s_waitcnt vmcnt(8)" ::: "memory"); else if (t + 1 < NT) asm volatile("s_waitcnt vmcnt(4)" ::: "memory"); else asm volatile("s_waitcnt vmcnt(0)" ::: "memory");
        __builtin_amdgcn_s_barrier(); asm volatile("" ::: "memory");
        if (t + 3 < NT) ATT_STAGE_NEXT((t + 3) & (AT_NBUF - 1));
        const LAS unsigned char* tile = F.lds + (t & (AT_NBUF - 1)) * AT_TILE;
        if (s < nwin) {
            const int kr = krlo + s;
            if ((kr >= r0) && (kr < r0 + 8)) {
                bf16x8 kf[2][4], vf[8]; f32x4 sc[2];
                attn_kfrags(tile, band0, q, g, kf); attn_vfrags(tile, band0, q, g, vf);
                attn_scores(kf, qf, sc);
                bf16x8 pf = attn_softmax<true>(sc, rpb + (kr - r + 7) * 31, lo, o, mrun, lrun);
                attn_pv(vf, pf, o); ATT_KEEP1(pf);
            }
        } else {
#pragma unroll
            for (int hh = 0; hh < 2; ++hh) {
                bf16x8 kf[2][4], vf[8]; f32x4 sc[2];
                attn_kfrags(tile, 32 * hh, q, g, kf); attn_vfrags(tile, 32 * hh, q, g, vf);
                attn_scores(kf, qf, sc);
                bf16x8 pf = attn_softmax<false>(sc, nullptr, 0, o, mrun, lrun);
                attn_pv(vf, pf, o); ATT_KEEP1(pf);
            }
        }
        if (++s == nst) { attn_finish(F, o, lrun, qtok, h, g); s = 0; ++bh; }
    }
#undef ATT_STAGE_NEXT
    __builtin_amdgcn_s_barrier(); asm volatile("" ::: "memory");
}
__device__ __forceinline__ void p3_mixers(Frame& F) {
    __syncthreads();
    DBG_BEGIN(ts_);
    for (int rep = 0; rep < REPS(31); ++rep) sgu_wg(F, F.vc, F.G, 2);
    DBG_END(F, 10, ts_); DBG_BEGIN(ta_);
    for (int rep = 0; rep < REPS(32); ++rep) attn_wg(F);
    DBG_END(F, 11, ta_);
}
struct Args { const float* in[19]; float* out; unsigned char* ws; int ph_lo, ph_hi; };
__global__ void __launch_bounds__(NWAVES * 64, 2) mk_fwd(Args args) {
    extern __shared__ __attribute__((aligned(16))) unsigned char lds[];
    Frame F;
    F.lds = (LAS unsigned char*)lds;
    F.MISC = (volatile LAS unsigned*)(F.lds + MISC_OFF);
    F.tid = threadIdx.x; F.lane = F.tid & 63; F.wave = __builtin_amdgcn_readfirstlane(F.tid >> 6);
    F.G = gridDim.x;
    unsigned char* ws = args.ws;
    F.ctl = (gu32*)(ws + WS_CTL);
    F.x = args.in[0]; F.c = args.in[1]; F.ctx = args.in[2]; F.cctx = args.in[3]; F.w_ada = args.in[4]; F.b_ada = args.in[5]; F.norm1_w = args.in[6]; F.w_in = args.in[7]; F.rpb = args.in[8];
    F.sgu_norm_w = args.in[9]; F.sgu_w = args.in[10]; F.sgu_b = args.in[11]; F.gna = args.in[12]; F.gsgu = args.in[13]; F.w_out = args.in[14]; F.norm2_w = args.in[15];
    F.w_ff1 = args.in[16]; F.w_ff2 = args.in[17]; F.fnw = args.in[18]; F.out = args.out;
    F.modf = (float*)(ws + WS_MODF); F.part = (float*)(ws + WS_PART); F.ssna = (float*)(ws + WS_SSNA); F.sssg = (float*)(ws + WS_SSSG); F.cbias = (float*)(ws + WS_CBIAS); F.pss = (float*)(ws + WS_PSS); F.ssgp = (float*)(ws + WS_SSGP);
    F.Wt_in = (bf16*)(ws + WS_WIN); F.Wt_out = (bf16*)(ws + WS_WOUT); F.Wt_ff1 = (bf16*)(ws + WS_WFF1); F.Wt_ff2 = (bf16*)(ws + WS_WFF2);
    F.A1 = (bf16*)(ws + WS_A1); F.QB = (bf16*)(ws + WS_Q); F.KB = (bf16*)(ws + WS_K); F.VT = (bf16*)(ws + WS_VT); F.UB = (bf16*)(ws + WS_U); F.GT = (bf16*)(ws + WS_GT);
    F.A2 = (bf16*)(ws + WS_A2); F.HB = (bf16*)(ws + WS_H); F.XB = (bf16*)(ws + WS_XB);
    for (int u = F.tid; u < (LDS_BYTES - LDSCTL_OFF) / 4; u += NWAVES * 64) ((LAS unsigned*)(F.lds + LDSCTL_OFF))[u] = 0u;
    __syncthreads();
    XcdBarrier bar; bar.bar = (unsigned*)(F.ctl + CW_BAR); bar.x = 0; bar.st = nullptr;
    F.vc = (int)blockIdx.x;
    if (MK_N_LAUNCHES == 1) {
        bar.x = xb_xcc_id(); bar.st = F.MISC + 8;
        if (F.tid == 0) F.MISC[12] = xb_add(&bar.bar[XB_XCNT(bar.x)], 1u);
    }
    const int lo = args.ph_lo, hi = args.ph_hi;
#define IN(k) (lo <= (k) && (k) < hi)
#define SEAM(k) do { if (IN(k) && IN((k) + 1)) { DBG_BEGIN(tb_); xcd_barrier(bar); DBG_END(F, 16 + (k), tb_); } } while (0)

    DBG_BEGIN(tp_);
    if (IN(0)) { p0_ada(F); } DBG_END(F, 0, tp_); SEAM(0);
    if (MK_N_LAUNCHES == 1) {
        if (F.tid == 0) { bool ok = (F.G == 256) && (bar.x < 8u);
            for (unsigned jx = 0; jx < 16; ++jx) { const unsigned cnt = xb_ld(&bar.bar[XB_XCNT(jx)]); ok = ok && (cnt == (jx < 8 ? 32u : 0u)); }
            F.MISC[13] = ok ? (bar.x + 8u * F.MISC[12]) : (unsigned)blockIdx.x; }
        __syncthreads();
        F.vc = (int)F.MISC[13];
    }
    DBG_MARK(tp_); if (IN(1)) { p1_rows(F); p0_transpose(F, (int)blockIdx.x * NWAVES + F.wave, 2048, 26, I_IN / 2048, I_OUT / 2048, false); }
    DBG_MARK(tp_);
    if (IN(2)) {
        pg8::Gemm g{F.A1, F.Wt_in, MA, DIN, D, D}; pg8::InProjOrder S; S.G = F.G; S.c = F.vc;
        pg8::EpiInProj E{F.QB, WS_SLOT / 2, 0.08838834764831845f * LOG2E, F.ssgp};
        pg8::gemm_phase<pg8::EpiInProj, pg8::InProjOrder, true, true>(F.lds + RING_OFF, g, S, E);
        if (F.vc >= 64) { p2_cbias(F);
            const int tw = (F.vc - 64) * NWAVES + F.wave;
            p0_transpose(F, I_IN + tw, 192 * NWAVES, F.vc - 64 < 64 ? 6 : 5, 1 << 30, 0, true); }
    } DBG_END(F, 2, tp_); SEAM(2);
    DBG_MARK(tp_);
    if (IN(3)) { for (int rep = 0; rep < REPS(3); ++rep) p3_mixers(F); } DBG_END(F, 3, tp_); SEAM(3);
    DBG_MARK(tp_);
    if (IN(4)) {
        pg8::Gemm g{F.A2, F.Wt_out, M, D, D, D}; pg8::StdOrder S; S.init(M, D, F.G, F.vc);
        pg8::Unit u0; S.next(0, u0); fill_tab_outproj(F, u0.pm, u0.pn & 3);
        pg8::EpiOutProj E{F.x, F.XB, F.A1, LDK, F.pss, (const LAS float*)(F.lds + COLTAB_OFF), (const LAS float*)(F.lds + COLTAB_OFF) + 1024, (const LAS float*)(F.lds + ROWTAB_OFF)};
        pg8::gemm_phase<pg8::EpiOutProj, pg8::StdOrder, true, true>(F.lds + RING_OFF, g, S, E);
    } DBG_END(F, 4, tp_); SEAM(4);
    DBG_MARK(tp_);
    if (IN(5)) p0_transpose(F, (int)blockIdx.x * NWAVES + F.wave + TR_K_SPLIT * 2048, 2048, 16, 1 << 30, 0, false);
    if (IN(5)) for (int rep = 0; rep < REPS(5); ++rep) {
        pg8::Gemm g{F.A1, F.Wt_ff1, M, DFF, D, LDK}; pg8::StdOrder S; S.init(M, DFF, F.G, F.vc);
        pg8::Unit u0; S.next(0, u0); fill_tab_ff1(F, u0.pm, u0.pn & 3);
        pg8::EpiRelu2 E{F.HB, LDF2, (const LAS float*)(F.lds + COLTAB_OFF), (const LAS float*)(F.lds + ROWTAB_OFF)};
        pg8::gemm_phase<pg8::EpiRelu2, pg8::StdOrder, true, true>(F.lds + RING_OFF, g, S, E);
    } DBG_END(F, 5, tp_); SEAM(5);
    DBG_MARK(tp_);
    if (IN(6)) {
        pg8::Gemm g{F.HB, F.Wt_ff2, M, D, DFF, LDF2}; pg8::Ff2Order S; S.c = F.vc;
        fill_tab_ff2(F, S);
        pg8::EpiGatedRes E{F.XB, (const LAS float*)(F.lds + COLTAB_OFF)};
        pg8::gemm_phase<pg8::EpiGatedRes, pg8::Ff2Order, true, true>(F.lds + RING_OFF, g, S, E);
    } DBG_END(F, 6, tp_); SEAM(6);
    DBG_MARK(tp_);
    if (IN(7)) { p9_final(F); } DBG_END(F, 7, tp_);
    if (DBG_SLOT >= 0) {
        __syncthreads();
        if (blockIdx.x == 0 && F.tid == 0) { const unsigned long long v = (unsigned long long)__hip_atomic_load((unsigned*)(F.ctl + CW_DBG + 64 * (DBG_SLOT >= 0 ? DBG_SLOT : 0)), RLX_AGENT) * DBG_MULT;
            const unsigned long long t0 = __builtin_amdgcn_s_memrealtime(); while (__builtin_amdgcn_s_memrealtime() - t0 < v) __builtin_amdgcn_s_sleep(8); }
    }
#undef IN
#undef SEAM
}

extern "C" void kernel_launch(void* const* d_in, const int* in_sizes, int n_in, void* d_out, int out_size, void* d_ws, size_t ws_size, hipStream_t stream) {
    static int grid = 0;
    if (grid == 0) {
        if (n_in != 19 || in_sizes[0] != M * D || out_size != M * D || ws_size < WS_END) { fprintf(stderr, "kernel_launch: unexpected shapes / workspace (%zu)\n", ws_size); grid = -1; return; }
        int dev = 0, cus = 0, per_cu = 0;
        if (hipGetDevice(&dev) != hipSuccess || hipDeviceGetAttribute(&cus, hipDeviceAttributeMultiprocessorCount, dev) != hipSuccess) { grid = -1; return; }
        if (hipFuncSetAttribute((const void*)mk_fwd, hipFuncAttributeMaxDynamicSharedMemorySize, LDS_BYTES) != hipSuccess) { grid = -1; return; }
        if (hipOccupancyMaxActiveBlocksPerMultiprocessor(&per_cu, (const void*)mk_fwd, NWAVES * 64, LDS_BYTES) != hipSuccess || per_cu < 1) { fprintf(stderr, "kernel_launch: occupancy query says %d\n", per_cu); }
        (void)hipGetLastError();
        if (cus < 256) { fprintf(stderr, "kernel_launch: needs 256 CUs, device has %d\n", cus); grid = -1; return; }
        grid = 256;
    }
    if (grid < 0) return;
    if (hipMemsetAsync((char*)d_ws + WS_CTL, 0, CTL_ZERO_BYTES, stream) != hipSuccess) return;
    Args a{};
    for (int i = 0; i < 19; ++i) a.in[i] = (const float*)d_in[i];
    a.out = (float*)d_out; a.ws = (unsigned char*)d_ws;
    if (MK_N_LAUNCHES == 1) { a.ph_lo = 0; a.ph_hi = N_PHASES; hipLaunchKernelGGL(mk_fwd, dim3(grid), dim3(NWAVES * 64), LDS_BYTES, stream, a); }
    else for (int p = 0; p < N_PHASES; ++p) { a.ph_lo = p; a.ph_hi = p + 1; hipLaunchKernelGGL(mk_fwd, dim3(grid), dim3(NWAVES * 64), LDS_BYTES, stream, a); }
}
```
